# Optimizing an MI355X kernel written in HIP

```python
import jax, jax.numpy as jnp
from jax import lax
import numpy as np

D_MODEL = 2048
BATCH = 4
SEQ = 2048
DEPTH = 2

GRID_W = 64
CTX_LEN = 256
D_FF = 5632
D_A = 1024
GROUPS_A = 8
CHUNK_A = 128
D_B = 1024
HEADS_B = 8
HEAD_DK = D_B // HEADS_B
HEAD_DV = D_B // HEADS_B
CHUNK_B = 64
N_MOD = 9
N_NORM = 6
MACARON = 0.5
EPS = 1e-6
SPLIT_SIZES = (D_A, D_A, D_B, D_B, D_B, D_B, D_B, D_MODEL, D_MODEL)
IN_COLS = 2 * D_A + 5 * D_B + 2 * D_MODEL
OFF_F = 2 * D_A + D_B
OFF_G = 2 * D_A + 4 * D_B

kernel_name = 'hybrid_gmlp_hgrn2_dit'


def _rms(x, g):
    xf = x.astype(jnp.float32)
    y = xf * lax.rsqrt(jnp.mean(xf * xf, axis=-1, keepdims=True) + EPS)
    return (y * g.astype(jnp.float32)).astype(x.dtype)


def _layernorm(x, g):
    xf = x.astype(jnp.float32)
    xc = xf - jnp.mean(xf, axis=-1, keepdims=True)
    y = xc * lax.rsqrt(jnp.mean(xc * xc, axis=-1, keepdims=True) + EPS)
    return (y * g.astype(jnp.float32)).astype(x.dtype)


def _modulate(z, g_pre, shift, scale):
    return _rms(z, g_pre) * (1 + scale) + shift


def _residual(z, y, g_post, gate, weight):
    return z + weight * gate * _rms(y, g_post)


def _swiglu(h, w_gu, w_down):
    a, b = jnp.split(h @ w_gu, 2, axis=-1)
    return (jax.nn.silu(a) * b) @ w_down


def _split_cols(p):
    idx = [int(i) for i in np.cumsum(SPLIT_SIZES)[:-1]]
    return jnp.split(p, idx, axis=-1)


def _chunk_mlp(u, v, n_chunks, g_norm, w_s, b_s):
    b, n, _ = u.shape
    v = _layernorm(v, g_norm).reshape(b, n_chunks, CHUNK_A, GROUPS_A, D_A // GROUPS_A)
    sv = jnp.einsum('gts,bcsgd->bctgd', w_s, v) + b_s.T[None, None, :, :, None]
    return u * sv.reshape(b, n, D_A)


def _heads(t):
    b, n, _ = t.shape
    return jnp.transpose(t.reshape(b, n, HEADS_B, -1), (0, 2, 1, 3)).astype(jnp.float32)


def _decay(f_logit, lb):
    f = lb + (1.0 - lb) * jax.nn.sigmoid(f_logit.astype(jnp.float32))
    f = jnp.maximum(f, 1e-30)
    return _heads(1.0 - f), _heads(jnp.log(f))


def _hgrn_scan(q, k, v, logf, s0):
    b, h, n, _ = q.shape
    nc = n // CHUNK_B

    def to_chunks(t):
        return jnp.moveaxis(t.reshape(b, h, nc, CHUNK_B, t.shape[-1]), 2, 0)

    tri = jnp.tril(jnp.ones((CHUNK_B, CHUNK_B), dtype=bool))[:, :, None]

    def step(S, inp):
        qc, kc, vc, gc = inp
        cum = jnp.cumsum(gc, axis=2)
        inter = jnp.einsum('bhtd,bhde->bhte', qc * jnp.exp(cum), S)
        diff = cum[:, :, :, None, :] - cum[:, :, None, :, :]
        dec = jnp.where(tri, jnp.exp(jnp.where(tri, diff, 0.0)), 0.0)
        scores = jnp.einsum('bhtd,bhsd,bhtsd->bhts', qc, kc, dec)
        intra = jnp.einsum('bhts,bhse->bhte', scores, vc)
        last = cum[:, :, -1:, :]
        S_new = jnp.exp(last[:, :, 0, :])[..., None] * S + jnp.einsum('bhsd,bhse->bhde', kc * jnp.exp(last - cum), vc)
        return S_new, inter + intra

    s_fin, o = lax.scan(step, s0, (to_chunks(q), to_chunks(k), to_chunks(v), to_chunks(logf)))
    o = jnp.moveaxis(o, 0, 2).reshape(b, h, n, -1)
    return o, s_fin


def _final_state(k, v, logf):
    cum = jnp.cumsum(logf, axis=2)
    return jnp.einsum('bhsd,bhse->bhde', k * jnp.exp(cum[:, :, -1:, :] - cum), v)


def _readout(o, g_gate, gain):
    b, h, n, dv = o.shape
    o = jnp.transpose(o, (0, 2, 1, 3))
    o = o * lax.rsqrt(jnp.mean(o * o, axis=-1, keepdims=True) + EPS)
    o = o.reshape(b, n, h * dv) * gain.astype(jnp.float32)
    return o.astype(g_gate.dtype) * jax.nn.silu(g_gate)


def _merge(y_a, y_b, ga, gb, w_up_a, w_up_b, w_out):
    m = jax.nn.sigmoid(ga) * (y_a @ w_up_a) + jax.nn.sigmoid(gb) * (y_b @ w_up_b)
    return m @ w_out


def _mixer(h, hc, n_chunks, w_in, chunk_g, w_s, b_s, lb_f, lb_b, hgrn_g, w_up_a, w_up_b, w_out, need_ctx):
    b = h.shape[0]
    flip = lambda t: jnp.flip(t, axis=2)
    u, v, q, f_f, f_b, i, g, ga, gb = _split_cols(h @ w_in)
    if need_ctx:
        uc, vc, qc, f_fc, f_bc, ic, gc, gac, gbc = _split_cols(hc @ w_in)
    else:
        f_fc, f_bc, ic = jnp.split(hc @ w_in[:, OFF_F:OFF_G], 3, axis=-1)
    k_fc, lf_c = _decay(f_fc, lb_f)
    k_bc, lbw_c = _decay(f_bc, lb_b)
    v_c = _heads(ic)
    if need_ctx:
        q_c = _heads(qc)
        s0 = jnp.zeros((b, HEADS_B, HEAD_DK, HEAD_DV), jnp.float32)
        o_cf, s_cf = _hgrn_scan(q_c, k_fc, v_c, lf_c, s0)
        o_cb, s_cb = _hgrn_scan(flip(q_c), flip(k_bc), flip(v_c), flip(lbw_c), s0)
        y_bc = _readout(o_cf + flip(o_cb), gc, hgrn_g)
        y_ac = _chunk_mlp(jax.nn.gelu(uc), jax.nn.gelu(vc), hc.shape[1] // CHUNK_A, chunk_g, w_s, b_s)
        out_c = _merge(y_ac, y_bc, gac, gbc, w_up_a, w_up_b, w_out)
    else:
        s_cf = _final_state(k_fc, v_c, lf_c)
        s_cb = _final_state(flip(k_bc), flip(v_c), flip(lbw_c))
        out_c = None
    q_l = _heads(q)
    v_l = _heads(i)
    k_f, lf = _decay(f_f, lb_f)
    k_b, lbw = _decay(f_b, lb_b)
    o_f, _ = _hgrn_scan(q_l, k_f, v_l, lf, s_cf)
    o_b, _ = _hgrn_scan(flip(q_l), flip(k_b), flip(v_l), flip(lbw), s_cb)
    y_b = _readout(o_f + flip(o_b), g, hgrn_g)
    y_a = _chunk_mlp(jax.nn.gelu(u), jax.nn.gelu(v), n_chunks, chunk_g, w_s, b_s)
    out = _merge(y_a, y_b, ga, gb, w_up_a, w_up_b, w_out)
    return out, out_c


def setup_inputs(seed: int = 0) -> dict:
    key = jax.random.key(seed)
    ks = jax.random.split(key, 20)
    D = D_MODEL

    def nrm(k, shape, fan_in):
        return jax.random.normal(k, shape, jnp.float32) * (fan_in ** -0.5)

    def near_one(k, shape, s):
        return 1.0 + s * jax.random.normal(k, shape, jnp.float32)

    return {
        'x': jax.random.normal(ks[0], (BATCH, SEQ, D), jnp.float32),
        'c': jax.random.normal(ks[1], (BATCH, D), jnp.float32),
        'ctx': jax.random.normal(ks[2], (BATCH, CTX_LEN, D), jnp.float32),
        'c_ctx': jax.random.normal(ks[3], (D,), jnp.float32),
        'w_mod': nrm(ks[4], (DEPTH, D, N_MOD * D), D),
        'b_mod': 0.01 * jax.random.normal(ks[5], (DEPTH, N_MOD * D), jnp.float32),
        'norm_g': near_one(ks[6], (DEPTH, N_NORM, D), 0.05),
        'ffn1_w_gu': nrm(ks[7], (DEPTH, D, 2 * D_FF), D),
        'ffn1_w_down': nrm(ks[8], (DEPTH, D_FF, D), D_FF),
        'ffn2_w_gu': nrm(ks[9], (DEPTH, D, 2 * D_FF), D),
        'ffn2_w_down': nrm(ks[10], (DEPTH, D_FF, D), D_FF),
        'w_in': nrm(ks[11], (DEPTH, D, IN_COLS), D),
        'chunk_norm_g': near_one(ks[12], (DEPTH, D_A), 0.05),
        'w_spatial': nrm(ks[13], (DEPTH, GROUPS_A, CHUNK_A, CHUNK_A), CHUNK_A),
        'b_spatial': near_one(ks[14], (DEPTH, GROUPS_A, CHUNK_A), 0.02),
        'lb_logits': jax.random.normal(ks[15], (DEPTH, 2, D_B), jnp.float32),
        'hgrn_norm_g': near_one(ks[16], (DEPTH, D_B), 0.05),
        'w_up_a': nrm(ks[17], (DEPTH, D_A, D), D_A),
        'w_up_b': nrm(ks[18], (DEPTH, D_B, D), D_B),
        'w_out': nrm(ks[19], (DEPTH, D, D), D),
    }


def reference(x, c, ctx, c_ctx, w_mod, b_mod, norm_g, ffn1_w_gu, ffn1_w_down, ffn2_w_gu, ffn2_w_down,
              w_in, chunk_norm_g, w_spatial, b_spatial, lb_logits, hgrn_norm_g, w_up_a, w_up_b, w_out):
    n = x.shape[1]
    rows = n // GRID_W
    n_chunks = rows // (CHUNK_A // GRID_W)
    lb_all = jnp.cumsum(jax.nn.softmax(lb_logits.astype(jnp.float32), axis=0), axis=0)
    lb_all = lb_all - lb_all[0:1]
    sc = jax.nn.silu(c)
    scc = jax.nn.silu(c_ctx)
    xc = ctx
    for l in range(DEPTH):
        last = l == DEPTH - 1
        mod = (sc @ w_mod[l] + b_mod[l]).reshape(x.shape[0], 1, N_MOD, D_MODEL)
        modc = (scc @ w_mod[l] + b_mod[l]).reshape(1, 1, N_MOD, D_MODEL)
        g = norm_g[l]
        h = _modulate(x, g[0], mod[:, :, 0], mod[:, :, 1])
        x = _residual(x, _swiglu(h, ffn1_w_gu[l], ffn1_w_down[l]), g[1], mod[:, :, 2], MACARON)
        hc = _modulate(xc, g[0], modc[:, :, 0], modc[:, :, 1])
        xc = _residual(xc, _swiglu(hc, ffn1_w_gu[l], ffn1_w_down[l]), g[1], modc[:, :, 2], MACARON)
        h = _modulate(x, g[2], mod[:, :, 3], mod[:, :, 4])
        hc = _modulate(xc, g[2], modc[:, :, 3], modc[:, :, 4])
        y, yc = _mixer(h, hc, n_chunks, w_in[l], chunk_norm_g[l], w_spatial[l], b_spatial[l],
                       lb_all[l, 0], lb_all[l, 1], hgrn_norm_g[l], w_up_a[l], w_up_b[l], w_out[l],
                       not last)
        x = _residual(x, y, g[3], mod[:, :, 5], 1.0)
        h = _modulate(x, g[4], mod[:, :, 6], mod[:, :, 7])
        x = _residual(x, _swiglu(h, ffn2_w_gu[l], ffn2_w_down[l]), g[5], mod[:, :, 8], MACARON)
        if not last:
            xc = _residual(xc, yc, g[3], modc[:, :, 5], 1.0)
            hc = _modulate(xc, g[4], modc[:, :, 6], modc[:, :, 7])
            xc = _residual(xc, _swiglu(hc, ffn2_w_gu[l], ffn2_w_down[l]), g[5], modc[:, :, 8], MACARON)
    return x
```

```cpp
#include <hip/hip_runtime.h>
#include <cstdio>
#include <cstdint>

#ifndef MK_PER_PHASE
#define MK_PER_PHASE 0
#endif

namespace pg8 {
#define PG8_LAS __attribute__((address_space(3)))
typedef unsigned short bf16_t;
typedef short bf16x8 __attribute__((ext_vector_type(8)));
typedef float f32x4 __attribute__((ext_vector_type(4)));
typedef unsigned u32x4 __attribute__((ext_vector_type(4)));
constexpr int BM = 256, BK = 64, HALF = 128, HTB = HALF * BK * 2, STAGE_BYTES = 8 * HTB, NXCD = 8, WGM = 8;

__host__ __device__ __forceinline__ int lds_byte(int r, int c) { const int st = (r >> 4) * 2 + (c >> 5), rr = r & 15, cc = c & 31, ob = rr * 64 + cc * 2; return st * 1024 + (ob ^ (((ob >> 9) & 1) << 5)); }
__host__ __device__ __forceinline__ void stage_rc(int b, int& R, int& C) { const int st = b / 1024, sb = b % 1024, swz = sb ^ (((sb >> 9) & 1) << 5); R = (st >> 1) * 16 + swz / 64; C = (st & 1) * 32 + (swz % 64) / 2; }
__host__ __device__ __forceinline__ int perm32(int rho) { const int n = rho >> 4, i = rho & 15; return 8 * (i >> 2) + 4 * n + (i & 3); }

struct Unit { int pm, pn; };
struct Gemm { const bf16_t* A; const bf16_t* Bt; int K, lda, ldb; };

struct RectOrder {
    int pma, nma, pna, nna, pmb, nmb, pnb, nnb, G, c;
    __device__ __forceinline__ bool map(int wgid, int nM, int nN, int pm0, int pn0, Unit& u) const {
        const int nwg = nM * nN;
        { const int q = nwg / NXCD, r = nwg % NXCD, xcd = wgid % NXCD, off = wgid / NXCD; wgid = (xcd < r ? xcd * (q + 1) : r * (q + 1) + (xcd - r) * q) + off; }
        const int nig = WGM * nN, gid = wgid / nig, fm = gid * WGM, gsz = (nM - fm) < WGM ? (nM - fm) : WGM;
        u.pm = pm0 + fm + ((wgid % nig) % gsz); u.pn = pn0 + (wgid % nig) / gsz; return true;
    }
    __device__ __forceinline__ bool next(int i, Unit& u) const {
        long L = (long)i * G + c; const int na = nma * nna;
        if (L < na) return map((int)L, nma, nna, pma, pna, u);
        L -= na; if (L < (long)nmb * nnb) return map((int)L, nmb, nnb, pmb, pnb, u);
        return false;
    }
    __device__ __forceinline__ void a_ready(const Unit&) const {}
    __device__ __forceinline__ void done(const Unit&) const {}
};

__device__ __forceinline__ unsigned cvt_pk_bf16(float lo, float hi) { unsigned r; asm volatile("v_cvt_pk_bf16_f32 %0, %1, %2" : "=v"(r) : "v"(lo), "v"(hi)); return r; }

template <class Epi, class Sched, bool ALIGN_EPI = false, bool SP2 = false>
__device__ __forceinline__ void gemm_phase(PG8_LAS unsigned char* lds, const Gemm g, const Sched& S, const Epi& E) {
    int tid_ = threadIdx.x; asm volatile("" : "+v"(tid_));
    const int tid = tid_, wid = __builtin_amdgcn_readfirstlane(tid >> 6), lane = tid & 63, wr = wid >> 2, wc = wid & 3, fr = lane & 15, fq = lane >> 4;
    const int K = g.K, nt = K / BK;
    unsigned voffA[2], voffB[2];
#pragma unroll
    for (int i = 0; i < 2; ++i) { int R, C; stage_rc(tid * 16 + i * 8192, R, C); const int Rb = Epi::PERM ? ((R & ~31) + perm32(R & 31)) : R;
        voffA[i] = (unsigned)(R * g.lda + C) * 2u; voffB[i] = (unsigned)(Rb * g.ldb + C) * 2u; }
    const size_t kstep = (size_t)(BK * 2);
    const size_t hstepA = (size_t)HALF * g.lda * 2, hstepB = (size_t)HALF * g.ldb * 2;
    const size_t tstepA = 2 * hstepA, tstepB = 2 * hstepB;
    const unsigned ldsw = (unsigned)wid * 1024u;
    const int aoff = lds_byte(wr * 64 + fr, fq * 8), boff = lds_byte(wc * 32 + fr, fq * 8);
#define PG8_SA(b, h) (((b) * 2 + (h)) * HTB)
#define PG8_SB(b, h) ((4 + (b) * 2 + (h)) * HTB)
#define PG8_STAGE(bufoff, gbase, voff) do { _Pragma("unroll") for (int _i = 0; _i < 2; ++_i) \
        __builtin_amdgcn_global_load_lds((const unsigned*)((const char*)(gbase) + (voff)[_i]), (PG8_LAS unsigned*)(lds + (bufoff) + ldsw + _i * 8192), 16, 0, 0); } while (0)
#define PG8_LDA(dst, b, h) do { _Pragma("unroll") for (int m = 0; m < 4; ++m) _Pragma("unroll") for (int k = 0; k < 2; ++k) dst[m][k] = *(const PG8_LAS bf16x8*)(lds + PG8_SA(b, h) + aoff + m * 2048 + k * 1024); } while (0)
#define PG8_LDB(dst, b, h) do { _Pragma("unroll") for (int n = 0; n < 2; ++n) _Pragma("unroll") for (int k = 0; k < 2; ++k) dst[n][k] = *(const PG8_LAS bf16x8*)(lds + PG8_SB(b, h) + boff + n * 2048 + k * 1024); } while (0)
#define PG8_MMA(ai, bj, At, Bt) do { __builtin_amdgcn_s_setprio(1); _Pragma("unroll") for (int m = 0; m < 4; ++m) _Pragma("unroll") for (int n = 0; n < 2; ++n) _Pragma("unroll") for (int k = 0; k < 2; ++k) \
        acc[ai][bj][m][n] = __builtin_amdgcn_mfma_f32_16x16x32_bf16(Bt[n][k], At[m][k], acc[ai][bj][m][n], 0, 0, 0); __builtin_amdgcn_s_setprio(0); } while (0)
#define PG8_WAIT_V(n) asm volatile("s_waitcnt vmcnt(" #n ")" ::: "memory")
#define PG8_WAIT_L(n) asm volatile("s_waitcnt lgkmcnt(" #n ")" ::: "memory")
#define PG8_BAR __builtin_amdgcn_s_barrier()
#define PG8_SCHED __builtin_amdgcn_sched_barrier(0)
    Unit cur, nxt; int ui = 0;
    if (!S.next(0, cur)) return;
    f32x4 acc[2][2][4][2];
#pragma unroll
    for (int a = 0; a < 2; ++a)
#pragma unroll
        for (int b = 0; b < 2; ++b)
#pragma unroll
            for (int m = 0; m < 4; ++m)
#pragma unroll
                for (int n = 0; n < 2; ++n) acc[a][b][m][n] = (f32x4){0.f, 0.f, 0.f, 0.f};
    bf16x8 At[4][2], B0[2][2], B1[2][2];
    const char* cA = (const char*)g.A + (size_t)cur.pm * tstepA; const char* cB = (const char*)g.Bt + (size_t)cur.pn * tstepB;
    S.a_ready(cur);
    if constexpr (SP2) {
        PG8_STAGE(PG8_SB(0, 0), cB, voffB); PG8_STAGE(PG8_SB(0, 1), cB + hstepB, voffB); PG8_STAGE(PG8_SA(0, 0), cA, voffA); PG8_STAGE(PG8_SA(0, 1), cA + hstepA, voffA);
        if (wr == 1) PG8_BAR;
        PG8_WAIT_V(2); PG8_BAR;
        PG8_STAGE(PG8_SB(1, 0), cB + kstep, voffB); PG8_STAGE(PG8_SA(1, 0), cA + kstep, voffA); PG8_STAGE(PG8_SB(1, 1), cB + hstepB + kstep, voffB);
        PG8_WAIT_V(6); PG8_BAR;
    } else {
        PG8_STAGE(PG8_SB(0, 0), cB, voffB); PG8_STAGE(PG8_SA(0, 0), cA, voffA); PG8_STAGE(PG8_SB(0, 1), cB + hstepB, voffB); PG8_STAGE(PG8_SA(0, 1), cA + hstepA, voffA);
        if (wr == 1) PG8_BAR;
        PG8_WAIT_V(4); PG8_BAR;
        PG8_STAGE(PG8_SB(1, 0), cB + kstep, voffB); PG8_STAGE(PG8_SA(1, 0), cA + kstep, voffA); PG8_STAGE(PG8_SB(1, 1), cB + hstepB + kstep, voffB);
        PG8_WAIT_V(6); PG8_BAR;
    }
    for (;;) {
        const bool has_next = S.next(ui + 1, nxt);
        const char* nA = has_next ? (const char*)g.A + (size_t)nxt.pm * tstepA : cA; const char* nB = has_next ? (const char*)g.Bt + (size_t)nxt.pn * tstepB : cB;
        for (int t = 0; t < nt; t += 2) {
            const bool last = (t == nt - 2);
            const char* a1 = cA + (size_t)(t + 1) * kstep;
            const char* a2 = last ? nA : cA + (size_t)(t + 2) * kstep; const char* b2 = last ? nB : cB + (size_t)(t + 2) * kstep;
            const char* a3 = a2 + kstep; const char* b3 = b2 + kstep;
            if (last && has_next) S.a_ready(nxt);
            if constexpr (SP2) {
            PG8_LDB(B0, 0, 0); PG8_LDB(B1, 0, 1); PG8_SCHED; PG8_LDA(At, 0, 0); PG8_STAGE(PG8_SA(1, 1), a1 + hstepA, voffA);
            PG8_WAIT_V(8); PG8_WAIT_L(0); PG8_BAR; PG8_MMA(0, 0, At, B0); PG8_MMA(0, 1, At, B1); PG8_BAR; PG8_SCHED;
            PG8_LDA(At, 0, 1); PG8_STAGE(PG8_SB(0, 0), b2, voffB); PG8_STAGE(PG8_SB(0, 1), b2 + hstepB, voffB); PG8_STAGE(PG8_SA(0, 0), a2, voffA);
            PG8_WAIT_V(8); PG8_WAIT_L(0); PG8_BAR; PG8_MMA(1, 0, At, B0); PG8_MMA(1, 1, At, B1); PG8_BAR; PG8_SCHED;
            PG8_LDB(B0, 1, 0); PG8_LDB(B1, 1, 1); PG8_SCHED; PG8_LDA(At, 1, 0); PG8_STAGE(PG8_SA(0, 1), a2 + hstepA, voffA);
            PG8_WAIT_V(8); PG8_WAIT_L(0); PG8_BAR; PG8_MMA(0, 0, At, B0); PG8_MMA(0, 1, At, B1); PG8_BAR; PG8_SCHED;
            PG8_LDA(At, 1, 1); PG8_STAGE(PG8_SB(1, 0), b3, voffB); PG8_STAGE(PG8_SB(1, 1), b3 + hstepB, voffB); PG8_STAGE(PG8_SA(1, 0), a3, voffA);
            PG8_WAIT_V(8); PG8_WAIT_L(0); PG8_BAR; PG8_MMA(1, 0, At, B0); PG8_MMA(1, 1, At, B1); PG8_BAR; PG8_SCHED;
            } else {
            PG8_LDB(B0, 0, 0); PG8_SCHED; PG8_LDA(At, 0, 0); PG8_STAGE(PG8_SA(1, 1), a1 + hstepA, voffA);
            PG8_WAIT_L(8); PG8_BAR; PG8_WAIT_L(0); PG8_MMA(0, 0, At, B0); PG8_BAR; PG8_SCHED;
            PG8_LDB(B1, 0, 1); PG8_STAGE(PG8_SB(0, 0), b2, voffB);
            PG8_BAR; PG8_WAIT_L(0); PG8_MMA(0, 1, At, B1); PG8_BAR;
            PG8_LDA(At, 0, 1); PG8_STAGE(PG8_SA(0, 0), a2, voffA);
            PG8_BAR; PG8_WAIT_L(0); PG8_MMA(1, 0, At, B0); PG8_BAR; PG8_SCHED;
            PG8_STAGE(PG8_SB(0, 1), b2 + hstepB, voffB);
            PG8_WAIT_V(6); PG8_BAR; PG8_MMA(1, 1, At, B1); PG8_BAR;
            PG8_LDB(B0, 1, 0); PG8_SCHED; PG8_LDA(At, 1, 0); PG8_STAGE(PG8_SA(0, 1), a2 + hstepA, voffA);
            PG8_WAIT_L(8); PG8_BAR; PG8_WAIT_L(0); PG8_MMA(0, 0, At, B0); PG8_BAR; PG8_SCHED;
            PG8_LDB(B1, 1, 1); PG8_STAGE(PG8_SB(1, 0), b3, voffB);
            PG8_BAR; PG8_WAIT_L(0); PG8_MMA(0, 1, At, B1); PG8_BAR;
            PG8_LDA(At, 1, 1); PG8_STAGE(PG8_SA(1, 0), a3, voffA);
            PG8_BAR; PG8_WAIT_L(0); PG8_MMA(1, 0, At, B0); PG8_BAR; PG8_SCHED;
            PG8_STAGE(PG8_SB(1, 1), b3 + hstepB, voffB);
            PG8_WAIT_V(6); PG8_BAR; PG8_MMA(1, 1, At, B1); PG8_BAR;
            }
        }
        if constexpr (ALIGN_EPI) { if (wr == 0) PG8_BAR; }
        E(acc, cur, wr, wc, fr, fq); S.done(cur);
        if (!has_next) break;
#pragma unroll
        for (int a = 0; a < 2; ++a)
#pragma unroll
            for (int b = 0; b < 2; ++b)
#pragma unroll
                for (int m = 0; m < 4; ++m)
#pragma unroll
                    for (int n = 0; n < 2; ++n) acc[a][b][m][n] = (f32x4){0.f, 0.f, 0.f, 0.f};
        cur = nxt; cA = nA; cB = nB; ++ui;
        if constexpr (ALIGN_EPI) { if (wr == 1) PG8_BAR; }
    }
    PG8_WAIT_V(0);
    if constexpr (!ALIGN_EPI) { if (wr == 0) PG8_BAR; }
    PG8_BAR;
#undef PG8_SA
#undef PG8_SB
#undef PG8_STAGE
#undef PG8_LDA
#undef PG8_LDB
#undef PG8_MMA
#undef PG8_WAIT_V
#undef PG8_WAIT_L
#undef PG8_BAR
#undef PG8_SCHED
}
}

constexpr int NWAVES = 8;
constexpr int DM = 2048, BATCH = 4, SEQ = 2048, DEPTH = 2, CTXL = 256, DFF = 5632, DA = 1024, DBB = 1024, NHEAD = 8, HDIM = 128, NMOD = 9, NNORM = 6;
constexpr int INC = 2 * DA + 5 * DBB + 2 * DM;
constexpr int TX = BATCH * SEQ, TC = BATCH * CTXL, TT = TX + TC;
constexpr int NGRP = 5;
constexpr float EPS = 1e-6f;

constexpr size_t MiB = 1u << 20;
constexpr size_t WS_CTL = 0, WS_MOD = 1 * MiB, ZERO_BYTES = 2 * MiB;
constexpr size_t WS_LBT = 2 * MiB;
constexpr size_t WS_W = 4 * MiB, W_LAYER = 192 * MiB;
constexpr size_t WO_GU1 = 0, WO_D1 = 44 * MiB, WO_IN = 66 * MiB, WO_UP = 110 * MiB, WO_OUT = 118 * MiB, WO_GU2 = 126 * MiB, WO_D2 = 170 * MiB;
constexpr size_t WS_X = 388 * MiB;
constexpr size_t WS_H = 460 * MiB;
constexpr size_t WS_Y = 496 * MiB;
constexpr size_t WS_R = 568 * MiB;
constexpr size_t WS_ACT = WS_R;
constexpr size_t WS_U = WS_R, WS_V = WS_R + 18 * MiB, WS_Q = WS_R + 36 * MiB, WS_KF = WS_R + 54 * MiB, WS_KB = WS_R + 72 * MiB, WS_VI = WS_R + 90 * MiB;
constexpr size_t WS_LF = WS_R + 108 * MiB, WS_LB = WS_R + 144 * MiB;
constexpr size_t WS_M1 = WS_R, WS_MB = WS_R + 72 * MiB;
constexpr size_t WS_SG = WS_R + 180 * MiB;
constexpr size_t WS_SA = WS_R + 198 * MiB, WS_SB = WS_R + 234 * MiB;
constexpr size_t WS_OF = WS_R + 270 * MiB, WS_OB = WS_R + 306 * MiB;
constexpr size_t WS_YAB = WS_R + 342 * MiB;
constexpr size_t WS_END = WS_R + 378 * MiB;
constexpr int CW_TMO = 0, CW_BAR = 4096;

constexpr int RING_OFF = 0, RING_BYTES = 131072;
constexpr int LDSCTL_OFF = RING_BYTES, MISC_OFF = LDSCTL_OFF + 320;
constexpr int LDS_BYTES = 147456;

#define GAS __attribute__((address_space(1)))
#define LAS __attribute__((address_space(3)))
typedef unsigned short bf16;
typedef unsigned v4u __attribute__((ext_vector_type(4)));
typedef unsigned v2u __attribute__((ext_vector_type(2)));
typedef float f32x4 __attribute__((ext_vector_type(4)));
typedef short bf16x8 __attribute__((ext_vector_type(8)));
typedef GAS unsigned gu32;
#define RLX_AGENT __ATOMIC_RELAXED, __HIP_MEMORY_SCOPE_AGENT
#define LDS_WAIT() asm volatile("s_waitcnt lgkmcnt(0)" ::: "memory")
#define VM_WAIT() asm volatile("s_waitcnt vmcnt(0)" ::: "memory")
__device__ __forceinline__ unsigned pk2(float lo, float hi) { return pg8::cvt_pk_bf16(lo, hi); }
__device__ __forceinline__ float bflo(unsigned w) { return __uint_as_float(w << 16); }
__device__ __forceinline__ float bfhi(unsigned w) { return __uint_as_float(w & 0xffff0000u); }
__device__ __forceinline__ float bf2f(unsigned short b) { return __uint_as_float(((unsigned)b) << 16); }
__device__ __forceinline__ float fsigmoid(float x) { return __builtin_amdgcn_rcpf(1.0f + __expf(-x)); }
__device__ __forceinline__ float fsilu(float x) { return x * fsigmoid(x); }
__device__ __forceinline__ float fgelu_tanh(float x) { return x * fsigmoid(1.5957691216057308f * (x + 0.044715f * x * x * x)); }
__device__ __forceinline__ float wave_sum(float v) {
#pragma unroll
    for (int o = 1; o < 64; o <<= 1) v += __shfl_xor(v, o);
    return v;
}

#define XB_TMO      128
#define XB_XCNT(j)  (256  + 64 * (j))
#define XB_XSUB(j)  (1280 + 64 * (j))
#define XB_XGEN(j)  (2304 + 64 * (j))
#define XB_TOP      3328
#define XB_TOPGEN   3392
#define XCD_BAR_WORDS 3456
#define XB_SPIN_CAP (1u << 18)

__device__ __forceinline__ unsigned xb_ld(unsigned* p)              { return __hip_atomic_load(p, __ATOMIC_RELAXED, __HIP_MEMORY_SCOPE_AGENT); }
__device__ __forceinline__ unsigned xb_add(unsigned* p, unsigned v) { return __hip_atomic_fetch_add(p, v, __ATOMIC_RELAXED, __HIP_MEMORY_SCOPE_AGENT); }
__device__ __forceinline__ unsigned xb_xcc_id() { return (unsigned)__builtin_amdgcn_s_getreg((3 << 11) | 20) & 0xFu; }
#define XB_SPIN(cond, bar) do { unsigned _sp = 0; while (cond) { __builtin_amdgcn_s_sleep(1); \
    if ((++_sp & 255u) == 0u) { if (xb_ld(&(bar)[XB_TMO])) break; if (_sp > XB_SPIN_CAP) { atomicAdd(&(bar)[XB_TMO], 1u); break; } } } } while (0)

struct XcdBarrier {
    unsigned* bar; unsigned x;
    volatile LAS unsigned* st;
};
__device__ __forceinline__ XcdBarrier xcd_barrier_post(unsigned* bar, volatile LAS unsigned* st) {
    XcdBarrier b; b.bar = bar; b.x = xb_xcc_id(); b.st = st;
    if (threadIdx.x == 0) (void)xb_add(&bar[XB_XCNT(b.x)], 1u);
    return b;
}
__device__ __forceinline__ void xcd_barrier_complete(unsigned* bar, unsigned x, unsigned& nloc, unsigned& nx) {
    const unsigned G = gridDim.x * gridDim.y * gridDim.z;
    unsigned sum, cnt, mine, sp = 0u;
    for (;;) {
        sum = 0u; cnt = 0u; mine = 0u;
#pragma unroll
        for (unsigned j = 0; j < 16; ++j) { const unsigned c = xb_ld(&bar[XB_XCNT(j)]); sum += c; cnt += (c > 0u) ? 1u : 0u; mine = (j == x) ? c : mine; }
        if (sum == G) break;
        __builtin_amdgcn_s_sleep(1);
        if ((++sp & 255u) == 0u) { if (xb_ld(&bar[XB_TMO])) break; if (sp > XB_SPIN_CAP) { atomicAdd(&bar[XB_TMO], 1u); break; } }
    }
    nloc = mine > 0u ? mine : 1u; nx = cnt > 0u ? cnt : 1u;
}
__device__ __forceinline__ void xcd_barrier(const XcdBarrier& b) {
    asm volatile("s_waitcnt vmcnt(0)" ::: "memory");
    __syncthreads();
    if (threadIdx.x == 0) {
        unsigned* bar = b.bar;
        __builtin_amdgcn_s_waitcnt(0);
        unsigned nloc = b.st[0], nx = b.st[1];
        if (nloc == 0u) { xcd_barrier_complete(bar, b.x, nloc, nx); b.st[0] = nloc; b.st[1] = nx; }
        const unsigned old = xb_add(&bar[XB_XSUB(b.x)], 1u);
        const unsigned gen = old / nloc;
        if (old + 1u == (gen + 1u) * nloc) {
            __builtin_amdgcn_fence(__ATOMIC_RELEASE, "agent");
            asm volatile("s_waitcnt vmcnt(0)" ::: "memory");
            const unsigned og = xb_add(&bar[XB_TOP], 1u);
            const unsigned tg = og / nx;
            if (og + 1u == (tg + 1u) * nx) xb_add(&bar[XB_TOPGEN], 1u);
            else XB_SPIN(xb_ld(&bar[XB_TOPGEN]) == tg, bar);
            __builtin_amdgcn_fence(__ATOMIC_ACQUIRE, "agent");
            xb_add(&bar[XB_XGEN(b.x)], 1u);
            asm volatile("s_waitcnt vmcnt(0)" ::: "memory");
        } else {
            XB_SPIN(xb_ld(&bar[XB_XGEN(b.x)]) == gen, bar);
            __builtin_amdgcn_fence(__ATOMIC_ACQUIRE, "agent");
            asm volatile("s_waitcnt vmcnt(0)" ::: "memory");
        }
    }
    __syncthreads();
}

using pg8::Unit;
__device__ __forceinline__ v4u pack8(const f32x4 a, const f32x4 b) { v4u w; w.x = pk2(a[0], a[1]); w.y = pk2(a[2], a[3]); w.z = pk2(b[0], b[1]); w.w = pk2(b[2], b[3]); return w; }

struct EpiGU {
    static constexpr bool PERM = true;
    bf16* O;
    __device__ __forceinline__ void operator()(const f32x4 (&acc)[2][2][4][2], const Unit& u, int wr, int wc, int fr, int fq) const {
        const int row0 = u.pm * 256 + wr * 64 + fr, col0 = u.pn * 128 + wc * 32 + 8 * fq;
#pragma unroll
        for (int ai = 0; ai < 2; ++ai)
#pragma unroll
            for (int m = 0; m < 4; ++m) {
                f32x4 v0, v1;
#pragma unroll
                for (int j = 0; j < 4; ++j) { v0[j] = fsilu(acc[ai][0][m][0][j]) * acc[ai][1][m][0][j]; v1[j] = fsilu(acc[ai][0][m][1][j]) * acc[ai][1][m][1][j]; }
                *(v4u*)(O + (size_t)(row0 + ai * 128 + m * 16) * DFF + col0) = pack8(v0, v1);
            }
    }
};
struct EpiF32 {
    static constexpr bool PERM = false;
    float* C; int ldc;
    __device__ __forceinline__ void operator()(const f32x4 (&acc)[2][2][4][2], const Unit& u, int wr, int wc, int fr, int fq) const {
        const int row0 = u.pm * 256 + wr * 64 + fr, col0 = u.pn * 256 + wc * 32 + 4 * fq;
#pragma unroll
        for (int ai = 0; ai < 2; ++ai)
#pragma unroll
            for (int m = 0; m < 4; ++m) { float* rowp = C + (size_t)(row0 + ai * 128 + m * 16) * ldc + col0;
#pragma unroll
                for (int bj = 0; bj < 2; ++bj)
#pragma unroll
                    for (int n = 0; n < 2; ++n) *(f32x4*)(rowp + bj * 128 + n * 16) = acc[ai][bj][m][n]; }
    }
};
struct EpiIN {
    static constexpr bool PERM = true;
    bf16 *U, *V, *Q, *KF, *KB, *VI, *SG, *SA, *SB; float *LF, *LB; const float* lbt;
    __device__ __forceinline__ void operator()(const f32x4 (&acc)[2][2][4][2], const Unit& u, int wr, int wc, int fr, int fq) const {
        const int row0 = u.pm * 256 + wr * 64 + fr;
        const int grp = u.pn >> 2;
        const int cbase = u.pn * 256 + wc * 32 + 8 * fq;
        if (grp == 3 || grp == 4) {
            const int dir = grp - 3; bf16* KO = dir ? KB : KF; float* LO = dir ? LB : LF;
#pragma unroll
            for (int bj = 0; bj < 2; ++bj) {
                const int c = cbase + bj * 128 - (3072 + 1024 * dir);
                const f32x4 l0 = *(const f32x4*)(lbt + dir * 1024 + c), l1 = *(const f32x4*)(lbt + dir * 1024 + c + 4);
#pragma unroll
                for (int ai = 0; ai < 2; ++ai)
#pragma unroll
                    for (int m = 0; m < 4; ++m) {
                        const size_t off = (size_t)(row0 + ai * 128 + m * 16) * 1024 + c;
                        f32x4 k0, k1, g0, g1;
#pragma unroll
                        for (int j = 0; j < 4; ++j) {
                            { const float z = fminf(fmaxf(acc[ai][bj][m][0][j], -80.f), 80.f), e = __expf(-z), s = __builtin_amdgcn_rcpf(1.0f + e), lb = l0[j];
                              const float f = fmaxf(lb + (1.0f - lb) * s, 1e-30f); k0[j] = (1.0f - lb) * (e * s); g0[j] = __logf(f); }
                            { const float z = fminf(fmaxf(acc[ai][bj][m][1][j], -80.f), 80.f), e = __expf(-z), s = __builtin_amdgcn_rcpf(1.0f + e), lb = l1[j];
                              const float f = fmaxf(lb + (1.0f - lb) * s, 1e-30f); k1[j] = (1.0f - lb) * (e * s); g1[j] = __logf(f); }
                        }
                        *(v4u*)(KO + off) = pack8(k0, k1);
                        *(f32x4*)(LO + off) = g0; *(f32x4*)(LO + off + 4) = g1;
                    }
            }
            return;
        }
        bf16* O; int ld, csub, fn;
        if (grp == 0) { O = U; ld = 1024; csub = 0; fn = 1; }
        else if (grp == 1) { O = V; ld = 1024; csub = 1024; fn = 1; }
        else if (grp == 2) { O = Q; ld = 1024; csub = 2048; fn = 0; }
        else if (grp == 5) { O = VI; ld = 1024; csub = 5120; fn = 0; }
        else if (grp == 6) { O = SG; ld = 1024; csub = 6144; fn = 2; }
        else if (grp <= 8) { O = SA; ld = 2048; csub = 7168; fn = 3; }
        else { O = SB; ld = 2048; csub = 9216; fn = 3; }
#pragma unroll
        for (int ai = 0; ai < 2; ++ai)
#pragma unroll
            for (int m = 0; m < 4; ++m)
#pragma unroll
                for (int bj = 0; bj < 2; ++bj) {
                    f32x4 v0 = acc[ai][bj][m][0], v1 = acc[ai][bj][m][1];
                    if (fn == 1) {
#pragma unroll
                        for (int j = 0; j < 4; ++j) { v0[j] = fgelu_tanh(v0[j]); v1[j] = fgelu_tanh(v1[j]); } }
                    else if (fn == 2) {
#pragma unroll
                        for (int j = 0; j < 4; ++j) { v0[j] = fsilu(v0[j]); v1[j] = fsilu(v1[j]); } }
                    else if (fn == 3) {
#pragma unroll
                        for (int j = 0; j < 4; ++j) { v0[j] = fsigmoid(v0[j]); v1[j] = fsigmoid(v1[j]); } }
                    *(v4u*)(O + (size_t)(row0 + ai * 128 + m * 16) * ld + (cbase + bj * 128 - csub)) = pack8(v0, v1);
                }
    }
};
template <int SECOND> struct EpiMerge {
    static constexpr bool PERM = true;
    const bf16* SG_; float* M1; bf16* MB;
    __device__ __forceinline__ void operator()(const f32x4 (&acc)[2][2][4][2], const Unit& u, int wr, int wc, int fr, int fq) const {
        const int row0 = u.pm * 256 + wr * 64 + fr, col0 = u.pn * 256 + wc * 32 + 8 * fq;
#pragma unroll
        for (int ai = 0; ai < 2; ++ai)
#pragma unroll
            for (int m = 0; m < 4; ++m)
#pragma unroll
                for (int bj = 0; bj < 2; ++bj) {
                    const size_t off = (size_t)(row0 + ai * 128 + m * 16) * 2048 + col0 + bj * 128;
                    const v4u s = *(const v4u*)(SG_ + off);
                    f32x4 v0 = acc[ai][bj][m][0], v1 = acc[ai][bj][m][1];
                    v0[0] *= bflo(s.x); v0[1] *= bfhi(s.x); v0[2] *= bflo(s.y); v0[3] *= bfhi(s.y);
                    v1[0] *= bflo(s.z); v1[1] *= bfhi(s.z); v1[2] *= bflo(s.w); v1[3] *= bfhi(s.w);
                    if (SECOND) { v0 += *(const f32x4*)(M1 + off); v1 += *(const f32x4*)(M1 + off + 4); *(v4u*)(MB + off) = pack8(v0, v1); }
                    else { *(f32x4*)(M1 + off) = v0; *(f32x4*)(M1 + off + 4) = v1; }
                }
    }
};

struct Args { const float* in[20]; float* out; unsigned char* ws; int ph_lo, ph_hi; };

struct Frame {
    LAS unsigned char* lds;
    int wave, G, bx;
};
__device__ __forceinline__ int opaque_tid() { int t = threadIdx.x; asm volatile("" : "+v"(t)); return t; }
#define FTID (tid__)
#define FLANE (tid__ & 63)
#define TID_DECL() const int tid__ = opaque_tid()
__device__ __forceinline__ unsigned char* opaque_ptr(unsigned char* p) { asm volatile("" : "+s"(p)); return p; }
__device__ __forceinline__ int opaque_int(int i) { asm volatile("" : "+s"(i)); return i; }
#define INP(i) (args.in[opaque_int(i)])

__device__ __forceinline__ void p0_tr_item(const float* W, int ldsrc, int k0, int sc0, bf16* dst, int ldd, int n0, int koff, LAS float* scr, int lane) {
    const int rr = lane >> 3, c4 = (lane & 7) * 4;
#pragma unroll
    for (int i = 0; i < 8; ++i) { const int kk = 8 * i + rr; const f32x4 v = *(const f32x4*)(W + (size_t)(k0 + kk) * ldsrc + sc0 + c4);
        LAS float* s = scr + kk * 33 + c4; s[0] = v[0]; s[1] = v[1]; s[2] = v[2]; s[3] = v[3]; }
    LDS_WAIT(); asm volatile("" ::: "memory");
    const int c = lane & 7;
#pragma unroll
    for (int j = 0; j < 4; ++j) { const int n = (lane >> 3) + 8 * j; const LAS float* s = scr + (8 * c) * 33 + n;
        v4u o; o.x = pk2(s[0 * 33], s[1 * 33]); o.y = pk2(s[2 * 33], s[3 * 33]); o.z = pk2(s[4 * 33], s[5 * 33]); o.w = pk2(s[6 * 33], s[7 * 33]);
        *(v4u*)(dst + (size_t)(n0 + n) * ldd + koff + k0 + 8 * c) = o; }
    LDS_WAIT(); asm volatile("" ::: "memory");
}
__device__ __forceinline__ void p0_tr_mat(const float* W, int K, int N, bf16* dst, int ldd, int koff, bool gu, int r, LAS float* scr, int lane) {
    const int nblk = N / 32, kb = r / nblk, nb = r % nblk;
    int sc0 = 32 * nb;
    if (gu) { const int tile = nb >> 3, within = 32 * (nb & 7); sc0 = (within < 128) ? (128 * tile + within) : (DFF + 128 * tile + within - 128); }
    p0_tr_item(W, N, 64 * kb, sc0, dst, ldd, 32 * nb, koff, scr, lane);
}

__device__ __forceinline__ void p0_prologue(Frame& F, const Args& args) {
    TID_DECL();
    unsigned char* ws = opaque_ptr(args.ws);
    {
        LAS float* scr = (LAS float*)(F.lds + RING_OFF + F.wave * 16384);
        const int gw = F.bx * NWAVES + F.wave, NGW = F.G * NWAVES;
        constexpr int I_GU = (DM / 64) * (2 * DFF / 32), I_D = (DFF / 64) * (DM / 32), I_IN = (DM / 64) * (INC / 32), I_UP = (DA / 64) * (DM / 32), I_OUT = (DM / 64) * (DM / 32);
        constexpr int PER_LAYER = 2 * I_GU + 2 * I_D + I_IN + 2 * I_UP + I_OUT;
        for (int it = gw; it < DEPTH * PER_LAYER; it += NGW) {
            const int l = it / PER_LAYER; int r = it % PER_LAYER;
            unsigned char* wl = ws + WS_W + (size_t)l * W_LAYER;
            if (r < I_GU) { p0_tr_mat(INP(7) + (size_t)l * DM * 2 * DFF, DM, 2 * DFF, (bf16*)(wl + WO_GU1), DM, 0, true, r, scr, FLANE); continue; } r -= I_GU;
            if (r < I_D) { p0_tr_mat(INP(8) + (size_t)l * DFF * DM, DFF, DM, (bf16*)(wl + WO_D1), DFF, 0, false, r, scr, FLANE); continue; } r -= I_D;
            if (r < I_IN) { p0_tr_mat(INP(11) + (size_t)l * DM * INC, DM, INC, (bf16*)(wl + WO_IN), DM, 0, false, r, scr, FLANE); continue; } r -= I_IN;
            if (r < I_UP) { p0_tr_mat(INP(17) + (size_t)l * DA * DM, DA, DM, (bf16*)(wl + WO_UP), 2 * DA, 0, false, r, scr, FLANE); continue; } r -= I_UP;
            if (r < I_UP) { p0_tr_mat(INP(18) + (size_t)l * DBB * DM, DBB, DM, (bf16*)(wl + WO_UP), 2 * DA, DA, false, r, scr, FLANE); continue; } r -= I_UP;
            if (r < I_OUT) { p0_tr_mat(INP(19) + (size_t)l * DM * DM, DM, DM, (bf16*)(wl + WO_OUT), DM, 0, false, r, scr, FLANE); continue; } r -= I_OUT;
            if (r < I_GU) { p0_tr_mat(INP(9) + (size_t)l * DM * 2 * DFF, DM, 2 * DFF, (bf16*)(wl + WO_GU2), DM, 0, true, r, scr, FLANE); continue; } r -= I_GU;
            p0_tr_mat(INP(10) + (size_t)l * DFF * DM, DFF, DM, (bf16*)(wl + WO_D2), DFF, 0, false, r, scr, FLANE);
        }
    }
    __syncthreads();
    {
        float* mod = (float*)(ws + WS_MOD);
        LAS float* sc = (LAS float*)(F.lds + RING_OFF);
        LAS float* red = (LAS float*)(F.lds + RING_OFF + 65536);
        for (int t = FTID; t < NGRP * DM; t += NWAVES * 64) { const int g = t >> 11, kk = t & (DM - 1);
            const float cv = (g < 4) ? INP(1)[g * DM + kk] : INP(3)[kk];
            sc[t] = cv / (1.0f + __expf(-cv)); }
        __syncthreads();
        constexpr int NB = NMOD * DM / 32, NITEM = DEPTH * NB;
        const int cg = FLANE & 7, kr = FLANE >> 3;
        for (int it = F.bx; it < NITEM; it += F.G) {
            const int l = it / NB, nb = it % NB;
            const float* W = INP(4) + (size_t)l * DM * NMOD * DM + (size_t)(F.wave * 256 + kr) * (NMOD * DM) + nb * 32 + 4 * cg;
            f32x4 a[NGRP];
#pragma unroll
            for (int g = 0; g < NGRP; ++g) a[g] = (f32x4){0.f, 0.f, 0.f, 0.f};
#pragma unroll 8
            for (int i = 0; i < 32; ++i) { const f32x4 w = *(const f32x4*)(W + (size_t)(8 * i) * (NMOD * DM));
#pragma unroll
                for (int g = 0; g < NGRP; ++g) { const float sv = sc[g * DM + F.wave * 256 + 8 * i + kr]; a[g] += w * sv; } }
#pragma unroll
            for (int g = 0; g < NGRP; ++g)
#pragma unroll
                for (int c = 0; c < 4; ++c) { float v = a[g][c]; v += __shfl_xor(v, 8); v += __shfl_xor(v, 16); v += __shfl_xor(v, 32); a[g][c] = v; }
            if (kr == 0) {
#pragma unroll
                for (int g = 0; g < NGRP; ++g)
#pragma unroll
                    for (int c = 0; c < 4; ++c) red[(F.wave * 8 + cg) * 20 + g * 4 + c] = a[g][c]; }
            __syncthreads();
            if (FTID < 160) { const int cgi = FTID / 20, v = FTID % 20, g = v >> 2, c = v & 3; float sum = 0.f;
#pragma unroll
                for (int w = 0; w < NWAVES; ++w) sum += red[(w * 8 + cgi) * 20 + v];
                const int n = nb * 32 + 4 * cgi + c;
                mod[(size_t)(l * NGRP + g) * NMOD * DM + n] = sum + INP(5)[(size_t)l * NMOD * DM + n]; }
            __syncthreads();
        }
    }
    if (F.bx == 0) {
        float* lbt = (float*)(ws + WS_LBT);
        for (int idx = FTID; idx < 2 * DBB; idx += NWAVES * 64) {
            float z[DEPTH], mx = -3.0e38f, den = 0.f;
#pragma unroll
            for (int l = 0; l < DEPTH; ++l) { z[l] = INP(15)[l * 2 * DBB + idx]; mx = fmaxf(mx, z[l]); }
#pragma unroll
            for (int l = 0; l < DEPTH; ++l) { z[l] = __expf(z[l] - mx); den += z[l]; }
            float cum = 0.f; const float s0 = z[0] / den;
#pragma unroll
            for (int l = 0; l < DEPTH; ++l) { cum += z[l] / den; lbt[l * 2 * DBB + idx] = (l == 0) ? 0.f : (cum - s0); }
        }
    }
}

__device__ __forceinline__ int row_grp(int row) { return row < TX ? (row >> 11) : 4; }
template <int MODE>
__device__ __forceinline__ void thin_phase(Frame& F, const Args& args, int nrows, const float* Y, const float* gpost, const float* mod_r, int gate_i, float w,
                                           const float* gpre, const float* mod_m, int shift_i, int scale_i) {
    TID_DECL();
    unsigned char* ws = opaque_ptr(args.ws);
    float* X = (float*)(ws + WS_X); bf16* H = (bf16*)(ws + WS_H);
    const int rpw = nrows / F.G, r0 = F.bx * rpw, g0 = row_grp(r0), g1 = row_grp(r0 + rpw - 1);
    LAS float* VA = (LAS float*)(F.lds + RING_OFF);
    LAS float* VB = VA + 2 * DM;
    LAS float* VC = VB + 2 * DM;
    for (int t = FTID; t < 2 * DM; t += NWAVES * 64) { const int gi = t >> 11, n = t & (DM - 1), g = gi ? g1 : g0;
        if (MODE != 0) VA[t] = w * mod_r[(size_t)(g * NMOD + gate_i) * DM + n] * gpost[n];
        if (MODE != 2) { VB[t] = gpre[n] * (1.0f + mod_m[(size_t)(g * NMOD + scale_i) * DM + n]); VC[t] = mod_m[(size_t)(g * NMOD + shift_i) * DM + n]; } }
    __syncthreads();
    for (int rr = F.wave; rr < rpw; rr += NWAVES) {
        const int row = r0 + rr, gi = (row_grp(row) == g0) ? 0 : 1;
        f32x4 x[8];
        if (MODE == 0) {
            const float* src = row < TX ? INP(0) + (size_t)row * DM : INP(2) + (size_t)(row - TX) * DM;
#pragma unroll
            for (int j = 0; j < 8; ++j) x[j] = *(const f32x4*)(src + 4 * FLANE + 256 * j);
        } else {
            f32x4 y[8]; float s = 0.f;
#pragma unroll
            for (int j = 0; j < 8; ++j) { y[j] = *(const f32x4*)(Y + (size_t)row * DM + 4 * FLANE + 256 * j); s += (y[j][0] * y[j][0] + y[j][1] * y[j][1]) + (y[j][2] * y[j][2] + y[j][3] * y[j][3]); }
            const float r = 1.0f / sqrtf(wave_sum(s) * (1.0f / DM) + EPS);
#pragma unroll
            for (int j = 0; j < 8; ++j) { const f32x4 a = *(const LAS f32x4*)(VA + gi * DM + 4 * FLANE + 256 * j); x[j] = *(const f32x4*)(X + (size_t)row * DM + 4 * FLANE + 256 * j) + a * y[j] * r; }
        }
        if (MODE == 2) {
#pragma unroll
            for (int j = 0; j < 8; ++j) *(f32x4*)(args.out + (size_t)row * DM + 4 * FLANE + 256 * j) = x[j];
        } else {
            float s = 0.f;
#pragma unroll
            for (int j = 0; j < 8; ++j) { *(f32x4*)(X + (size_t)row * DM + 4 * FLANE + 256 * j) = x[j]; s += (x[j][0] * x[j][0] + x[j][1] * x[j][1]) + (x[j][2] * x[j][2] + x[j][3] * x[j][3]); }
            const float r = 1.0f / sqrtf(wave_sum(s) * (1.0f / DM) + EPS);
#pragma unroll
            for (int j = 0; j < 8; ++j) { const f32x4 b = *(const LAS f32x4*)(VB + gi * DM + 4 * FLANE + 256 * j), c = *(const LAS f32x4*)(VC + gi * DM + 4 * FLANE + 256 * j);
                const f32x4 h = x[j] * r * b + c; v2u o; o.x = pk2(h[0], h[1]); o.y = pk2(h[2], h[3]);
                *(v2u*)(H + (size_t)row * DM + 4 * FLANE + 256 * j) = o; }
        }
    }
    __syncthreads();
}

__device__ __forceinline__ void readout_phase(Frame& F, const Args& args, int nrows, const float* gain) {
    TID_DECL();
    unsigned char* ws = opaque_ptr(args.ws);
    const float* OF = (const float*)(ws + WS_OF); const float* OB = (const float*)(ws + WS_OB); const bf16* SG = (const bf16*)(ws + WS_SG); bf16* YAB = (bf16*)(ws + WS_YAB);
    const int gw = F.bx * NWAVES + F.wave, NGW = F.G * NWAVES;
    for (int row = gw; row < nrows; row += NGW) {
        const size_t off = (size_t)row * DBB + 16 * FLANE;
        f32x4 o[4]; float s = 0.f;
#pragma unroll
        for (int j = 0; j < 4; ++j) { o[j] = *(const f32x4*)(OF + off + 4 * j) + *(const f32x4*)(OB + off + 4 * j); s += (o[j][0] * o[j][0] + o[j][1] * o[j][1]) + (o[j][2] * o[j][2] + o[j][3] * o[j][3]); }
        s += __shfl_xor(s, 1); s += __shfl_xor(s, 2); s += __shfl_xor(s, 4);
        const float r = 1.0f / sqrtf(s * (1.0f / HDIM) + EPS);
        const v4u g0 = *(const v4u*)(SG + off), g1 = *(const v4u*)(SG + off + 8);
        const unsigned gw_[8] = {g0.x, g0.y, g0.z, g0.w, g1.x, g1.y, g1.z, g1.w};
        unsigned ow[8];
#pragma unroll
        for (int j = 0; j < 4; ++j) { const f32x4 gn = *(const f32x4*)(gain + 16 * FLANE + 4 * j);
            const float a0 = o[j][0] * r * gn[0] * bflo(gw_[2 * j]), a1 = o[j][1] * r * gn[1] * bfhi(gw_[2 * j]), a2 = o[j][2] * r * gn[2] * bflo(gw_[2 * j + 1]), a3 = o[j][3] * r * gn[3] * bfhi(gw_[2 * j + 1]);
            ow[2 * j] = pk2(a0, a1); ow[2 * j + 1] = pk2(a2, a3); }
        bf16* dst = YAB + (size_t)row * (2 * DA) + DA + 16 * FLANE;
        *(v4u*)dst = (v4u){ow[0], ow[1], ow[2], ow[3]}; *(v4u*)(dst + 8) = (v4u){ow[4], ow[5], ow[6], ow[7]};
    }
}

constexpr int GM_VNT = 0, GM_STAT = 128 * 272;
__device__ __forceinline__ void gmlp_unit(Frame& F, const Args& args, int row0, int g, const float* cng, const float* wsp, const float* bsp) {
    TID_DECL();
    unsigned char* ws = opaque_ptr(args.ws);
    const bf16* U = (const bf16*)(ws + WS_U); const bf16* V = (const bf16*)(ws + WS_V); bf16* YAB = (bf16*)(ws + WS_YAB);
    LAS unsigned char* vnT = F.lds + RING_OFF + GM_VNT; LAS float* stat = (LAS float*)(F.lds + RING_OFF + GM_STAT);
    for (int rr = 0; rr < 16; ++rr) {
        const int row = 16 * F.wave + rr; const bf16* vp = V + (size_t)(row0 + row) * DA + 8 * FLANE;
        const v4u a = *(const v4u*)vp, b = *(const v4u*)(vp + 512);
        const unsigned wv[8] = {a.x, a.y, a.z, a.w, b.x, b.y, b.z, b.w}; float s = 0.f, q = 0.f;
#pragma unroll
        for (int j = 0; j < 8; ++j) { const float lo = bflo(wv[j]), hi = bfhi(wv[j]); s += lo + hi; q += lo * lo + hi * hi; }
        s = wave_sum(s); q = wave_sum(q);
        const float mean = s * (1.0f / DA), var = fmaxf(q * (1.0f / DA) - mean * mean, 0.f);
        if (FLANE == 0) { stat[2 * row] = mean; stat[2 * row + 1] = 1.0f / sqrtf(var + EPS); }
    }
    __syncthreads();
    for (int it = FTID; it < 128 * 16; it += NWAVES * 64) {
        const int s = it & 127, dd = it >> 7;
        const v4u a = *(const v4u*)(V + (size_t)(row0 + s) * DA + g * 128 + 8 * dd);
        const float mean = stat[2 * s], rstd = stat[2 * s + 1];
        const f32x4 g0 = *(const f32x4*)(cng + g * 128 + 8 * dd), g1 = *(const f32x4*)(cng + g * 128 + 8 * dd + 4);
        const unsigned wv[4] = {a.x, a.y, a.z, a.w};
#pragma unroll
        for (int j = 0; j < 4; ++j) {
            const float lo = (bflo(wv[j]) - mean) * rstd * (j < 2 ? g0[2 * j] : g1[2 * j - 4]), hi = (bfhi(wv[j]) - mean) * rstd * (j < 2 ? g0[2 * j + 1] : g1[2 * j - 3]);
            const unsigned p = pk2(lo, hi);
            *(LAS unsigned short*)(vnT + (8 * dd + 2 * j) * 272 + 2 * s) = (unsigned short)(p & 0xffffu);
            *(LAS unsigned short*)(vnT + (8 * dd + 2 * j + 1) * 272 + 2 * s) = (unsigned short)(p >> 16);
        }
    }
    __syncthreads();
    const int i = FLANE & 15, gq = FLANE >> 4;
    f32x4 acc[8];
#pragma unroll
    for (int md = 0; md < 8; ++md) acc[md] = (f32x4){0.f, 0.f, 0.f, 0.f};
    const float* wrow = wsp + ((size_t)g * 128 + 16 * F.wave + i) * 128;
#pragma unroll
    for (int kk = 0; kk < 4; ++kk) {
        const f32x4 w0 = *(const f32x4*)(wrow + 32 * kk + 8 * gq), w1 = *(const f32x4*)(wrow + 32 * kk + 8 * gq + 4);
        const v4u wb = pack8(w0, w1); bf16x8 bfrag; __builtin_memcpy(&bfrag, &wb, 16);
#pragma unroll
        for (int md = 0; md < 8; ++md) {
            const bf16x8 afrag = *(const LAS bf16x8*)(vnT + (16 * md + i) * 272 + (32 * kk + 8 * gq) * 2);
            acc[md] = __builtin_amdgcn_mfma_f32_16x16x32_bf16(afrag, bfrag, acc[md], 0, 0, 0);
        }
    }
    const int t = 16 * F.wave + i; const float bias = bsp[g * 128 + t];
#pragma unroll
    for (int md = 0; md < 8; ++md) {
        const size_t col = (size_t)g * 128 + 16 * md + 4 * gq;
        const v2u uu = *(const v2u*)(U + (size_t)(row0 + t) * DA + col);
        v2u o; o.x = pk2(bflo(uu.x) * (acc[md][0] + bias), bfhi(uu.x) * (acc[md][1] + bias)); o.y = pk2(bflo(uu.y) * (acc[md][2] + bias), bfhi(uu.y) * (acc[md][3] + bias));
        *(v2u*)(YAB + (size_t)(row0 + t) * (2 * DA) + col) = o;
    }
    __syncthreads();
}

constexpr int SC_QS = 0, SC_KS = 17408, SC_KET = 34816, SC_VT = 51200, SC_DD = 67584;
__device__ __forceinline__ int scan_row(int b, int dir, int tau) {
    if (tau < CTXL) return TX + CTXL * b + (dir ? (CTXL - 1 - tau) : tau);
    const int t = tau - CTXL; return SEQ * b + (dir ? (SEQ - 1 - t) : t);
}
__device__ __forceinline__ void scan_unit(Frame& F, const Args& args, int b, int h, int dir, bool ctx_out) {
    TID_DECL();
    unsigned char* ws = opaque_ptr(args.ws);
    const bf16* Q = (const bf16*)(ws + WS_Q) + h * HDIM; const bf16* KK = (const bf16*)(ws + (dir ? WS_KB : WS_KF)) + h * HDIM; const bf16* VI = (const bf16*)(ws + WS_VI) + h * HDIM;
    const float* LG = (const float*)(ws + (dir ? WS_LB : WS_LF)) + h * HDIM; float* O = (float*)(ws + (dir ? WS_OB : WS_OF)) + h * HDIM;
    LAS unsigned char* L = F.lds + RING_OFF;
    const int sb1 = FTID >> 7, dcol = FTID & 127;
    const int i = FLANE & 15, gq = FLANE >> 4, eb = 16 * F.wave;
    f32x4 S[8];
#pragma unroll
    for (int tt = 0; tt < 8; ++tt) S[tt] = (f32x4){0.f, 0.f, 0.f, 0.f};
    constexpr int NG = (CTXL + SEQ) / 64;
    float lf[16]; unsigned short qv[16], kv[16], vv[16];
#pragma unroll
    for (int j = 0; j < 16; ++j) { const size_t ro = (size_t)scan_row(b, dir, sb1 * 16 + j) * DBB + dcol; lf[j] = LG[ro]; qv[j] = Q[ro]; kv[j] = KK[ro]; vv[j] = VI[ro]; }
    for (int gi = 0; gi < NG; ++gi) {
        __syncthreads();
        {
            float a[16], run = 0.f;
#pragma unroll
            for (int j = 0; j < 16; ++j) { run += lf[j]; a[j] = run; }
            const float a15 = run;
            unsigned ke[8], vt[8];
#pragma unroll
            for (int j = 0; j < 16; ++j) {
                const float q = bf2f(qv[j]), k = bf2f(kv[j]);
                const float qs = q * __expf(a[j]), ks = k * __expf(fminf(-a[j], 80.f)), kev = k * __expf(a15 - a[j]);
                const unsigned pq = pk2(qs, ks);
                *(LAS unsigned short*)(L + SC_QS + (sb1 * 16 + j) * 272 + 2 * dcol) = (unsigned short)(pq & 0xffffu);
                *(LAS unsigned short*)(L + SC_KS + (sb1 * 16 + j) * 272 + 2 * dcol) = (unsigned short)(pq >> 16);
                const unsigned pe = pk2(kev, 0.f) & 0xffffu;
                if (j & 1) { ke[j >> 1] |= pe << 16; vt[j >> 1] |= ((unsigned)vv[j]) << 16; } else { ke[j >> 1] = pe; vt[j >> 1] = (unsigned)vv[j]; }
            }
            *(LAS v4u*)(L + SC_KET + (sb1 * 128 + dcol) * 32) = (v4u){ke[0], ke[1], ke[2], ke[3]}; *(LAS v4u*)(L + SC_KET + (sb1 * 128 + dcol) * 32 + 16) = (v4u){ke[4], ke[5], ke[6], ke[7]};
            *(LAS v4u*)(L + SC_VT + (sb1 * 128 + dcol) * 32) = (v4u){vt[0], vt[1], vt[2], vt[3]}; *(LAS v4u*)(L + SC_VT + (sb1 * 128 + dcol) * 32 + 16) = (v4u){vt[4], vt[5], vt[6], vt[7]};
            *(LAS float*)(L + SC_DD + (sb1 * 128 + dcol) * 4) = __expf(a15);
        }
        if (gi + 1 < NG) {
#pragma unroll
            for (int j = 0; j < 16; ++j) { const size_t ro = (size_t)scan_row(b, dir, (gi + 1) * 64 + sb1 * 16 + j) * DBB + dcol; lf[j] = LG[ro]; qv[j] = Q[ro]; kv[j] = KK[ro]; vv[j] = VI[ro]; }
        }
        __syncthreads();
        const bool do_out = ctx_out || gi >= CTXL / 64;
#pragma unroll 1
        for (int sb = 0; sb < 4; ++sb) {
            const v2u vraw = *(const LAS v2u*)(L + SC_VT + (sb * 128 + eb + i) * 32 + 8 * gq);
            const v4u vw = (v4u){vraw.x, vraw.y, 0u, 0u}; bf16x8 vf; __builtin_memcpy(&vf, &vw, 16);
            if (do_out) {
                f32x4 P = (f32x4){0.f, 0.f, 0.f, 0.f};
#pragma unroll
                for (int kk = 0; kk < 4; ++kk) {
                    const bf16x8 af = *(const LAS bf16x8*)(L + SC_KS + (sb * 16 + i) * 272 + (32 * kk + 8 * gq) * 2);
                    const bf16x8 bfr = *(const LAS bf16x8*)(L + SC_QS + (sb * 16 + i) * 272 + (32 * kk + 8 * gq) * 2);
                    P = __builtin_amdgcn_mfma_f32_16x16x32_bf16(af, bfr, P, 0, 0, 0);
                }
#pragma unroll
                for (int r = 0; r < 4; ++r) P[r] = (4 * gq + r <= i) ? P[r] : 0.f;
                const v4u pw = (v4u){pk2(P[0], P[1]), pk2(P[2], P[3]), 0u, 0u}; bf16x8 pb; __builtin_memcpy(&pb, &pw, 16);
                f32x4 Oa = __builtin_amdgcn_mfma_f32_16x16x32_bf16(vf, pb, (f32x4){0.f, 0.f, 0.f, 0.f}, 0, 0, 0);
#pragma unroll
                for (int kk = 0; kk < 4; ++kk) {
                    const v4u sw = (v4u){pk2(S[2 * kk][0], S[2 * kk][1]), pk2(S[2 * kk][2], S[2 * kk][3]), pk2(S[2 * kk + 1][0], S[2 * kk + 1][1]), pk2(S[2 * kk + 1][2], S[2 * kk + 1][3])};
                    bf16x8 sf; __builtin_memcpy(&sf, &sw, 16);
                    const v2u q0 = *(const LAS v2u*)(L + SC_QS + (sb * 16 + i) * 272 + (32 * kk + 4 * gq) * 2), q1 = *(const LAS v2u*)(L + SC_QS + (sb * 16 + i) * 272 + (32 * kk + 16 + 4 * gq) * 2);
                    const v4u qw = (v4u){q0.x, q0.y, q1.x, q1.y}; bf16x8 qb; __builtin_memcpy(&qb, &qw, 16);
                    Oa = __builtin_amdgcn_mfma_f32_16x16x32_bf16(sf, qb, Oa, 0, 0, 0);
                }
                *(f32x4*)(O + (size_t)scan_row(b, dir, gi * 64 + sb * 16 + i) * DBB + eb + 4 * gq) = Oa;
            }
#pragma unroll
            for (int tt = 0; tt < 8; ++tt) {
                const f32x4 dd = *(const LAS f32x4*)(L + SC_DD + (sb * 128 + 16 * tt + 4 * gq) * 4);
                const v2u kraw = *(const LAS v2u*)(L + SC_KET + (sb * 128 + 16 * tt + i) * 32 + 8 * gq);
                const v4u kw = (v4u){kraw.x, kraw.y, 0u, 0u}; bf16x8 kf; __builtin_memcpy(&kf, &kw, 16);
                S[tt] = __builtin_amdgcn_mfma_f32_16x16x32_bf16(kf, vf, S[tt] * dd, 0, 0, 0);
            }
        }
    }
    __syncthreads();
}

constexpr int NPH_LAYER = 12, NPHASES = 2 + DEPTH * NPH_LAYER;
__global__ void __launch_bounds__(NWAVES * 64, 2) mk_fwd(Args args) {
    TID_DECL();
    extern __shared__ __attribute__((aligned(16))) unsigned char lds[];
    Frame F;
    F.lds = (LAS unsigned char*)lds;
    F.wave = __builtin_amdgcn_readfirstlane(FTID >> 6);
    F.G = gridDim.x; F.bx = blockIdx.x;
    for (int u = FTID; u < (LDS_BYTES - LDSCTL_OFF) / 4; u += NWAVES * 64) ((LAS unsigned*)(F.lds + LDSCTL_OFF))[u] = 0u;
    __syncthreads();
    XcdBarrier bar = xcd_barrier_post((unsigned*)(args.ws + WS_CTL) + CW_BAR, (volatile LAS unsigned*)(F.lds + MISC_OFF) + 8);
    const int lo = args.ph_lo, hi = args.ph_hi;
#define IN(k) (lo <= (k) && (k) < hi)
#define SEAM(k) do { if (IN(k) && IN((k) + 1)) xcd_barrier(bar); } while (0)
    using pg8::Gemm; using pg8::RectOrder; using pg8::gemm_phase;
    LAS unsigned char* ring = F.lds + RING_OFF;
#define WSB() unsigned char* ws = opaque_ptr(args.ws)
#define MODALL ((const float*)(ws + WS_MOD))
#define NORMG(l_) (INP(6) + (size_t)(l_) * NNORM * DM)
#define MODL(l_) (MODALL + (size_t)(l_) * NGRP * NMOD * DM)
#define WL(l_) (ws + WS_W + (size_t)(l_) * W_LAYER)

    if (IN(0)) p0_prologue(F, args);
    SEAM(0);
    if (IN(1)) { WSB(); thin_phase<0>(F, args, TT, nullptr, nullptr, nullptr, 0, 0.f, NORMG(0), MODALL, 0, 1); }
    SEAM(1);
#pragma nounroll
    for (int l = 0; l < DEPTH; ++l) {
        const int pb = 2 + l * NPH_LAYER; const bool lastl = (l == DEPTH - 1);
        const int npan_late = lastl ? TX / 256 : TT / 256;
        if (IN(pb + 0)) { WSB(); Gemm g{(const bf16*)(ws + WS_H), (const bf16*)(WL(l) + WO_GU1), DM, DM, DM}; RectOrder S{0, TT / 256, 0, 2 * DFF / 256, 0, 0, 0, 0, F.G, F.bx}; EpiGU E{(bf16*)(ws + WS_ACT)};
            gemm_phase<EpiGU, RectOrder, true, true>(ring, g, S, E); }
        SEAM(pb + 0);
        if (IN(pb + 1)) { WSB(); Gemm g{(const bf16*)(ws + WS_ACT), (const bf16*)(WL(l) + WO_D1), DFF, DFF, DFF}; RectOrder S{0, TT / 256, 0, DM / 256, 0, 0, 0, 0, F.G, F.bx}; EpiF32 E{(float*)(ws + WS_Y), DM};
            gemm_phase<EpiF32, RectOrder, true, true>(ring, g, S, E); }
        SEAM(pb + 1);
        if (IN(pb + 2)) { WSB(); thin_phase<1>(F, args, TT, (const float*)(ws + WS_Y), NORMG(l) + 1 * DM, MODL(l), 2, 0.5f, NORMG(l) + 2 * DM, MODL(l), 3, 4); }
        SEAM(pb + 2);
        if (IN(pb + 3)) { WSB(); Gemm g{(const bf16*)(ws + WS_H), (const bf16*)(WL(l) + WO_IN), DM, DM, DM};
            RectOrder S{0, lastl ? TX / 256 : TT / 256, 0, INC / 256, TX / 256, lastl ? TC / 256 : 0, 12, 12, F.G, F.bx};
            EpiIN E{(bf16*)(ws + WS_U), (bf16*)(ws + WS_V), (bf16*)(ws + WS_Q), (bf16*)(ws + WS_KF), (bf16*)(ws + WS_KB), (bf16*)(ws + WS_VI), (bf16*)(ws + WS_SG), (bf16*)(ws + WS_SA), (bf16*)(ws + WS_SB),
                    (float*)(ws + WS_LF), (float*)(ws + WS_LB), (const float*)(ws + WS_LBT) + (size_t)l * 2 * DBB};
            gemm_phase<EpiIN, RectOrder, true, true>(ring, g, S, E); }
        SEAM(pb + 3);
        if (IN(pb + 4)) {
            if (F.bx < 64) { scan_unit(F, args, F.bx & 3, (F.bx >> 2) & 7, F.bx >> 5, !lastl); }
            else {
                const int nch = lastl ? TX / 128 : TT / 128;
                for (int it = F.bx - 64; it < nch * 8; it += F.G - 64)
                    gmlp_unit(F, args, (it >> 3) * 128, it & 7, INP(12) + (size_t)l * DA, INP(13) + (size_t)l * 8 * 128 * 128, INP(14) + (size_t)l * 8 * 128);
            }
        }
        SEAM(pb + 4);
        if (IN(pb + 5)) readout_phase(F, args, npan_late * 256, INP(16) + (size_t)l * DBB);
        SEAM(pb + 5);
        if (IN(pb + 6)) { RectOrder S{0, npan_late, 0, DM / 256, 0, 0, 0, 0, F.G, F.bx};
            { WSB(); Gemm g{(const bf16*)(ws + WS_YAB), (const bf16*)(WL(l) + WO_UP), DA, 2 * DA, 2 * DA}; EpiMerge<0> E{(const bf16*)(ws + WS_SA), (float*)(ws + WS_M1), (bf16*)(ws + WS_MB)};
              gemm_phase<EpiMerge<0>, RectOrder, true, true>(ring, g, S, E); }
            { WSB(); Gemm g{(const bf16*)(ws + WS_YAB) + DA, (const bf16*)(WL(l) + WO_UP) + DA, DBB, 2 * DA, 2 * DA}; EpiMerge<1> E{(const bf16*)(ws + WS_SB), (float*)(ws + WS_M1), (bf16*)(ws + WS_MB)};
              gemm_phase<EpiMerge<1>, RectOrder, true, true>(ring, g, S, E); } }
        SEAM(pb + 6);
        if (IN(pb + 7)) { WSB(); Gemm g{(const bf16*)(ws + WS_MB), (const bf16*)(WL(l) + WO_OUT), DM, DM, DM}; RectOrder S{0, npan_late, 0, DM / 256, 0, 0, 0, 0, F.G, F.bx}; EpiF32 E{(float*)(ws + WS_Y), DM};
            gemm_phase<EpiF32, RectOrder, true, true>(ring, g, S, E); }
        SEAM(pb + 7);
        if (IN(pb + 8)) { WSB(); thin_phase<1>(F, args, npan_late * 256, (const float*)(ws + WS_Y), NORMG(l) + 3 * DM, MODL(l), 5, 1.0f, NORMG(l) + 4 * DM, MODL(l), 6, 7); }
        SEAM(pb + 8);
        if (IN(pb + 9)) { WSB(); Gemm g{(const bf16*)(ws + WS_H), (const bf16*)(WL(l) + WO_GU2), DM, DM, DM}; RectOrder S{0, npan_late, 0, 2 * DFF / 256, 0, 0, 0, 0, F.G, F.bx}; EpiGU E{(bf16*)(ws + WS_ACT)};
            gemm_phase<EpiGU, RectOrder, true, true>(ring, g, S, E); }
        SEAM(pb + 9);
        if (IN(pb + 10)) { WSB(); Gemm g{(const bf16*)(ws + WS_ACT), (const bf16*)(WL(l) + WO_D2), DFF, DFF, DFF}; RectOrder S{0, npan_late, 0, DM / 256, 0, 0, 0, 0, F.G, F.bx}; EpiF32 E{(float*)(ws + WS_Y), DM};
            gemm_phase<EpiF32, RectOrder, true, true>(ring, g, S, E); }
        SEAM(pb + 10);
        if (IN(pb + 11)) { WSB();
            if (lastl) thin_phase<2>(F, args, TX, (const float*)(ws + WS_Y), NORMG(l) + 5 * DM, MODL(l), 8, 0.5f, nullptr, nullptr, 0, 0);
            else thin_phase<1>(F, args, TT, (const float*)(ws + WS_Y), NORMG(l) + 5 * DM, MODL(l), 8, 0.5f, NORMG(l + 1), MODL(l + 1), 0, 1);
        }
        if (!lastl) SEAM(pb + 11);
    }
#undef IN
#undef SEAM
}

extern "C" void kernel_launch(void* const* d_in, const int* in_sizes, int n_in, void* d_out, int out_size, void* d_ws, size_t ws_size, hipStream_t stream) {
    static int grid = 0;
    if (grid == 0) {
        if (n_in != 20 || in_sizes[0] != TX * DM || out_size != TX * DM || ws_size < WS_END) {
            fprintf(stderr, "kernel_launch: unexpected shapes / workspace (n_in %d, in0 %d, out %d, ws %zu, need %zu); nothing launched\n", n_in, n_in > 0 ? in_sizes[0] : -1, out_size, ws_size, (size_t)WS_END); grid = -1; return; }
        int dev = 0, cus = 0, per_cu = 0;
        if (hipGetDevice(&dev) != hipSuccess || hipDeviceGetAttribute(&cus, hipDeviceAttributeMultiprocessorCount, dev) != hipSuccess) { grid = -1; return; }
        if (hipFuncSetAttribute((const void*)mk_fwd, hipFuncAttributeMaxDynamicSharedMemorySize, LDS_BYTES) != hipSuccess) { fprintf(stderr, "kernel_launch: hipFuncSetAttribute failed\n"); grid = -1; return; }
        if (hipOccupancyMaxActiveBlocksPerMultiprocessor(&per_cu, (const void*)mk_fwd, NWAVES * 64, LDS_BYTES) != hipSuccess || per_cu < 1)
            fprintf(stderr, "kernel_launch: note: occupancy query reports %d workgroups per CU\n", per_cu);
        (void)hipGetLastError();
        grid = cus;
        if (grid != 256) fprintf(stderr, "kernel_launch: note: %d CUs\n", grid);
    }
    if (grid < 0) return;
    if (hipMemsetAsync((char*)d_ws, 0, ZERO_BYTES, stream) != hipSuccess) { fprintf(stderr, "kernel_launch: memset failed\n"); return; }
    Args a{};
    for (int i = 0; i < 20; ++i) a.in[i] = (const float*)d_in[i];
    a.out = (float*)d_out; a.ws = (unsigned char*)d_ws;
#if MK_PER_PHASE
    for (int p = 0; p < NPHASES; ++p) { a.ph_lo = p; a.ph_hi = p + 1; hipLaunchKernelGGL(mk_fwd, dim3(grid), dim3(NWAVES * 64), LDS_BYTES, stream, a); }
#else
    a.ph_lo = 0; a.ph_hi = NPHASES;
    hipLaunchKernelGGL(mk_fwd, dim3(grid), dim3(NWAVES * 64), LDS_BYTES, stream, a);
#endif
    const hipError_t le = hipPeekAtLastError();
    if (le != hipSuccess) fprintf(stderr, "kernel_launch: launch failed: %s\n", hipGetErrorName(le));
}
```

```cpp
#include <hip/hip_runtime.h>
#include <cstdio>
#include <cstdint>

#ifndef STAG_GU
#define STAG_GU 0
#endif
#ifndef STAG_IN
#define STAG_IN 0
#endif
#ifndef REP_GEMM
#define REP_GEMM 1
#endif
#ifndef REP_P0
#define REP_P0 1
#endif
#ifndef REP_S1
#define REP_S1 1
#endif
#ifndef REP_GMLP
#define REP_GMLP 1
#endif
#ifndef REP_SA
#define REP_SA 1
#endif
#ifndef REP_SB
#define REP_SB 1
#endif
#ifndef REP_THIN
#define REP_THIN 1
#endif
#ifndef PROBE_PHASE
#define PROBE_PHASE (-1)
#endif
#ifndef PROBE_MULT
#define PROBE_MULT 9
#endif
#ifndef MK_PER_PHASE
#define MK_PER_PHASE 0
#endif

namespace pg8 {
#define PG8_LAS __attribute__((address_space(3)))
typedef unsigned short bf16_t;
typedef short bf16x8 __attribute__((ext_vector_type(8)));
typedef float f32x4 __attribute__((ext_vector_type(4)));
typedef unsigned u32x4 __attribute__((ext_vector_type(4)));
constexpr int BM = 256, BK = 64, HALF = 128, HTB = HALF * BK * 2, STAGE_BYTES = 8 * HTB, NXCD = 8, WGM = 8;

__host__ __device__ __forceinline__ int lds_byte(int r, int c) { const int st = (r >> 4) * 2 + (c >> 5), rr = r & 15, cc = c & 31, ob = rr * 64 + cc * 2; return st * 1024 + (ob ^ (((ob >> 9) & 1) << 5)); }
__host__ __device__ __forceinline__ void stage_rc(int b, int& R, int& C) { const int st = b / 1024, sb = b % 1024, swz = sb ^ (((sb >> 9) & 1) << 5); R = (st >> 1) * 16 + swz / 64; C = (st & 1) * 32 + (swz % 64) / 2; }
__host__ __device__ __forceinline__ int perm32(int rho) { const int n = rho >> 4, i = rho & 15; return 8 * (i >> 2) + 4 * n + (i & 3); }

struct Unit { int pm, pn, kt0, nkt, slab; };
struct Gemm { const bf16_t* A; const bf16_t* Bt; int lda, ldb; };

struct RectOrder {
    int pma, nma, pna, nna, pmb, nmb, pnb, nnb, nsl, kA, kB, KT, G, c;
    __device__ __forceinline__ void map(int wgid, int nM, int nN, int pm0, int pn0, Unit& u) const {
        const int nwg = nM * nN;
        { const int q = nwg / NXCD, r = nwg % NXCD, xcd = wgid % NXCD, off = wgid / NXCD; wgid = (xcd < r ? xcd * (q + 1) : r * (q + 1) + (xcd - r) * q) + off; }
        const int nig = WGM * nN, gid = wgid / nig, fm = gid * WGM, gsz = (nM - fm) < WGM ? (nM - fm) : WGM;
        u.pm = pm0 + fm + ((wgid % nig) % gsz); u.pn = pn0 + (wgid % nig) / gsz;
    }
    __device__ __forceinline__ bool next(int i, Unit& u) const {
        long L = (long)i * G + c; const int na = nma * nna;
        if (L < na) { map((int)L, nma, nna, pma, pna, u); u.kt0 = 0; u.nkt = KT; u.slab = -1; return true; }
        L -= na; const int nb1 = nmb * nnb;
        if (L < (long)nb1 * nsl) { const int sl = (int)(L / nb1); map((int)(L % nb1), nmb, nnb, pmb, pnb, u);
            if (nsl > 1) { u.kt0 = (sl >> 1) * (kA + kB) + (sl & 1) * kA; u.nkt = (sl & 1) ? kB : kA; u.slab = sl; } else { u.kt0 = 0; u.nkt = KT; u.slab = -1; }
            return true; }
        return false;
    }
    __device__ __forceinline__ void a_ready(const Unit&) const {}
    __device__ __forceinline__ void done(const Unit&) const {}
};

__device__ __forceinline__ unsigned cvt_pk_bf16(float lo, float hi) { unsigned r; asm volatile("v_cvt_pk_bf16_f32 %0, %1, %2" : "=v"(r) : "v"(lo), "v"(hi)); return r; }

template <class Epi, class Sched, bool ALIGN_EPI = false, bool SP2 = false>
__device__ __forceinline__ void gemm_phase(PG8_LAS unsigned char* lds, const Gemm g, const Sched& S, const Epi& E, unsigned stagger = 0u) {
    int tid_ = threadIdx.x; asm volatile("" : "+v"(tid_));
    const int tid = tid_, wid = __builtin_amdgcn_readfirstlane(tid >> 6), lane = tid & 63, wr = wid >> 2, wc = wid & 3, fr = lane & 15, fq = lane >> 4;
    unsigned voffA[2], voffB[2];
#pragma unroll
    for (int i = 0; i < 2; ++i) { int R, C; stage_rc(tid * 16 + i * 8192, R, C); const int Rb = Epi::PERM ? ((R & ~31) + perm32(R & 31)) : R;
        voffA[i] = (unsigned)(R * g.lda + C) * 2u; voffB[i] = (unsigned)(Rb * g.ldb + C) * 2u; }
    const size_t kstep = (size_t)(BK * 2);
    const size_t hstepA = (size_t)HALF * g.lda * 2, hstepB = (size_t)HALF * g.ldb * 2;
    const size_t tstepA = 2 * hstepA, tstepB = 2 * hstepB;
    const unsigned ldsw = (unsigned)wid * 1024u;
    const int aoff = lds_byte(wr * 64 + fr, fq * 8), boff = lds_byte(wc * 32 + fr, fq * 8);
#define PG8_SA(b, h) (((b) * 2 + (h)) * HTB)
#define PG8_SB(b, h) ((4 + (b) * 2 + (h)) * HTB)
#define PG8_STAGE(bufoff, gbase, voff) do { _Pragma("unroll") for (int _i = 0; _i < 2; ++_i) \
        __builtin_amdgcn_global_load_lds((const unsigned*)((const char*)(gbase) + (voff)[_i]), (PG8_LAS unsigned*)(lds + (bufoff) + ldsw + _i * 8192), 16, 0, 0); } while (0)
#define PG8_LDA(dst, b, h) do { _Pragma("unroll") for (int m = 0; m < 4; ++m) _Pragma("unroll") for (int k = 0; k < 2; ++k) dst[m][k] = *(const PG8_LAS bf16x8*)(lds + PG8_SA(b, h) + aoff + m * 2048 + k * 1024); } while (0)
#define PG8_LDB(dst, b, h) do { _Pragma("unroll") for (int n = 0; n < 2; ++n) _Pragma("unroll") for (int k = 0; k < 2; ++k) dst[n][k] = *(const PG8_LAS bf16x8*)(lds + PG8_SB(b, h) + boff + n * 2048 + k * 1024); } while (0)
#define PG8_MMA(ai, bj, At, Bt) do { __builtin_amdgcn_s_setprio(1); _Pragma("unroll") for (int m = 0; m < 4; ++m) _Pragma("unroll") for (int n = 0; n < 2; ++n) _Pragma("unroll") for (int k = 0; k < 2; ++k) \
        acc[ai][bj][m][n] = __builtin_amdgcn_mfma_f32_16x16x32_bf16(Bt[n][k], At[m][k], acc[ai][bj][m][n], 0, 0, 0); __builtin_amdgcn_s_setprio(0); } while (0)
#define PG8_WAIT_V(n) asm volatile("s_waitcnt vmcnt(" #n ")" ::: "memory")
#define PG8_WAIT_L(n) asm volatile("s_waitcnt lgkmcnt(" #n ")" ::: "memory")
#define PG8_BAR __builtin_amdgcn_s_barrier()
#define PG8_SCHED __builtin_amdgcn_sched_barrier(0)
    Unit cur, nxt; int ui = 0;
    if (!S.next(0, cur)) return;
    if (stagger) { const unsigned long long t0_ = __builtin_amdgcn_s_memrealtime(); while (__builtin_amdgcn_s_memrealtime() - t0_ < stagger) __builtin_amdgcn_s_sleep(4); }
    f32x4 acc[2][2][4][2];
#pragma unroll
    for (int a = 0; a < 2; ++a)
#pragma unroll
        for (int b = 0; b < 2; ++b)
#pragma unroll
            for (int m = 0; m < 4; ++m)
#pragma unroll
                for (int n = 0; n < 2; ++n) acc[a][b][m][n] = (f32x4){0.f, 0.f, 0.f, 0.f};
    bf16x8 At[4][2], B0[2][2], B1[2][2];
    const char* cA = (const char*)g.A + (size_t)cur.pm * tstepA + (size_t)cur.kt0 * kstep; const char* cB = (const char*)g.Bt + (size_t)cur.pn * tstepB + (size_t)cur.kt0 * kstep;
    S.a_ready(cur);
    if constexpr (SP2) {
        PG8_STAGE(PG8_SB(0, 0), cB, voffB); PG8_STAGE(PG8_SB(0, 1), cB + hstepB, voffB); PG8_STAGE(PG8_SA(0, 0), cA, voffA); PG8_STAGE(PG8_SA(0, 1), cA + hstepA, voffA);
        if (wr == 1) PG8_BAR;
        PG8_WAIT_V(2); PG8_BAR;
        PG8_STAGE(PG8_SB(1, 0), cB + kstep, voffB); PG8_STAGE(PG8_SA(1, 0), cA + kstep, voffA); PG8_STAGE(PG8_SB(1, 1), cB + hstepB + kstep, voffB);
        PG8_WAIT_V(6); PG8_BAR;
    } else {
        PG8_STAGE(PG8_SB(0, 0), cB, voffB); PG8_STAGE(PG8_SA(0, 0), cA, voffA); PG8_STAGE(PG8_SB(0, 1), cB + hstepB, voffB); PG8_STAGE(PG8_SA(0, 1), cA + hstepA, voffA);
        if (wr == 1) PG8_BAR;
        PG8_WAIT_V(4); PG8_BAR;
        PG8_STAGE(PG8_SB(1, 0), cB + kstep, voffB); PG8_STAGE(PG8_SA(1, 0), cA + kstep, voffA); PG8_STAGE(PG8_SB(1, 1), cB + hstepB + kstep, voffB);
        PG8_WAIT_V(6); PG8_BAR;
    }
    for (;;) {
        const bool has_next = S.next(ui + 1, nxt);
        const char* nA = has_next ? (const char*)g.A + (size_t)nxt.pm * tstepA + (size_t)nxt.kt0 * kstep : cA; const char* nB = has_next ? (const char*)g.Bt + (size_t)nxt.pn * tstepB + (size_t)nxt.kt0 * kstep : cB;
        const int nt = cur.nkt;
        for (int t = 0; t < nt; t += 2) {
            const bool last = (t == nt - 2);
            const char* a1 = cA + (size_t)(t + 1) * kstep;
            const char* a2 = last ? nA : cA + (size_t)(t + 2) * kstep; const char* b2 = last ? nB : cB + (size_t)(t + 2) * kstep;
            const char* a3 = a2 + kstep; const char* b3 = b2 + kstep;
            if (last && has_next) S.a_ready(nxt);
            if constexpr (Epi::MIDK) { if (t == (nt >> 1)) E.mid(acc, cur, wr, wc, fr, fq); }
            if constexpr (SP2) {
            PG8_LDB(B0, 0, 0); PG8_LDB(B1, 0, 1); PG8_SCHED; PG8_LDA(At, 0, 0); PG8_STAGE(PG8_SA(1, 1), a1 + hstepA, voffA);
            PG8_WAIT_V(8); PG8_WAIT_L(0); PG8_BAR; PG8_MMA(0, 0, At, B0); PG8_MMA(0, 1, At, B1); PG8_BAR; PG8_SCHED;
            PG8_LDA(At, 0, 1); PG8_STAGE(PG8_SB(0, 0), b2, voffB); PG8_STAGE(PG8_SB(0, 1), b2 + hstepB, voffB); PG8_STAGE(PG8_SA(0, 0), a2, voffA);
            PG8_WAIT_V(8); PG8_WAIT_L(0); PG8_BAR; PG8_MMA(1, 0, At, B0); PG8_MMA(1, 1, At, B1); PG8_BAR; PG8_SCHED;
            PG8_LDB(B0, 1, 0); PG8_LDB(B1, 1, 1); PG8_SCHED; PG8_LDA(At, 1, 0); PG8_STAGE(PG8_SA(0, 1), a2 + hstepA, voffA);
            PG8_WAIT_V(8); PG8_WAIT_L(0); PG8_BAR; PG8_MMA(0, 0, At, B0); PG8_MMA(0, 1, At, B1); PG8_BAR; PG8_SCHED;
            PG8_LDA(At, 1, 1); PG8_STAGE(PG8_SB(1, 0), b3, voffB); PG8_STAGE(PG8_SB(1, 1), b3 + hstepB, voffB); PG8_STAGE(PG8_SA(1, 0), a3, voffA);
            PG8_WAIT_V(8); PG8_WAIT_L(0); PG8_BAR; PG8_MMA(1, 0, At, B0); PG8_MMA(1, 1, At, B1); PG8_BAR; PG8_SCHED;
            } else {
            PG8_LDB(B0, 0, 0); PG8_SCHED; PG8_LDA(At, 0, 0); PG8_STAGE(PG8_SA(1, 1), a1 + hstepA, voffA);
            PG8_WAIT_L(8); PG8_BAR; PG8_WAIT_L(0); PG8_MMA(0, 0, At, B0); PG8_BAR; PG8_SCHED;
            PG8_LDB(B1, 0, 1); PG8_STAGE(PG8_SB(0, 0), b2, voffB);
            PG8_BAR; PG8_WAIT_L(0); PG8_MMA(0, 1, At, B1); PG8_BAR;
            PG8_LDA(At, 0, 1); PG8_STAGE(PG8_SA(0, 0), a2, voffA);
            PG8_BAR; PG8_WAIT_L(0); PG8_MMA(1, 0, At, B0); PG8_BAR; PG8_SCHED;
            PG8_STAGE(PG8_SB(0, 1), b2 + hstepB, voffB);
            PG8_WAIT_V(6); PG8_BAR; PG8_MMA(1, 1, At, B1); PG8_BAR;
            PG8_LDB(B0, 1, 0); PG8_SCHED; PG8_LDA(At, 1, 0); PG8_STAGE(PG8_SA(0, 1), a2 + hstepA, voffA);
            PG8_WAIT_L(8); PG8_BAR; PG8_WAIT_L(0); PG8_MMA(0, 0, At, B0); PG8_BAR; PG8_SCHED;
            PG8_LDB(B1, 1, 1); PG8_STAGE(PG8_SB(1, 0), b3, voffB);
            PG8_BAR; PG8_WAIT_L(0); PG8_MMA(0, 1, At, B1); PG8_BAR;
            PG8_LDA(At, 1, 1); PG8_STAGE(PG8_SA(1, 0), a3, voffA);
            PG8_BAR; PG8_WAIT_L(0); PG8_MMA(1, 0, At, B0); PG8_BAR; PG8_SCHED;
            PG8_STAGE(PG8_SB(1, 1), b3 + hstepB, voffB);
            PG8_WAIT_V(6); PG8_BAR; PG8_MMA(1, 1, At, B1); PG8_BAR;
            }
        }
        if constexpr (ALIGN_EPI) { if (wr == 0) PG8_BAR; }
        asm volatile("s_nop 7\n\ts_nop 7" ::: "memory");
        E(acc, cur, wr, wc, fr, fq); S.done(cur);
        if (!has_next) break;
#pragma unroll
        for (int a = 0; a < 2; ++a)
#pragma unroll
            for (int b = 0; b < 2; ++b)
#pragma unroll
                for (int m = 0; m < 4; ++m)
#pragma unroll
                    for (int n = 0; n < 2; ++n) acc[a][b][m][n] = (f32x4){0.f, 0.f, 0.f, 0.f};
        cur = nxt; cA = nA; cB = nB; ++ui;
        if constexpr (ALIGN_EPI) { if (wr == 1) PG8_BAR; }
    }
    PG8_WAIT_V(0);
    if constexpr (!ALIGN_EPI) { if (wr == 0) PG8_BAR; }
    PG8_BAR;
#undef PG8_SA
#undef PG8_SB
#undef PG8_STAGE
#undef PG8_LDA
#undef PG8_LDB
#undef PG8_MMA
#undef PG8_WAIT_V
#undef PG8_WAIT_L
#undef PG8_BAR
#undef PG8_SCHED
}
}

constexpr int NWAVES = 8;
constexpr int DM = 2048, BATCH = 4, SEQ = 2048, DEPTH = 2, CTXL = 256, DFF = 5632, DA = 1024, DBB = 1024, NHEAD = 8, HDIM = 128, NMOD = 9, NNORM = 6;
constexpr int INC = 2 * DA + 5 * DBB + 2 * DM;
constexpr int TX = BATCH * SEQ, TC = BATCH * CTXL, TT = TX + TC;
constexpr int NGRP = 5;
constexpr float EPS = 1e-6f;

constexpr size_t MiB = 1u << 20;
constexpr size_t WS_CTL = 0, WS_MOD = 1 * MiB, ZERO_BYTES = 32768;
constexpr size_t WS_LBT = 2 * MiB;
constexpr size_t WS_W = 4 * MiB, W_LAYER = 192 * MiB;
constexpr size_t WO_GU1 = 0, WO_D1 = 44 * MiB, WO_IN = 66 * MiB, WO_UP = 110 * MiB, WO_OUT = 118 * MiB, WO_GU2 = 126 * MiB, WO_D2 = 170 * MiB;
constexpr size_t WS_X = 388 * MiB;
constexpr size_t WS_H = 460 * MiB;
constexpr size_t WS_Y = 496 * MiB;
constexpr size_t WS_YS = 528 * MiB;
constexpr int NSLAB = 8, NSLAB_OUT = 4;
constexpr size_t WS_R = 592 * MiB;
constexpr size_t WS_ACT = WS_R;
constexpr size_t WS_U = WS_R, WS_V = WS_R + 18 * MiB, WS_Q = WS_R + 36 * MiB, WS_KF = WS_R + 54 * MiB, WS_KB = WS_R + 72 * MiB, WS_VI = WS_R + 90 * MiB;
constexpr size_t WS_LF = WS_R + 108 * MiB, WS_LB = WS_R + 144 * MiB;
constexpr size_t WS_M1 = WS_R, WS_MB = WS_R + 72 * MiB;
constexpr size_t WS_SG = WS_R + 180 * MiB;
constexpr size_t WS_SA = WS_R + 198 * MiB, WS_SB = WS_R + 234 * MiB;
constexpr size_t WS_OF = WS_R + 270 * MiB, WS_OB = WS_R + 306 * MiB;
constexpr size_t WS_YAB = WS_R + 342 * MiB;
constexpr size_t WS_SLOC = WS_R + 378 * MiB;
constexpr size_t WS_ATOT = WS_R + 394 * MiB;
constexpr size_t WS_VST = WS_R + 395 * MiB;
constexpr size_t WS_END = WS_R + 397 * MiB;
constexpr int CW_TMO = 0, CW_BAR = 4096;

constexpr int RING_OFF = 0, RING_BYTES = 131072;
constexpr int LDSCTL_OFF = RING_BYTES, MISC_OFF = LDSCTL_OFF + 320;
constexpr int LDS_BYTES = 147456;

#define GAS __attribute__((address_space(1)))
#define LAS __attribute__((address_space(3)))
typedef unsigned short bf16;
typedef unsigned v4u __attribute__((ext_vector_type(4)));
typedef unsigned v2u __attribute__((ext_vector_type(2)));
typedef float f32x4 __attribute__((ext_vector_type(4)));
typedef short bf16x8 __attribute__((ext_vector_type(8)));
typedef GAS unsigned gu32;
#define RLX_AGENT __ATOMIC_RELAXED, __HIP_MEMORY_SCOPE_AGENT
#define LDS_WAIT() asm volatile("s_waitcnt lgkmcnt(0)" ::: "memory")
#define VM_WAIT() asm volatile("s_waitcnt vmcnt(0)" ::: "memory")
__device__ __forceinline__ unsigned pk2(float lo, float hi) { return pg8::cvt_pk_bf16(lo, hi); }
__device__ __forceinline__ unsigned pk2_sw(float lo, float hi) { const unsigned a = __float_as_uint(lo), b = __float_as_uint(hi); return ((a + 0x7fffu + ((a >> 16) & 1u)) >> 16) | ((b + 0x7fffu + ((b >> 16) & 1u)) & 0xffff0000u); }
__device__ __forceinline__ float bflo(unsigned w) { return __uint_as_float(w << 16); }
__device__ __forceinline__ float bfhi(unsigned w) { return __uint_as_float(w & 0xffff0000u); }
__device__ __forceinline__ float bf2f(unsigned short b) { return __uint_as_float(((unsigned)b) << 16); }
__device__ __forceinline__ float fsigmoid(float x) { return __builtin_amdgcn_rcpf(1.0f + __expf(-x)); }
__device__ __forceinline__ float fsilu(float x) { return x * fsigmoid(x); }
__device__ __forceinline__ float fgelu_tanh(float x) { return x * fsigmoid(1.5957691216057308f * (x + 0.044715f * x * x * x)); }
__device__ __forceinline__ float wave_sum(float v) {
#pragma unroll
    for (int o = 1; o < 64; o <<= 1) v += __shfl_xor(v, o);
    return v;
}

#define XB_TMO      128
#define XB_XCNT(j)  (256  + 64 * (j))
#define XB_XSUB(j)  (1280 + 64 * (j))
#define XB_XGEN(j)  (2304 + 64 * (j))
#define XB_TOP      3328
#define XB_TOPGEN   3392
#define XCD_BAR_WORDS 3456
#define XB_SPIN_CAP (1u << 18)

__device__ __forceinline__ unsigned xb_ld(unsigned* p)              { return __hip_atomic_load(p, __ATOMIC_RELAXED, __HIP_MEMORY_SCOPE_AGENT); }
__device__ __forceinline__ unsigned xb_add(unsigned* p, unsigned v) { return __hip_atomic_fetch_add(p, v, __ATOMIC_RELAXED, __HIP_MEMORY_SCOPE_AGENT); }
__device__ __forceinline__ unsigned xb_xcc_id() { return (unsigned)__builtin_amdgcn_s_getreg((3 << 11) | 20) & 0xFu; }
#define XB_SPIN(cond, bar) do { unsigned _sp = 0; while (cond) { __builtin_amdgcn_s_sleep(1); \
    if ((++_sp & 255u) == 0u) { if (xb_ld(&(bar)[XB_TMO])) break; if (_sp > XB_SPIN_CAP) { atomicAdd(&(bar)[XB_TMO], 1u); break; } } } } while (0)

struct XcdBarrier {
    unsigned* bar; unsigned x;
    volatile LAS unsigned* st;
};
__device__ __forceinline__ XcdBarrier xcd_barrier_post(unsigned* bar, volatile LAS unsigned* st) {
    XcdBarrier b; b.bar = bar; b.x = xb_xcc_id(); b.st = st;
    if (threadIdx.x == 0) (void)xb_add(&bar[XB_XCNT(b.x)], 1u);
    return b;
}
__device__ __forceinline__ void xcd_barrier_complete(unsigned* bar, unsigned x, unsigned& nloc, unsigned& nx) {
    const unsigned G = gridDim.x * gridDim.y * gridDim.z;
    unsigned sum, cnt, mine, sp = 0u;
    for (;;) {
        sum = 0u; cnt = 0u; mine = 0u;
#pragma unroll
        for (unsigned j = 0; j < 16; ++j) { const unsigned c = xb_ld(&bar[XB_XCNT(j)]); sum += c; cnt += (c > 0u) ? 1u : 0u; mine = (j == x) ? c : mine; }
        if (sum == G) break;
        __builtin_amdgcn_s_sleep(1);
        if ((++sp & 255u) == 0u) { if (xb_ld(&bar[XB_TMO])) break; if (sp > XB_SPIN_CAP) { atomicAdd(&bar[XB_TMO], 1u); break; } }
    }
    nloc = mine > 0u ? mine : 1u; nx = cnt > 0u ? cnt : 1u;
}
__device__ __forceinline__ void xcd_barrier(const XcdBarrier& b) {
    asm volatile("s_waitcnt vmcnt(0)" ::: "memory");
    __syncthreads();
    if (threadIdx.x == 0) {
        unsigned* bar = b.bar;
        __builtin_amdgcn_s_waitcnt(0);
        unsigned nloc = b.st[0], nx = b.st[1];
        if (nloc == 0u) { xcd_barrier_complete(bar, b.x, nloc, nx); b.st[0] = nloc; b.st[1] = nx; }
        const unsigned old = xb_add(&bar[XB_XSUB(b.x)], 1u);
        const unsigned gen = old / nloc;
        if (old + 1u == (gen + 1u) * nloc) {
            __builtin_amdgcn_fence(__ATOMIC_RELEASE, "agent");
            asm volatile("s_waitcnt vmcnt(0)" ::: "memory");
            const unsigned og = xb_add(&bar[XB_TOP], 1u);
            const unsigned tg = og / nx;
            if (og + 1u == (tg + 1u) * nx) xb_add(&bar[XB_TOPGEN], 1u);
            else XB_SPIN(xb_ld(&bar[XB_TOPGEN]) == tg, bar);
            __builtin_amdgcn_fence(__ATOMIC_ACQUIRE, "agent");
            xb_add(&bar[XB_XGEN(b.x)], 1u);
            asm volatile("s_waitcnt vmcnt(0)" ::: "memory");
        } else {
            XB_SPIN(xb_ld(&bar[XB_XGEN(b.x)]) == gen, bar);
            __builtin_amdgcn_fence(__ATOMIC_ACQUIRE, "agent");
            asm volatile("s_waitcnt vmcnt(0)" ::: "memory");
        }
    }
    __syncthreads();
}

using pg8::Unit;
__device__ __forceinline__ v4u pack8(const f32x4 a, const f32x4 b) { v4u w; w.x = pk2(a[0], a[1]); w.y = pk2(a[2], a[3]); w.z = pk2(b[0], b[1]); w.w = pk2(b[2], b[3]); return w; }

struct EpiGU {
    static constexpr bool PERM = true, MIDK = false;
    bf16* O;
    __device__ __forceinline__ void operator()(const f32x4 (&acc)[2][2][4][2], const Unit& u, int wr, int wc, int fr, int fq) const {
        const int row0 = u.pm * 256 + wr * 64 + fr, col0 = u.pn * 128 + wc * 32 + 8 * fq;
#pragma unroll
        for (int ai = 0; ai < 2; ++ai)
#pragma unroll
            for (int m = 0; m < 4; ++m) {
                f32x4 v0, v1;
#pragma unroll
                for (int j = 0; j < 4; ++j) { v0[j] = fsilu(acc[ai][0][m][0][j]) * acc[ai][1][m][0][j]; v1[j] = fsilu(acc[ai][0][m][1][j]) * acc[ai][1][m][1][j]; }
                *(v4u*)(O + (size_t)(row0 + ai * 128 + m * 16) * DFF + col0) = pack8(v0, v1);
            }
    }
};
struct EpiY {
    static constexpr bool PERM = true, MIDK = false;
    bf16* Y16; bf16* YS;
    __device__ __forceinline__ void operator()(const f32x4 (&acc)[2][2][4][2], const Unit& u, int wr, int wc, int fr, int fq) const {
        const int row0 = u.pm * 256 + wr * 64 + fr, col0 = u.pn * 256 + wc * 32 + 8 * fq;
        if (u.slab < 0) {
#pragma unroll
            for (int ai = 0; ai < 2; ++ai)
#pragma unroll
                for (int m = 0; m < 4; ++m)
#pragma unroll
                    for (int bj = 0; bj < 2; ++bj) *(v4u*)(Y16 + (size_t)(row0 + ai * 128 + m * 16) * DM + col0 + bj * 128) = pack8(acc[ai][bj][m][0], acc[ai][bj][m][1]);
        } else {
            bf16* base = YS + (size_t)u.slab * TC * DM;
#pragma unroll
            for (int ai = 0; ai < 2; ++ai)
#pragma unroll
                for (int m = 0; m < 4; ++m)
#pragma unroll
                    for (int bj = 0; bj < 2; ++bj) *(v4u*)(base + (size_t)(row0 - TX + ai * 128 + m * 16) * DM + col0 + bj * 128) = pack8(acc[ai][bj][m][0], acc[ai][bj][m][1]);
        }
    }
};
constexpr int SEQT = CTXL + SEQ;
__device__ __forceinline__ size_t hm_row(int row) {
    int b, tau; if (row < TX) { b = row >> 11; tau = CTXL + (row & (SEQ - 1)); } else { const int rc = row - TX; b = rc >> 8; tau = rc & (CTXL - 1); }
    return ((size_t)b * NHEAD * SEQT + tau) * HDIM;
}
struct EpiIN {
    static constexpr bool PERM = true, MIDK = false;
    bf16 *U, *V, *Q, *VI, *SG, *SA, *SB; float *LF, *LB; const float* lbt; float* VST;
    __device__ __forceinline__ void operator()(const f32x4 (&acc)[2][2][4][2], const Unit& u, int wr, int wc, int fr, int fq) const {
        const int row0 = u.pm * 256 + wr * 64 + fr;
        const int grp = u.pn >> 2;
        const int cbase = u.pn * 256 + wc * 32 + 8 * fq;
        if (grp >= 2 && grp <= 5) {
            const int d0 = wc * 32 + 8 * fq;
#pragma unroll
            for (int bj = 0; bj < 2; ++bj) {
                const size_t hoff = (size_t)((u.pn & 3) * 2 + bj) * SEQT * HDIM + d0;
                if (grp == 3 || grp == 4) {
                    const int dir = grp - 3; float* LO = dir ? LB : LF;
                    const int c = (u.pn & 3) * 256 + bj * 128 + d0;
                    const f32x4 l0 = *(const f32x4*)(lbt + dir * 1024 + c), l1 = *(const f32x4*)(lbt + dir * 1024 + c + 4);
#pragma unroll
                    for (int ai = 0; ai < 2; ++ai)
#pragma unroll
                        for (int m = 0; m < 4; ++m) {
                            f32x4 g0, g1;
#pragma unroll
                            for (int j = 0; j < 4; ++j) {
                                { const float z = fminf(fmaxf(acc[ai][bj][m][0][j], -80.f), 80.f), sg = __builtin_amdgcn_rcpf(1.0f + __expf(-z)), lb = l0[j]; g0[j] = __logf(fmaxf(lb + (1.0f - lb) * sg, 1e-30f)); }
                                { const float z = fminf(fmaxf(acc[ai][bj][m][1][j], -80.f), 80.f), sg = __builtin_amdgcn_rcpf(1.0f + __expf(-z)), lb = l1[j]; g1[j] = __logf(fmaxf(lb + (1.0f - lb) * sg, 1e-30f)); }
                            }
                            float* p = LO + hm_row(row0 + ai * 128 + m * 16) + hoff; *(f32x4*)p = g0; *(f32x4*)(p + 4) = g1;
                        }
                } else {
                    bf16* O = (grp == 2) ? Q : VI;
#pragma unroll
                    for (int ai = 0; ai < 2; ++ai)
#pragma unroll
                        for (int m = 0; m < 4; ++m) *(v4u*)(O + hm_row(row0 + ai * 128 + m * 16) + hoff) = pack8(acc[ai][bj][m][0], acc[ai][bj][m][1]);
                }
            }
            return;
        }
        bf16* O; int ld, csub, fn;
        if (grp == 0) { O = U; ld = 1024; csub = 0; fn = 1; }
        else if (grp == 1) { O = V; ld = 1024; csub = 1024; fn = 1; }
        else if (grp == 6) { O = SG; ld = 1024; csub = 6144; fn = 2; }
        else if (grp <= 8) { O = SA; ld = 2048; csub = 7168; fn = 3; }
        else { O = SB; ld = 2048; csub = 9216; fn = 3; }
        if (grp == 1) {
#pragma unroll
            for (int ai = 0; ai < 2; ++ai)
#pragma unroll
                for (int m = 0; m < 4; ++m) {
                    float sm = 0.f, sq = 0.f;
#pragma unroll
                    for (int bj = 0; bj < 2; ++bj) {
                        f32x4 v0 = acc[ai][bj][m][0], v1 = acc[ai][bj][m][1];
#pragma unroll
                        for (int j = 0; j < 4; ++j) { v0[j] = fgelu_tanh(v0[j]); v1[j] = fgelu_tanh(v1[j]); sm += v0[j] + v1[j]; sq += v0[j] * v0[j] + v1[j] * v1[j]; }
                        *(v4u*)(V + (size_t)(row0 + ai * 128 + m * 16) * 1024 + (cbase + bj * 128 - 1024)) = pack8(v0, v1);
                    }
                    sm += __shfl_xor(sm, 16); sm += __shfl_xor(sm, 32); sq += __shfl_xor(sq, 16); sq += __shfl_xor(sq, 32);
                    if (fq == 0) { float* p = VST + ((size_t)(row0 + ai * 128 + m * 16) * 16 + (u.pn & 3) * 4 + wc) * 2; p[0] = sm; p[1] = sq; }
                }
            return;
        }
#pragma unroll
        for (int ai = 0; ai < 2; ++ai)
#pragma unroll
            for (int m = 0; m < 4; ++m)
#pragma unroll
                for (int bj = 0; bj < 2; ++bj) {
                    f32x4 v0 = acc[ai][bj][m][0], v1 = acc[ai][bj][m][1];
                    if (fn == 1) {
#pragma unroll
                        for (int j = 0; j < 4; ++j) { v0[j] = fgelu_tanh(v0[j]); v1[j] = fgelu_tanh(v1[j]); } }
                    else if (fn == 2) {
#pragma unroll
                        for (int j = 0; j < 4; ++j) { v0[j] = fsilu(v0[j]); v1[j] = fsilu(v1[j]); } }
                    else {
#pragma unroll
                        for (int j = 0; j < 4; ++j) { v0[j] = fsigmoid(v0[j]); v1[j] = fsigmoid(v1[j]); } }
                    *(v4u*)(O + (size_t)(row0 + ai * 128 + m * 16) * ld + (cbase + bj * 128 - csub)) = pack8(v0, v1);
                }
    }
};
struct EpiMerge {
    static constexpr bool PERM = true, MIDK = true;
    const bf16* SA; const bf16* SB; bf16* MB;
    __device__ __forceinline__ void mid(f32x4 (&acc)[2][2][4][2], const Unit& u, int wr, int wc, int fr, int fq) const {
        int row0 = u.pm * 256 + wr * 64 + fr, col0 = u.pn * 256 + wc * 32 + 8 * fq;
        asm volatile("" : "+v"(row0), "+v"(col0));
#pragma unroll
        for (int ai = 0; ai < 2; ++ai)
#pragma unroll
            for (int m = 0; m < 4; ++m) {
#pragma unroll
                for (int bj = 0; bj < 2; ++bj) {
                    const size_t off = (size_t)(row0 + ai * 128 + m * 16) * 2048 + col0 + bj * 128;
                    const v4u a = *(const v4u*)(SA + off), b = *(const v4u*)(SB + off);
                    const unsigned aw[4] = {a.x, a.y, a.z, a.w}, bw[4] = {b.x, b.y, b.z, b.w};
#pragma unroll
                    for (int j = 0; j < 4; ++j) {
                        const float r0 = bflo(aw[j]) * __builtin_amdgcn_rcpf(fmaxf(bflo(bw[j]), 1e-30f)), r1 = bfhi(aw[j]) * __builtin_amdgcn_rcpf(fmaxf(bfhi(bw[j]), 1e-30f));
                        acc[ai][bj][m][j >> 1][2 * (j & 1)] *= r0; acc[ai][bj][m][j >> 1][2 * (j & 1) + 1] *= r1;
                    }
                }
                if (m & 1) asm volatile("" ::: "memory");
            }
    }
    __device__ __forceinline__ void operator()(const f32x4 (&acc)[2][2][4][2], const Unit& u, int wr, int wc, int fr, int fq) const {
        int row0 = u.pm * 256 + wr * 64 + fr, col0 = u.pn * 256 + wc * 32 + 8 * fq;
        asm volatile("" : "+v"(row0), "+v"(col0));
#pragma unroll
        for (int ai = 0; ai < 2; ++ai)
#pragma unroll
            for (int m = 0; m < 4; ++m)
#pragma unroll
                for (int bj = 0; bj < 2; ++bj) {
                    const size_t off = (size_t)(row0 + ai * 128 + m * 16) * 2048 + col0 + bj * 128;
                    const v4u s = *(const v4u*)(SB + off);
                    f32x4 v0 = acc[ai][bj][m][0], v1 = acc[ai][bj][m][1];
                    v0[0] *= fmaxf(bflo(s.x), 1e-30f); v0[1] *= fmaxf(bfhi(s.x), 1e-30f); v0[2] *= fmaxf(bflo(s.y), 1e-30f); v0[3] *= fmaxf(bfhi(s.y), 1e-30f);
                    v1[0] *= fmaxf(bflo(s.z), 1e-30f); v1[1] *= fmaxf(bfhi(s.z), 1e-30f); v1[2] *= fmaxf(bflo(s.w), 1e-30f); v1[3] *= fmaxf(bfhi(s.w), 1e-30f);
                    *(v4u*)(MB + off) = pack8(v0, v1);
                }
    }
};

struct Args { const float* in[20]; float* out; unsigned char* ws; int ph_lo, ph_hi; };

struct Frame {
    LAS unsigned char* lds;
    int wave, G, bx;
};
__device__ __forceinline__ int opaque_tid() { int t = threadIdx.x; asm volatile("" : "+v"(t)); return t; }
#define FTID (tid__)
#define FLANE (tid__ & 63)
#define TID_DECL() const int tid__ = opaque_tid()
__device__ __forceinline__ size_t opaque_zero() { size_t z = 0; asm volatile("" : "+s"(z)); return z; }
#define opaque_ptr(p) ((p) + opaque_zero())
__device__ __forceinline__ int opaque_int(int i) { asm volatile("" : "+s"(i)); return i; }
#define INP(i) (args.in[opaque_int(i)])

constexpr int I_GU = (DM / 64) * (2 * DFF / 32), I_D = (DFF / 64) * (DM / 32), I_IN = (DM / 64) * (INC / 32), I_UP = (DA / 64) * (DM / 32), I_OUT = (DM / 64) * (DM / 32);
constexpr int PER_LAYER = 2 * I_GU + 2 * I_D + I_IN + 2 * I_UP + I_OUT;
constexpr int IT_EARLY = I_GU + I_D + I_IN;
constexpr int SPARE_G = 227;
struct TrItem { const float* src; bf16* dst; int ldsrc, ldd; };
__device__ __forceinline__ TrItem tr_resolve(const Args& args, unsigned char* ws, int it) {
    const int l = it / PER_LAYER; int r = it % PER_LAYER;
    unsigned char* wl = ws + WS_W + (size_t)l * W_LAYER;
    const float* W; bf16* dst; int K, N, ldd, koff = 0; bool gu = false;
    if (r < I_GU) { W = INP(7) + (size_t)l * DM * 2 * DFF; K = DM; N = 2 * DFF; dst = (bf16*)(wl + WO_GU1); ldd = DM; gu = true; }
    else if ((r -= I_GU) < I_D) { W = INP(8) + (size_t)l * DFF * DM; K = DFF; N = DM; dst = (bf16*)(wl + WO_D1); ldd = DFF; }
    else if ((r -= I_D) < I_IN) { W = INP(11) + (size_t)l * DM * INC; K = DM; N = INC; dst = (bf16*)(wl + WO_IN); ldd = DM; }
    else if ((r -= I_IN) < I_UP) { W = INP(17) + (size_t)l * DA * DM; K = DA; N = DM; dst = (bf16*)(wl + WO_UP); ldd = 2 * DA; }
    else if ((r -= I_UP) < I_UP) { W = INP(18) + (size_t)l * DBB * DM; K = DBB; N = DM; dst = (bf16*)(wl + WO_UP); ldd = 2 * DA; koff = DA; }
    else if ((r -= I_UP) < I_OUT) { W = INP(19) + (size_t)l * DM * DM; K = DM; N = DM; dst = (bf16*)(wl + WO_OUT); ldd = DM; }
    else if ((r -= I_OUT) < I_GU) { W = INP(9) + (size_t)l * DM * 2 * DFF; K = DM; N = 2 * DFF; dst = (bf16*)(wl + WO_GU2); ldd = DM; gu = true; }
    else { r -= I_GU; W = INP(10) + (size_t)l * DFF * DM; K = DFF; N = DM; dst = (bf16*)(wl + WO_D2); ldd = DFF; }
    (void)K;
    const int nblk = N / 32, kb = r / nblk, nb = r % nblk;
    int sc0 = 32 * nb;
    if (gu) { const int tile = nb >> 3, within = 32 * (nb & 7); sc0 = (within < 128) ? (128 * tile + within) : (DFF + 128 * tile + within - 128); }
    TrItem t; t.src = W + (size_t)(64 * kb) * N + sc0; t.ldsrc = N; t.dst = dst + (size_t)(32 * nb) * ldd + koff + 64 * kb; t.ldd = ldd; return t;
}
__device__ __forceinline__ void tr_load(const TrItem& t, int lane, f32x4 (&v)[8]) {
    const int rr = lane >> 3, c4 = (lane & 7) * 4;
#pragma unroll
    for (int i = 0; i < 8; ++i) v[i] = __builtin_nontemporal_load((const f32x4*)(t.src + (size_t)(8 * i + rr) * t.ldsrc + c4));
}
__device__ __forceinline__ void tr_emit(const TrItem& t, int lane, const f32x4 (&v)[8], LAS float* scr) {
    const int rr = lane >> 3, c4 = (lane & 7) * 4;
#pragma unroll
    for (int i = 0; i < 8; ++i) { LAS float* s = scr + (8 * i + rr) * 33 + c4; s[0] = v[i][0]; s[1] = v[i][1]; s[2] = v[i][2]; s[3] = v[i][3]; }
    LDS_WAIT(); asm volatile("" ::: "memory");
    const int c = lane & 7;
#pragma unroll
    for (int j = 0; j < 4; ++j) { const int n = (lane >> 3) + 8 * j; const LAS float* s = scr + (8 * c) * 33 + n;
        v4u o; o.x = pk2(s[0 * 33], s[1 * 33]); o.y = pk2(s[2 * 33], s[3 * 33]); o.z = pk2(s[4 * 33], s[5 * 33]); o.w = pk2(s[6 * 33], s[7 * 33]);
        *(v4u*)(t.dst + (size_t)n * t.ldd + 8 * c) = o; }
    LDS_WAIT(); asm volatile("" ::: "memory");
}
__device__ __forceinline__ void convert_items(Frame& F, const Args& args, int it_lo, int it_hi, int iw, int nw) {
    TID_DECL();
    unsigned char* ws = opaque_ptr(args.ws);
    LAS float* scr = (LAS float*)(F.lds + RING_OFF + F.wave * 16384);
    int it = it_lo + iw;
    if (it < it_hi) {
        TrItem cur = tr_resolve(args, ws, it); f32x4 v[8]; tr_load(cur, FLANE, v);
        for (;;) {
            const int itn = it + nw; const bool more = itn < it_hi;
            TrItem nxt = cur; f32x4 vn[8];
            if (more) { nxt = tr_resolve(args, ws, itn); tr_load(nxt, FLANE, vn); }
            tr_emit(cur, FLANE, v, scr);
            if (!more) break;
#pragma unroll
            for (int i = 0; i < 8; ++i) v[i] = vn[i];
            cur = nxt; it = itn;
        }
    }
    __syncthreads();
}
__device__ __forceinline__ void mod_items(Frame& F, const Args& args, int iwg, int nwg) {
    TID_DECL();
    unsigned char* ws = opaque_ptr(args.ws);
    float* mod = (float*)(ws + WS_MOD);
    LAS float* sc = (LAS float*)(F.lds + RING_OFF);
    LAS float* red = (LAS float*)(F.lds + RING_OFF + 65536);
    for (int t = FTID; t < NGRP * DM; t += NWAVES * 64) { const int g = t >> 11, kk = t & (DM - 1);
        const float cv = (g < 4) ? INP(1)[g * DM + kk] : INP(3)[kk];
        sc[t] = cv / (1.0f + __expf(-cv)); }
    __syncthreads();
    constexpr int NB = NMOD * DM / 32;
    const int cg = FLANE & 7, kr = FLANE >> 3;
    for (int it = iwg; it < DEPTH * NB; it += nwg) {
        const int l = it / NB, nb = it % NB;
        const float* W = INP(4) + (size_t)l * DM * NMOD * DM + (size_t)(F.wave * 256 + kr) * (NMOD * DM) + nb * 32 + 4 * cg;
        f32x4 a[NGRP];
#pragma unroll
        for (int g = 0; g < NGRP; ++g) a[g] = (f32x4){0.f, 0.f, 0.f, 0.f};
#pragma unroll 8
        for (int i = 0; i < 32; ++i) { const f32x4 w = __builtin_nontemporal_load((const f32x4*)(W + (size_t)(8 * i) * (NMOD * DM)));
#pragma unroll
            for (int g = 0; g < NGRP; ++g) { const float sv = sc[g * DM + F.wave * 256 + 8 * i + kr]; a[g] += w * sv; } }
#pragma unroll
        for (int g = 0; g < NGRP; ++g)
#pragma unroll
            for (int c = 0; c < 4; ++c) { float v = a[g][c]; v += __shfl_xor(v, 8); v += __shfl_xor(v, 16); v += __shfl_xor(v, 32); a[g][c] = v; }
        if (kr == 0) {
#pragma unroll
            for (int g = 0; g < NGRP; ++g)
#pragma unroll
                for (int c = 0; c < 4; ++c) red[(F.wave * 8 + cg) * 20 + g * 4 + c] = a[g][c]; }
        __syncthreads();
        if (FTID < 160) { const int cgi = FTID / 20, v = FTID % 20, g = v >> 2, c = v & 3; float sum = 0.f;
#pragma unroll
            for (int w = 0; w < NWAVES; ++w) sum += red[(w * 8 + cgi) * 20 + v];
            const int n = nb * 32 + 4 * cgi + c;
            mod[(size_t)(l * NGRP + g) * NMOD * DM + n] = sum + INP(5)[(size_t)l * NMOD * DM + n]; }
        __syncthreads();
    }
}
__device__ __forceinline__ void p0_prologue(Frame& F, const Args& args) {
    TID_DECL();
    unsigned char* ws = opaque_ptr(args.ws);
    convert_items(F, args, 0, IT_EARLY, F.bx * NWAVES + F.wave, F.G * NWAVES);
    mod_items(F, args, F.bx, F.G);
    if (F.bx == 0) {
        float* lbt = (float*)(ws + WS_LBT);
        for (int idx = FTID; idx < 2 * DBB; idx += NWAVES * 64) {
            float z[DEPTH], mx = -3.0e38f, den = 0.f;
#pragma unroll
            for (int l = 0; l < DEPTH; ++l) { z[l] = INP(15)[l * 2 * DBB + idx]; mx = fmaxf(mx, z[l]); }
#pragma unroll
            for (int l = 0; l < DEPTH; ++l) { z[l] = __expf(z[l] - mx); den += z[l]; }
            float cum = 0.f; const float s0 = z[0] / den;
#pragma unroll
            for (int l = 0; l < DEPTH; ++l) { cum += z[l] / den; lbt[l * 2 * DBB + idx] = (l == 0) ? 0.f : (cum - s0); }
        }
    }
}
__device__ __forceinline__ void background_work(Frame& F, const Args& args, int slot) {
    const int iwg = F.bx - SPARE_G, nwg = F.G - SPARE_G, iw = iwg * NWAVES + F.wave, nw = nwg * NWAVES;
    constexpr int L1_HALF = PER_LAYER + PER_LAYER / 2;
    if (slot == 0) convert_items(F, args, IT_EARLY, PER_LAYER, iw, nw);
    else if (slot == 1) convert_items(F, args, PER_LAYER, L1_HALF, iw, nw);
    else convert_items(F, args, L1_HALF, 2 * PER_LAYER, iw, nw);
}

__device__ __forceinline__ int row_grp(int row) { return row < TX ? (row >> 11) : 4; }
template <int MODE, bool XIN = false>
__device__ __forceinline__ void thin_phase(Frame& F, const Args& args, int nrows, int nslab, const float* gpost, const float* mod_r, int gate_i, float w,
                                           const float* gpre, const float* mod_m, int shift_i, int scale_i) {
    TID_DECL();
    unsigned char* ws = opaque_ptr(args.ws);
    float* X = (float*)(ws + WS_X); bf16* H = (bf16*)(ws + WS_H);
    const int rpw = nrows / F.G, g0 = row_grp(32 * F.bx), g1 = 4;
    LAS float* VA = (LAS float*)(F.lds + RING_OFF);
    LAS float* VB = VA + 2 * DM;
    LAS float* VC = VB + 2 * DM;
    for (int t = FTID; t < 2 * DM; t += NWAVES * 64) { const int gi = t >> 11, n = t & (DM - 1), g = gi ? g1 : g0;
        if (MODE != 0) VA[t] = w * mod_r[(size_t)(g * NMOD + gate_i) * DM + n] * gpost[n];
        if (MODE != 2) { VB[t] = gpre[n] * (1.0f + mod_m[(size_t)(g * NMOD + scale_i) * DM + n]); VC[t] = mod_m[(size_t)(g * NMOD + shift_i) * DM + n]; } }
    __syncthreads();
    for (int rr = F.wave; rr < rpw; rr += NWAVES) {
        const int row = rr < 32 ? 32 * F.bx + rr : TX + 4 * F.bx + (rr - 32), gi = rr < 32 ? 0 : 1;
        f32x4 x[8];
        if (MODE == 0) {
            const float* src = row < TX ? INP(0) + (size_t)row * DM : INP(2) + (size_t)(row - TX) * DM;
#pragma unroll
            for (int j = 0; j < 8; ++j) x[j] = *(const f32x4*)(src + 4 * FLANE + 256 * j);
        } else {
            f32x4 y[8]; float s = 0.f;
            if (row < TX) {
                const bf16* Y16 = (const bf16*)(ws + WS_Y) + (size_t)row * DM + 4 * FLANE;
#pragma unroll
                for (int j = 0; j < 8; ++j) { const v2u w2 = *(const v2u*)(Y16 + 256 * j); y[j] = (f32x4){bflo(w2.x), bfhi(w2.x), bflo(w2.y), bfhi(w2.y)}; }
            } else {
                const bf16* YS = (const bf16*)(ws + WS_YS) + (size_t)(row - TX) * DM + 4 * FLANE;
#pragma unroll
                for (int j = 0; j < 8; ++j) { const v2u w2 = *(const v2u*)(YS + 256 * j); y[j] = (f32x4){bflo(w2.x), bfhi(w2.x), bflo(w2.y), bfhi(w2.y)}; }
#pragma unroll 1
                for (int sl = 1; sl < nslab; ++sl)
#pragma unroll
                    for (int j = 0; j < 8; ++j) { const v2u w2 = *(const v2u*)(YS + (size_t)sl * TC * DM + 256 * j); y[j] += (f32x4){bflo(w2.x), bfhi(w2.x), bflo(w2.y), bfhi(w2.y)}; }
            }
#pragma unroll
            for (int j = 0; j < 8; ++j) s += (y[j][0] * y[j][0] + y[j][1] * y[j][1]) + (y[j][2] * y[j][2] + y[j][3] * y[j][3]);
            const float r = 1.0f / sqrtf(wave_sum(s) * (1.0f / DM) + EPS);
            const float* xs = XIN ? (row < TX ? INP(0) + (size_t)row * DM : INP(2) + (size_t)(row - TX) * DM) : X + (size_t)row * DM;
#pragma unroll
            for (int j = 0; j < 8; ++j) { const f32x4 a = *(const LAS f32x4*)(VA + gi * DM + 4 * FLANE + 256 * j); x[j] = *(const f32x4*)(xs + 4 * FLANE + 256 * j) + a * y[j] * r; }
        }
        if (MODE == 2) {
#pragma unroll
            for (int j = 0; j < 8; ++j) *(f32x4*)(args.out + (size_t)row * DM + 4 * FLANE + 256 * j) = x[j];
        } else {
            float s = 0.f;
#pragma unroll
            for (int j = 0; j < 8; ++j) { if (MODE != 0) *(f32x4*)(X + (size_t)row * DM + 4 * FLANE + 256 * j) = x[j]; s += (x[j][0] * x[j][0] + x[j][1] * x[j][1]) + (x[j][2] * x[j][2] + x[j][3] * x[j][3]); }
            const float r = 1.0f / sqrtf(wave_sum(s) * (1.0f / DM) + EPS);
#pragma unroll
            for (int j = 0; j < 8; ++j) { const f32x4 b = *(const LAS f32x4*)(VB + gi * DM + 4 * FLANE + 256 * j), c = *(const LAS f32x4*)(VC + gi * DM + 4 * FLANE + 256 * j);
                const f32x4 h = x[j] * r * b + c; v2u o; o.x = pk2(h[0], h[1]); o.y = pk2(h[2], h[3]);
                *(v2u*)(H + (size_t)row * DM + 4 * FLANE + 256 * j) = o; }
        }
    }
    __syncthreads();
}

__device__ __forceinline__ void readout_phase(Frame& F, const Args& args, int nrows, const float* gain) {
    TID_DECL();
    unsigned char* ws = opaque_ptr(args.ws);
    const bf16* OF = (const bf16*)(ws + WS_OF); const bf16* OB = (const bf16*)(ws + WS_OB); const bf16* SG = (const bf16*)(ws + WS_SG); bf16* YAB = (bf16*)(ws + WS_YAB);
    const int gw = F.bx * NWAVES + F.wave, NGW = F.G * NWAVES;
    for (int row = gw; row < nrows; row += NGW) {
        const size_t off = (size_t)row * DBB + 16 * FLANE;
        const size_t hoff = hm_row(row) + (size_t)(FLANE >> 3) * SEQT * HDIM + 16 * (FLANE & 7);
        f32x4 o[4]; float s = 0.f;
#pragma unroll
        for (int j = 0; j < 4; ++j) { const v2u a2 = *(const v2u*)(OF + hoff + 4 * j), b2 = *(const v2u*)(OB + hoff + 4 * j);
            o[j] = (f32x4){bflo(a2.x) + bflo(b2.x), bfhi(a2.x) + bfhi(b2.x), bflo(a2.y) + bflo(b2.y), bfhi(a2.y) + bfhi(b2.y)}; s += (o[j][0] * o[j][0] + o[j][1] * o[j][1]) + (o[j][2] * o[j][2] + o[j][3] * o[j][3]); }
        s += __shfl_xor(s, 1); s += __shfl_xor(s, 2); s += __shfl_xor(s, 4);
        const float r = 1.0f / sqrtf(s * (1.0f / HDIM) + EPS);
        const v4u g0 = *(const v4u*)(SG + off), g1 = *(const v4u*)(SG + off + 8);
        const unsigned gw_[8] = {g0.x, g0.y, g0.z, g0.w, g1.x, g1.y, g1.z, g1.w};
        unsigned ow[8];
#pragma unroll
        for (int j = 0; j < 4; ++j) { const f32x4 gn = *(const f32x4*)(gain + 16 * FLANE + 4 * j);
            const float a0 = o[j][0] * r * gn[0] * bflo(gw_[2 * j]), a1 = o[j][1] * r * gn[1] * bfhi(gw_[2 * j]), a2 = o[j][2] * r * gn[2] * bflo(gw_[2 * j + 1]), a3 = o[j][3] * r * gn[3] * bfhi(gw_[2 * j + 1]);
            ow[2 * j] = pk2(a0, a1); ow[2 * j + 1] = pk2(a2, a3); }
        bf16* dst = YAB + (size_t)row * (2 * DA) + DA + 16 * FLANE;
        *(v4u*)dst = (v4u){ow[0], ow[1], ow[2], ow[3]}; *(v4u*)(dst + 8) = (v4u){ow[4], ow[5], ow[6], ow[7]};
    }
}

constexpr int GM_VNT = 0, GM_STAT = 128 * 272;
__device__ __forceinline__ void gmlp_unit(Frame& F, const Args& args, int row0, int g, const float* cng, const float* wsp, const float* bsp) {
    TID_DECL();
    unsigned char* ws = opaque_ptr(args.ws);
    const bf16* U = (const bf16*)(ws + WS_U); const bf16* V = (const bf16*)(ws + WS_V); bf16* YAB = (bf16*)(ws + WS_YAB);
    LAS unsigned char* vnT = F.lds + RING_OFF + GM_VNT; LAS float* stat = (LAS float*)(F.lds + RING_OFF + GM_STAT);
    if (FTID < 128) {
        const f32x4* p = (const f32x4*)((const float*)(ws + WS_VST) + (size_t)(row0 + FTID) * 32);
        float sm = 0.f, sq = 0.f;
#pragma unroll
        for (int k = 0; k < 8; ++k) { const f32x4 t = p[k]; sm += t[0] + t[2]; sq += t[1] + t[3]; }
        const float mean = sm * (1.0f / DA), var = fmaxf(sq * (1.0f / DA) - mean * mean, 0.f);
        stat[2 * FTID] = mean; stat[2 * FTID + 1] = 1.0f / sqrtf(var + EPS);
    }
    __syncthreads();
    for (int it = FTID; it < 128 * 16; it += NWAVES * 64) {
        const int s = it & 127, dd = it >> 7;
        const v4u a = *(const v4u*)(V + (size_t)(row0 + s) * DA + g * 128 + 8 * dd);
        const float mean = stat[2 * s], rstd = stat[2 * s + 1];
        const f32x4 g0 = *(const f32x4*)(cng + g * 128 + 8 * dd), g1 = *(const f32x4*)(cng + g * 128 + 8 * dd + 4);
        const unsigned wv[4] = {a.x, a.y, a.z, a.w};
#pragma unroll
        for (int j = 0; j < 4; ++j) {
            const float lo = (bflo(wv[j]) - mean) * rstd * (j < 2 ? g0[2 * j] : g1[2 * j - 4]), hi = (bfhi(wv[j]) - mean) * rstd * (j < 2 ? g0[2 * j + 1] : g1[2 * j - 3]);
            const unsigned p = pk2(lo, hi);
            *(LAS unsigned short*)(vnT + (8 * dd + 2 * j) * 272 + 2 * s) = (unsigned short)(p & 0xffffu);
            *(LAS unsigned short*)(vnT + (8 * dd + 2 * j + 1) * 272 + 2 * s) = (unsigned short)(p >> 16);
        }
    }
    __syncthreads();
    const int i = FLANE & 15, gq = FLANE >> 4;
    f32x4 acc[8];
#pragma unroll
    for (int md = 0; md < 8; ++md) acc[md] = (f32x4){0.f, 0.f, 0.f, 0.f};
    const float* wrow = wsp + ((size_t)g * 128 + 16 * F.wave + i) * 128;
#pragma unroll
    for (int kk = 0; kk < 4; ++kk) {
        const f32x4 w0 = *(const f32x4*)(wrow + 32 * kk + 8 * gq), w1 = *(const f32x4*)(wrow + 32 * kk + 8 * gq + 4);
        const v4u wb = pack8(w0, w1); bf16x8 bfrag; __builtin_memcpy(&bfrag, &wb, 16);
#pragma unroll
        for (int md = 0; md < 8; ++md) {
            const bf16x8 afrag = *(const LAS bf16x8*)(vnT + (16 * md + i) * 272 + (32 * kk + 8 * gq) * 2);
            acc[md] = __builtin_amdgcn_mfma_f32_16x16x32_bf16(afrag, bfrag, acc[md], 0, 0, 0);
        }
    }
    const int t = 16 * F.wave + i; const float bias = bsp[g * 128 + t];
#pragma unroll
    for (int md = 0; md < 8; ++md) {
        const size_t col = (size_t)g * 128 + 16 * md + 4 * gq;
        const v2u uu = *(const v2u*)(U + (size_t)(row0 + t) * DA + col);
        v2u o; o.x = pk2(bflo(uu.x) * (acc[md][0] + bias), bfhi(uu.x) * (acc[md][1] + bias)); o.y = pk2(bflo(uu.y) * (acc[md][2] + bias), bfhi(uu.y) * (acc[md][3] + bias));
        *(v2u*)(YAB + (size_t)(row0 + t) * (2 * DA) + col) = o;
    }
    __syncthreads();
}

constexpr int SC_QS = 0, SC_KS = 17408, SC_KET = 34816, SC_VT = 53248, SC_DD = 71680, SC_AT = 73728;
constexpr int SEGLEN = (CTXL + SEQ) / 4, SEG_GROUPS = SEGLEN / 64;
__device__ __forceinline__ int scan_tau(int dir, int sigma) { return dir ? (sigma < CTXL ? CTXL - 1 - sigma : SEQT + CTXL - 1 - sigma) : sigma; }
struct ScanRegs { f32x4 lf[4]; v2u qv[4], vv[4]; };
template <bool FULL>
__device__ __forceinline__ void scan_load(ScanRegs& R, const float* LG, const bf16* Q, const bf16* VI, int dir, int sigma0, int c0) {
#pragma unroll
    for (int p = 0; p < 4; ++p) { const size_t ro = (size_t)scan_tau(dir, sigma0 + p) * HDIM + c0;
        R.lf[p] = *(const f32x4*)(LG + ro); R.vv[p] = *(const v2u*)(VI + ro); if (FULL) R.qv[p] = *(const v2u*)(Q + ro); }
}
template <bool FULL>
__device__ __forceinline__ void scan_stage1(const ScanRegs& R, LAS unsigned char* L, int sb1, int c0, int qi, int lane, f32x4& atot) {
    f32x4 a[4]; a[0] = R.lf[0]; a[1] = a[0] + R.lf[1]; a[2] = a[1] + R.lf[2]; a[3] = a[2] + R.lf[3];
    f32x4 inc = a[3], a15;
#pragma unroll
    for (int c = 0; c < 4; ++c) { float v = inc[c]; float t = __shfl_up(v, 16); if (qi >= 1) v += t; t = __shfl_up(v, 32); if (qi >= 2) v += t; inc[c] = v; a15[c] = __shfl(v, 48 + (lane & 15)); }
    const f32x4 excl = inc - a[3];
    float kef[4][4];
#pragma unroll
    for (int p = 0; p < 4; ++p) {
        const f32x4 ap = a[p] + excl;
        f32x4 kf4;
#pragma unroll
        for (int c = 0; c < 4; ++c) { kf4[c] = 1.0f - __expf(R.lf[p][c]); kef[p][c] = kf4[c] * __expf(a15[c] - ap[c]); }
        if (FULL) {
            const f32x4 qf4 = (f32x4){bflo(R.qv[p].x), bfhi(R.qv[p].x), bflo(R.qv[p].y), bfhi(R.qv[p].y)};
            f32x4 qs, ks;
#pragma unroll
            for (int c = 0; c < 4; ++c) { qs[c] = qf4[c] * __expf(ap[c]); ks[c] = kf4[c] * __expf(fminf(-ap[c], 80.f)); }
            const int ro = (sb1 * 16 + 4 * qi + p) * 272 + 2 * c0;
            *(LAS v2u*)(L + SC_QS + ro) = (v2u){pk2(qs[0], qs[1]), pk2(qs[2], qs[3])};
            *(LAS v2u*)(L + SC_KS + ro) = (v2u){pk2(ks[0], ks[1]), pk2(ks[2], ks[3])};
        }
    }
    const int to = sb1 * 4608 + qi * 1152 + c0 * 8;
    *(LAS v4u*)(L + SC_KET + to) = (v4u){pk2(kef[0][0], kef[1][0]), pk2(kef[2][0], kef[3][0]), pk2(kef[0][1], kef[1][1]), pk2(kef[2][1], kef[3][1])};
    *(LAS v4u*)(L + SC_KET + to + 16) = (v4u){pk2(kef[0][2], kef[1][2]), pk2(kef[2][2], kef[3][2]), pk2(kef[0][3], kef[1][3]), pk2(kef[2][3], kef[3][3])};
    const unsigned v00 = R.vv[0].x, v01 = R.vv[0].y, v10 = R.vv[1].x, v11 = R.vv[1].y, v20 = R.vv[2].x, v21 = R.vv[2].y, v30 = R.vv[3].x, v31 = R.vv[3].y;
    *(LAS v4u*)(L + SC_VT + to) = (v4u){(v00 & 0xffffu) | (v10 << 16), (v20 & 0xffffu) | (v30 << 16), (v00 >> 16) | (v10 & 0xffff0000u), (v20 >> 16) | (v30 & 0xffff0000u)};
    *(LAS v4u*)(L + SC_VT + to + 16) = (v4u){(v01 & 0xffffu) | (v11 << 16), (v21 & 0xffffu) | (v31 << 16), (v01 >> 16) | (v11 & 0xffff0000u), (v21 >> 16) | (v31 & 0xffff0000u)};
    if (qi == 3) *(LAS f32x4*)(L + SC_DD + (sb1 * 128 + c0) * 4) = (f32x4){__expf(a15[0]), __expf(a15[1]), __expf(a15[2]), __expf(a15[3])};
    atot += a15;
}
template <bool FULL>
__device__ __forceinline__ void scan_stage2(f32x4 (&S)[8], LAS unsigned char* L, bf16* O, int dir, int sigma0, bool do_out, int i, int gq, int eb) {
#pragma unroll 1
    for (int sb = 0; sb < 4; ++sb) {
        const v2u vraw = *(const LAS v2u*)(L + SC_VT + sb * 4608 + gq * 1152 + (eb + i) * 8);
        const v4u vw = (v4u){vraw.x, vraw.y, 0u, 0u}; bf16x8 vf; __builtin_memcpy(&vf, &vw, 16);
        if (FULL && do_out) {
            f32x4 P = (f32x4){0.f, 0.f, 0.f, 0.f};
#pragma unroll
            for (int kk = 0; kk < 4; ++kk) {
                const bf16x8 af = *(const LAS bf16x8*)(L + SC_KS + (sb * 16 + i) * 272 + (32 * kk + 8 * gq) * 2);
                const bf16x8 bfr = *(const LAS bf16x8*)(L + SC_QS + (sb * 16 + i) * 272 + (32 * kk + 8 * gq) * 2);
                P = __builtin_amdgcn_mfma_f32_16x16x32_bf16(af, bfr, P, 0, 0, 0);
            }
#pragma unroll
            for (int r = 0; r < 4; ++r) P[r] = (4 * gq + r <= i) ? P[r] : 0.f;
            const v4u pw = (v4u){pk2(P[0], P[1]), pk2(P[2], P[3]), 0u, 0u}; bf16x8 pb; __builtin_memcpy(&pb, &pw, 16);
            f32x4 Oa = __builtin_amdgcn_mfma_f32_16x16x32_bf16(vf, pb, (f32x4){0.f, 0.f, 0.f, 0.f}, 0, 0, 0);
#pragma unroll
            for (int kk = 0; kk < 4; ++kk) {
                const v4u sw = (v4u){pk2(S[2 * kk][0], S[2 * kk][1]), pk2(S[2 * kk][2], S[2 * kk][3]), pk2(S[2 * kk + 1][0], S[2 * kk + 1][1]), pk2(S[2 * kk + 1][2], S[2 * kk + 1][3])};
                bf16x8 sf; __builtin_memcpy(&sf, &sw, 16);
                const v2u q0 = *(const LAS v2u*)(L + SC_QS + (sb * 16 + i) * 272 + (32 * kk + 4 * gq) * 2), q1 = *(const LAS v2u*)(L + SC_QS + (sb * 16 + i) * 272 + (32 * kk + 16 + 4 * gq) * 2);
                const v4u qw = (v4u){q0.x, q0.y, q1.x, q1.y}; bf16x8 qb; __builtin_memcpy(&qb, &qw, 16);
                Oa = __builtin_amdgcn_mfma_f32_16x16x32_bf16(sf, qb, Oa, 0, 0, 0);
            }
            *(v2u*)(O + (size_t)scan_tau(dir, sigma0 + sb * 16 + i) * HDIM + eb + 4 * gq) = (v2u){pk2_sw(Oa[0], Oa[1]), pk2_sw(Oa[2], Oa[3])};
        }
#pragma unroll
        for (int tt = 0; tt < 8; ++tt) {
            const f32x4 dd = *(const LAS f32x4*)(L + SC_DD + (sb * 128 + 16 * tt + 4 * gq) * 4);
            const v2u kraw = *(const LAS v2u*)(L + SC_KET + sb * 4608 + gq * 1152 + (16 * tt + i) * 8);
            const v4u kw = (v4u){kraw.x, kraw.y, 0u, 0u}; bf16x8 kf; __builtin_memcpy(&kf, &kw, 16);
            S[tt] = __builtin_amdgcn_mfma_f32_16x16x32_bf16(kf, vf, S[tt] * dd, 0, 0, 0);
        }
    }
}
template <bool FULL>
__device__ __forceinline__ void scan_pass(Frame& F, const Args& args, int b, int h, int dir, int seg, bool ctx_out) {
    TID_DECL();
    unsigned char* ws = opaque_ptr(args.ws);
    const size_t hb = (size_t)(b * NHEAD + h) * SEQT * HDIM;
    const bf16* Q = (const bf16*)(ws + WS_Q) + hb; const bf16* VI = (const bf16*)(ws + WS_VI) + hb;
    const float* LG = (const float*)(ws + (dir ? WS_LB : WS_LF)) + hb; bf16* O = (bf16*)(ws + (dir ? WS_OB : WS_OF)) + hb;
    f32x4* SLOC = (f32x4*)(ws + WS_SLOC); float* ATOT = (float*)(ws + WS_ATOT);
    const int unit = ((seg * 2 + dir) * NHEAD + h) * BATCH + b;
    LAS unsigned char* L = F.lds + RING_OFF;
    const int sb1 = F.wave >> 1, c0 = 64 * (F.wave & 1) + 4 * (FLANE & 15), qi = FLANE >> 4;
    const int i = FLANE & 15, gq = FLANE >> 4, eb = 16 * F.wave;
    f32x4 S[8];
#pragma unroll
    for (int tt = 0; tt < 8; ++tt) S[tt] = (f32x4){0.f, 0.f, 0.f, 0.f};
    if (FULL) {
        for (int j = 0; j < seg; ++j) { const int uj = ((j * 2 + dir) * NHEAD + h) * BATCH + b;
#pragma unroll
            for (int tt = 0; tt < 8; ++tt) { const f32x4 at = *(const f32x4*)(ATOT + (size_t)uj * HDIM + 16 * tt + 4 * gq);
                const f32x4 dec = (f32x4){__expf(at[0]), __expf(at[1]), __expf(at[2]), __expf(at[3])};
                S[tt] = S[tt] * dec + SLOC[((size_t)(uj * 8 + F.wave) * 8 + tt) * 64 + FLANE]; } }
    }
    f32x4 atot = (f32x4){0.f, 0.f, 0.f, 0.f};
    const int g_lo = seg * SEG_GROUPS, g_hi = g_lo + SEG_GROUPS, pos1 = sb1 * 16 + 4 * qi;
    ScanRegs RA, RB;
    scan_load<FULL>(RA, LG, Q, VI, dir, g_lo * 64 + pos1, c0);
    scan_load<FULL>(RB, LG, Q, VI, dir, (g_lo + 1) * 64 + pos1, c0);
    for (int gi = g_lo; gi < g_hi; gi += 2) {
        __syncthreads();
        scan_stage1<FULL>(RA, L, sb1, c0, qi, FLANE, atot);
        if (gi + 2 < g_hi) scan_load<FULL>(RA, LG, Q, VI, dir, (gi + 2) * 64 + pos1, c0);
        __syncthreads();
        scan_stage2<FULL>(S, L, O, dir, gi * 64, ctx_out || gi >= CTXL / 64, i, gq, eb);
        if (gi + 1 >= g_hi) break;
        __syncthreads();
        scan_stage1<FULL>(RB, L, sb1, c0, qi, FLANE, atot);
        if (gi + 3 < g_hi) scan_load<FULL>(RB, LG, Q, VI, dir, (gi + 3) * 64 + pos1, c0);
        __syncthreads();
        scan_stage2<FULL>(S, L, O, dir, (gi + 1) * 64, ctx_out || gi + 1 >= CTXL / 64, i, gq, eb);
    }
    if (!FULL) {
#pragma unroll
        for (int tt = 0; tt < 8; ++tt) SLOC[((size_t)(unit * 8 + F.wave) * 8 + tt) * 64 + FLANE] = S[tt];
        __syncthreads();
        LAS float* AT = (LAS float*)(L + SC_AT);
        if (qi == 0) *(LAS f32x4*)(AT + F.wave * 64 + 4 * (FLANE & 15)) = atot;
        __syncthreads();
        if (FTID < HDIM) { const int chh = FTID >> 6, cc = FTID & 63; ATOT[(size_t)unit * HDIM + FTID] = (AT[(0 + chh) * 64 + cc] + AT[(2 + chh) * 64 + cc]) + (AT[(4 + chh) * 64 + cc] + AT[(6 + chh) * 64 + cc]); }
    }
    __syncthreads();
}

constexpr int NPH_LAYER = 13, NPHASES = 2 + DEPTH * NPH_LAYER;
__global__ void __launch_bounds__(NWAVES * 64, 2) mk_fwd(Args args) {
    TID_DECL();
    extern __shared__ __attribute__((aligned(16))) unsigned char lds[];
    Frame F;
    F.lds = (LAS unsigned char*)lds;
    F.wave = __builtin_amdgcn_readfirstlane(FTID >> 6);
    F.G = gridDim.x; F.bx = blockIdx.x;
    for (int u = FTID; u < (LDS_BYTES - LDSCTL_OFF) / 4; u += NWAVES * 64) ((LAS unsigned*)(F.lds + LDSCTL_OFF))[u] = 0u;
    __syncthreads();
    XcdBarrier bar = xcd_barrier_post((unsigned*)(args.ws + WS_CTL) + CW_BAR, (volatile LAS unsigned*)(F.lds + MISC_OFF) + 8);
    const int lo = args.ph_lo, hi = args.ph_hi;
#define IN(k) (lo <= (k) && (k) < hi)
    unsigned long long probe_t = (PROBE_PHASE >= 0) ? __builtin_amdgcn_s_memrealtime() : 0ull; const unsigned long long probe_t0 = probe_t;
#define SEAM(k) do { if (IN(k) && IN((k) + 1)) xcd_barrier(bar); \
        if (PROBE_PHASE >= 0) { const unsigned long long tn_ = __builtin_amdgcn_s_memrealtime(); \
            if ((k) == PROBE_PHASE) { const unsigned long long w_ = (unsigned long long)PROBE_MULT * (tn_ - probe_t); while (__builtin_amdgcn_s_memrealtime() - tn_ < w_) __builtin_amdgcn_s_sleep(8); } \
            probe_t = __builtin_amdgcn_s_memrealtime(); } } while (0)
    using pg8::Gemm; using pg8::RectOrder; using pg8::gemm_phase;
    LAS unsigned char* ring = F.lds + RING_OFF;
#define WSB() unsigned char* ws = opaque_ptr(args.ws)
#define MODALL ((const float*)(ws + WS_MOD))
#define NORMG(l_) (INP(6) + (size_t)(l_) * NNORM * DM)
#define MODL(l_) (MODALL + (size_t)(l_) * NGRP * NMOD * DM)
#define WL(l_) (ws + WS_W + (size_t)(l_) * W_LAYER)

    if (IN(0)) { _Pragma("nounroll") for (int rep = 0; rep < REP_P0; ++rep) { p0_prologue(F, args); __syncthreads(); } }
    SEAM(0);
    if (IN(1)) { WSB(); _Pragma("nounroll") for (int rep = 0; rep < REP_THIN; ++rep) thin_phase<0>(F, args, TT, 0, nullptr, nullptr, 0, 0.f, NORMG(0), MODALL, 0, 1); }
    SEAM(1);
#pragma nounroll
    for (int l = 0; l < DEPTH; ++l) {
        const int pb = 2 + l * NPH_LAYER; const bool lastl = (l == DEPTH - 1);
        const int npan_late = lastl ? TX / 256 : TT / 256;
        const int gG = (l == 0) ? SPARE_G : F.G;
        if (IN(pb + 0)) { if (F.bx >= gG) background_work(F, args, 0); else {
            WSB(); Gemm g{(const bf16*)(ws + WS_H), (const bf16*)(WL(l) + WO_GU1), DM, DM}; RectOrder S{0, TT / 256, 0, 2 * DFF / 256, 0, 0, 0, 0, 1, 0, 0, DM / 64, gG, F.bx}; EpiGU E{(bf16*)(ws + WS_ACT)};
            _Pragma("nounroll") for (int rep = 0; rep < REP_GEMM; ++rep) gemm_phase<EpiGU, RectOrder, true, true>(ring, g, S, E, (unsigned)(F.bx & 7) * STAG_GU); } }
        SEAM(pb + 0);
        if (IN(pb + 1)) { WSB(); Gemm g{(const bf16*)(ws + WS_ACT), (const bf16*)(WL(l) + WO_D1), DFF, DFF}; RectOrder S{0, TX / 256, 0, DM / 256, TX / 256, TC / 256, 0, DM / 256, NSLAB, 12, 10, DFF / 64, F.G, F.bx}; EpiY E{(bf16*)(ws + WS_Y), (bf16*)(ws + WS_YS)};
            _Pragma("nounroll") for (int rep = 0; rep < REP_GEMM; ++rep) gemm_phase<EpiY, RectOrder, true, true>(ring, g, S, E); }
        SEAM(pb + 1);
        if (IN(pb + 2)) { WSB(); _Pragma("nounroll") for (int rep = 0; rep < REP_THIN; ++rep) { if (l == 0 && rep == 0) thin_phase<1, true>(F, args, TT, NSLAB, NORMG(l) + 1 * DM, MODL(l), 2, 0.5f, NORMG(l) + 2 * DM, MODL(l), 3, 4);
            else thin_phase<1>(F, args, TT, NSLAB, NORMG(l) + 1 * DM, MODL(l), 2, rep ? 0.f : 0.5f, NORMG(l) + 2 * DM, MODL(l), 3, 4); } }
        SEAM(pb + 2);
        if (IN(pb + 3)) { if (F.bx >= gG) background_work(F, args, 1); else {
            WSB(); Gemm g{(const bf16*)(ws + WS_H), (const bf16*)(WL(l) + WO_IN), DM, DM};
            RectOrder S{0, lastl ? TX / 256 : TT / 256, 0, INC / 256, TX / 256, lastl ? TC / 256 : 0, 12, 12, 1, 0, 0, DM / 64, gG, F.bx};
            EpiIN E{(bf16*)(ws + WS_U), (bf16*)(ws + WS_V), (bf16*)(ws + WS_Q), (bf16*)(ws + WS_VI), (bf16*)(ws + WS_SG), (bf16*)(ws + WS_SA), (bf16*)(ws + WS_SB),
                    (float*)(ws + WS_LF), (float*)(ws + WS_LB), (const float*)(ws + WS_LBT) + (size_t)l * 2 * DBB, (float*)(ws + WS_VST)};
            _Pragma("nounroll") for (int rep = 0; rep < REP_GEMM; ++rep) gemm_phase<EpiIN, RectOrder, true, true>(ring, g, S, E, (unsigned)(F.bx & 7) * STAG_IN); } }
        SEAM(pb + 3);
        if (IN(pb + 4)) {
            if (F.bx < 192) { _Pragma("nounroll") for (int rep = 0; rep < REP_S1 * REP_SA; ++rep)
                scan_pass<false>(F, args, F.bx & 3, (F.bx >> 2) & 7, (F.bx >> 5) & 1, F.bx >> 6, !lastl); }
            _Pragma("nounroll") for (int rep = 0; rep < REP_S1 * REP_GMLP; ++rep) {
            const int n3 = lastl ? 5 : 6;
            const int u_lo = F.bx >= 192 ? (F.bx - 192) * n3 : 64 * n3 + F.bx, u_hi = u_lo + (F.bx >= 192 ? n3 : 1);
            for (int it = u_lo; it < u_hi; ++it)
                gmlp_unit(F, args, (it >> 3) * 128, it & 7, INP(12) + (size_t)l * DA, INP(13) + (size_t)l * 8 * 128 * 128, INP(14) + (size_t)l * 8 * 128);
            }
        }
        SEAM(pb + 4);
        if (IN(pb + 5)) { _Pragma("nounroll") for (int rep = 0; rep < REP_S1 * REP_SB; ++rep) scan_pass<true>(F, args, F.bx & 3, (F.bx >> 2) & 7, (F.bx >> 5) & 1, F.bx >> 6, !lastl); }
        SEAM(pb + 5);
        if (IN(pb + 6)) { _Pragma("nounroll") for (int rep = 0; rep < REP_THIN; ++rep) readout_phase(F, args, npan_late * 256, INP(16) + (size_t)l * DBB); }
        SEAM(pb + 6);
        if (IN(pb + 7)) { WSB(); RectOrder S{0, npan_late, 0, DM / 256, 0, 0, 0, 0, 1, 0, 0, 2 * DA / 64, F.G, F.bx};
            Gemm g{(const bf16*)(ws + WS_YAB), (const bf16*)(WL(l) + WO_UP), 2 * DA, 2 * DA}; EpiMerge E{(const bf16*)(ws + WS_SA), (const bf16*)(ws + WS_SB), (bf16*)(ws + WS_MB)};
            _Pragma("nounroll") for (int rep = 0; rep < REP_GEMM; ++rep) gemm_phase<EpiMerge, RectOrder, true, true>(ring, g, S, E); }
        SEAM(pb + 7);
        if (IN(pb + 8)) { WSB(); Gemm g{(const bf16*)(ws + WS_MB), (const bf16*)(WL(l) + WO_OUT), DM, DM}; RectOrder S{0, TX / 256, 0, DM / 256, TX / 256, lastl ? 0 : TC / 256, 0, DM / 256, NSLAB_OUT, 8, 8, DM / 64, F.G, F.bx}; EpiY E{(bf16*)(ws + WS_Y), (bf16*)(ws + WS_YS)};
            _Pragma("nounroll") for (int rep = 0; rep < REP_GEMM; ++rep) gemm_phase<EpiY, RectOrder, true, true>(ring, g, S, E); }
        SEAM(pb + 8);
        if (IN(pb + 9)) { WSB(); _Pragma("nounroll") for (int rep = 0; rep < REP_THIN; ++rep) thin_phase<1>(F, args, npan_late * 256, NSLAB_OUT, NORMG(l) + 3 * DM, MODL(l), 5, rep ? 0.f : 1.0f, NORMG(l) + 4 * DM, MODL(l), 6, 7); }
        SEAM(pb + 9);
        if (IN(pb + 10)) { if (F.bx >= gG) background_work(F, args, 2); else {
            WSB(); Gemm g{(const bf16*)(ws + WS_H), (const bf16*)(WL(l) + WO_GU2), DM, DM}; RectOrder S{0, npan_late, 0, 2 * DFF / 256, 0, 0, 0, 0, 1, 0, 0, DM / 64, gG, F.bx}; EpiGU E{(bf16*)(ws + WS_ACT)};
            _Pragma("nounroll") for (int rep = 0; rep < REP_GEMM; ++rep) gemm_phase<EpiGU, RectOrder, true, true>(ring, g, S, E, (unsigned)(F.bx & 7) * STAG_GU); } }
        SEAM(pb + 10);
        if (IN(pb + 11)) { WSB(); Gemm g{(const bf16*)(ws + WS_ACT), (const bf16*)(WL(l) + WO_D2), DFF, DFF}; RectOrder S{0, TX / 256, 0, DM / 256, TX / 256, lastl ? 0 : TC / 256, 0, DM / 256, NSLAB, 12, 10, DFF / 64, F.G, F.bx}; EpiY E{(bf16*)(ws + WS_Y), (bf16*)(ws + WS_YS)};
            _Pragma("nounroll") for (int rep = 0; rep < REP_GEMM; ++rep) gemm_phase<EpiY, RectOrder, true, true>(ring, g, S, E); }
        SEAM(pb + 11);
        if (IN(pb + 12)) { WSB();
            if (lastl) _Pragma("nounroll") for (int rep = 0; rep < REP_THIN; ++rep) thin_phase<2>(F, args, TX, 0, NORMG(l) + 5 * DM, MODL(l), 8, 0.5f, nullptr, nullptr, 0, 0);
            else _Pragma("nounroll") for (int rep = 0; rep < REP_THIN; ++rep) thin_phase<1>(F, args, TT, NSLAB, NORMG(l) + 5 * DM, MODL(l), 8, rep ? 0.f : 0.5f, NORMG(l + 1), MODL(l + 1), 0, 1);
        }
        if (!lastl) SEAM(pb + 12);
    }
    if (PROBE_PHASE == 99 && F.bx == 0) { const unsigned long long tn_ = __builtin_amdgcn_s_memrealtime(), w_ = tn_ - probe_t0; while (__builtin_amdgcn_s_memrealtime() - tn_ < w_) __builtin_amdgcn_s_sleep(8); }
#undef IN
#undef SEAM
}

extern "C" void kernel_launch(void* const* d_in, const int* in_sizes, int n_in, void* d_out, int out_size, void* d_ws, size_t ws_size, hipStream_t stream) {
    static int grid = 0;
    if (grid == 0) {
        if (n_in != 20 || in_sizes[0] != TX * DM || out_size != TX * DM || ws_size < WS_END) {
            fprintf(stderr, "kernel_launch: unexpected shapes / workspace (n_in %d, in0 %d, out %d, ws %zu, need %zu); nothing launched\n", n_in, n_in > 0 ? in_sizes[0] : -1, out_size, ws_size, (size_t)WS_END); grid = -1; return; }
        int dev = 0, cus = 0, per_cu = 0;
        if (hipGetDevice(&dev) != hipSuccess || hipDeviceGetAttribute(&cus, hipDeviceAttributeMultiprocessorCount, dev) != hipSuccess) { grid = -1; return; }
        if (hipFuncSetAttribute((const void*)mk_fwd, hipFuncAttributeMaxDynamicSharedMemorySize, LDS_BYTES) != hipSuccess) { fprintf(stderr, "kernel_launch: hipFuncSetAttribute failed\n"); grid = -1; return; }
        if (hipOccupancyMaxActiveBlocksPerMultiprocessor(&per_cu, (const void*)mk_fwd, NWAVES * 64, LDS_BYTES) != hipSuccess || per_cu < 1)
            fprintf(stderr, "kernel_launch: note: occupancy query reports %d workgroups per CU\n", per_cu);
        (void)hipGetLastError();
        grid = cus;
        if (grid != 256) fprintf(stderr, "kernel_launch: note: %d CUs\n", grid);
    }
    if (grid < 0) return;
    if (hipMemsetAsync((char*)d_ws, 0, ZERO_BYTES, stream) != hipSuccess) { fprintf(stderr, "kernel_launch: memset failed\n"); return; }
    Args a{};
    for (int i = 0; i < 20; ++i) a.in[i] = (const float*)d_in[i];
    a.out = (float*)d_out; a.ws = (unsigned char*)d_ws;
#if MK_PER_PHASE
    for (int p = 0; p < NPHASES; ++p) { a.ph_lo = p; a.ph_hi = p + 1; hipLaunchKernelGGL(mk_fwd, dim3(grid), dim3(NWAVES * 64), LDS_BYTES, stream, a); }
#else
    a.ph_lo = 0; a.ph_hi = NPHASES;
    hipLaunchKernelGGL(mk_fwd, dim3(grid), dim3(NWAVES * 64), LDS_BYTES, stream, a);
#endif
    const hipError_t le = hipPeekAtLastError();
    if (le != hipSuccess) fprintf(stderr, "kernel_launch: launch failed: %s\n", hipGetErrorName(le));
}
```

```cpp
#include <hip/hip_runtime.h>
#include <cstdio>
#include <cstdint>

#ifndef STAG_GU
#define STAG_GU 0
#endif
#ifndef STAG_IN
#define STAG_IN 0
#endif
#ifndef REP_GEMM
#define REP_GEMM 1
#endif
#ifndef REP_P0
#define REP_P0 1
#endif
#ifndef REP_S1
#define REP_S1 1
#endif
#ifndef REP_GMLP
#define REP_GMLP 1
#endif
#ifndef REP_SA
#define REP_SA 1
#endif
#ifndef REP_SB
#define REP_SB 1
#endif
#ifndef REP_THIN
#define REP_THIN 1
#endif
#ifndef PROBE_PHASE
#define PROBE_PHASE (-1)
#endif
#ifndef PROBE_MULT
#define PROBE_MULT 9
#endif
#ifndef MK_PER_PHASE
#define MK_PER_PHASE 0
#endif

namespace pg8 {
#define PG8_LAS __attribute__((address_space(3)))
typedef unsigned short bf16_t;
typedef short bf16x8 __attribute__((ext_vector_type(8)));
typedef float f32x4 __attribute__((ext_vector_type(4)));
typedef unsigned u32x4 __attribute__((ext_vector_type(4)));
constexpr int BM = 256, BK = 64, HALF = 128, HTB = HALF * BK * 2, STAGE_BYTES = 8 * HTB, NXCD = 8, WGM = 8;

__host__ __device__ __forceinline__ int lds_byte(int r, int c) { const int st = (r >> 4) * 2 + (c >> 5), rr = r & 15, cc = c & 31, ob = rr * 64 + cc * 2; return st * 1024 + (ob ^ (((ob >> 9) & 1) << 5)); }
__host__ __device__ __forceinline__ void stage_rc(int b, int& R, int& C) { const int st = b / 1024, sb = b % 1024, swz = sb ^ (((sb >> 9) & 1) << 5); R = (st >> 1) * 16 + swz / 64; C = (st & 1) * 32 + (swz % 64) / 2; }
__host__ __device__ __forceinline__ int perm32(int rho) { const int n = rho >> 4, i = rho & 15; return 8 * (i >> 2) + 4 * n + (i & 3); }

struct Unit { int pm, pn, kt0, nkt, slab; };
struct Gemm { const bf16_t* A; const bf16_t* Bt; int lda, ldb; };

struct RectOrder {
    int pma, nma, pna, nna, pmb, nmb, pnb, nnb, nsl, kA, kB, KT, G, c;
    __device__ __forceinline__ void map(int wgid, int nM, int nN, int pm0, int pn0, Unit& u) const {
        const int nwg = nM * nN;
        { const int q = nwg / NXCD, r = nwg % NXCD, xcd = wgid % NXCD, off = wgid / NXCD; wgid = (xcd < r ? xcd * (q + 1) : r * (q + 1) + (xcd - r) * q) + off; }
        const int nig = WGM * nN, gid = wgid / nig, fm = gid * WGM, gsz = (nM - fm) < WGM ? (nM - fm) : WGM;
        u.pm = pm0 + fm + ((wgid % nig) % gsz); u.pn = pn0 + (wgid % nig) / gsz;
    }
    __device__ __forceinline__ bool next(int i, Unit& u) const {
        long L = (long)i * G + c; const int na = nma * nna;
        if (L < na) { map((int)L, nma, nna, pma, pna, u); u.kt0 = 0; u.nkt = KT; u.slab = -1; return true; }
        L -= na; const int nb1 = nmb * nnb;
        if (L < (long)nb1 * nsl) { const int sl = (int)(L / nb1); map((int)(L % nb1), nmb, nnb, pmb, pnb, u);
            if (nsl > 1) { u.kt0 = (sl >> 1) * (kA + kB) + (sl & 1) * kA; u.nkt = (sl & 1) ? kB : kA; u.slab = sl; } else { u.kt0 = 0; u.nkt = KT; u.slab = -1; }
            return true; }
        return false;
    }
    __device__ __forceinline__ void a_ready(const Unit&) const {}
    __device__ __forceinline__ void done(const Unit&) const {}
};

__device__ __forceinline__ unsigned cvt_pk_bf16(float lo, float hi) { unsigned r; asm volatile("v_cvt_pk_bf16_f32 %0, %1, %2" : "=v"(r) : "v"(lo), "v"(hi)); return r; }

template <class Epi, class Sched, bool ALIGN_EPI = false, bool SP2 = false>
__device__ __forceinline__ void gemm_phase(PG8_LAS unsigned char* lds, const Gemm g, const Sched& S, const Epi& E, unsigned stagger = 0u) {
    int tid_ = threadIdx.x; asm volatile("" : "+v"(tid_));
    const int tid = tid_, wid = __builtin_amdgcn_readfirstlane(tid >> 6), lane = tid & 63, wr = wid >> 2, wc = wid & 3, fr = lane & 15, fq = lane >> 4;
    unsigned voffA[2], voffB[2];
#pragma unroll
    for (int i = 0; i < 2; ++i) { int R, C; stage_rc(tid * 16 + i * 8192, R, C);
        const int Rb = Epi::PERM2 ? (64 * (R >> 5) + perm32(R & 31)) : (Epi::PERM ? ((R & ~31) + perm32(R & 31)) : R);
        voffA[i] = (unsigned)(R * g.lda + C) * 2u; voffB[i] = (unsigned)(Rb * g.ldb + C) * 2u; }
    const size_t kstep = (size_t)(BK * 2);
    const size_t hstepA = (size_t)HALF * g.lda * 2, hstepB = (size_t)(Epi::PERM2 ? 32 : HALF) * g.ldb * 2;
    const size_t tstepA = 2 * hstepA, tstepB = (size_t)BM * g.ldb * 2;
    const unsigned ldsw = (unsigned)wid * 1024u;
    const int aoff = lds_byte(wr * 64 + fr, fq * 8), boff = lds_byte(wc * 32 + fr, fq * 8);
#define PG8_SA(b, h) (((b) * 2 + (h)) * HTB)
#define PG8_SB(b, h) ((4 + (b) * 2 + (h)) * HTB)
#define PG8_STAGE(bufoff, gbase, voff) do { _Pragma("unroll") for (int _i = 0; _i < 2; ++_i) \
        __builtin_amdgcn_global_load_lds((const unsigned*)((const char*)(gbase) + (voff)[_i]), (PG8_LAS unsigned*)(lds + (bufoff) + ldsw + _i * 8192), 16, 0, 0); } while (0)
#define PG8_LDA(dst, b, h) do { _Pragma("unroll") for (int m = 0; m < 4; ++m) _Pragma("unroll") for (int k = 0; k < 2; ++k) dst[m][k] = *(const PG8_LAS bf16x8*)(lds + PG8_SA(b, h) + aoff + m * 2048 + k * 1024); } while (0)
#define PG8_LDB(dst, b, h) do { _Pragma("unroll") for (int n = 0; n < 2; ++n) _Pragma("unroll") for (int k = 0; k < 2; ++k) dst[n][k] = *(const PG8_LAS bf16x8*)(lds + PG8_SB(b, h) + boff + n * 2048 + k * 1024); } while (0)
#define PG8_MMA(ai, bj, At, Bt) do { __builtin_amdgcn_s_setprio(1); _Pragma("unroll") for (int m = 0; m < 4; ++m) _Pragma("unroll") for (int n = 0; n < 2; ++n) _Pragma("unroll") for (int k = 0; k < 2; ++k) \
        acc[ai][bj][m][n] = __builtin_amdgcn_mfma_f32_16x16x32_bf16(Bt[n][k], At[m][k], acc[ai][bj][m][n], 0, 0, 0); __builtin_amdgcn_s_setprio(0); } while (0)
#define PG8_WAIT_V(n) asm volatile("s_waitcnt vmcnt(" #n ")" ::: "memory")
#define PG8_WAIT_L(n) asm volatile("s_waitcnt lgkmcnt(" #n ")" ::: "memory")
#define PG8_BAR __builtin_amdgcn_s_barrier()
#define PG8_SCHED __builtin_amdgcn_sched_barrier(0)
    Unit cur, nxt; int ui = 0;
    if (!S.next(0, cur)) return;
    if (stagger) { const unsigned long long t0_ = __builtin_amdgcn_s_memrealtime(); while (__builtin_amdgcn_s_memrealtime() - t0_ < stagger) __builtin_amdgcn_s_sleep(4); }
    f32x4 acc[2][2][4][2];
#pragma unroll
    for (int a = 0; a < 2; ++a)
#pragma unroll
        for (int b = 0; b < 2; ++b)
#pragma unroll
            for (int m = 0; m < 4; ++m)
#pragma unroll
                for (int n = 0; n < 2; ++n) acc[a][b][m][n] = (f32x4){0.f, 0.f, 0.f, 0.f};
    bf16x8 At[4][2], B0[2][2], B1[2][2];
    const char* cA = (const char*)g.A + (size_t)cur.pm * tstepA + (size_t)cur.kt0 * kstep; const char* cB = (const char*)g.Bt + (size_t)cur.pn * tstepB + (size_t)cur.kt0 * kstep;
    S.a_ready(cur);
    if constexpr (SP2) {
        PG8_STAGE(PG8_SB(0, 0), cB, voffB); PG8_STAGE(PG8_SB(0, 1), cB + hstepB, voffB); PG8_STAGE(PG8_SA(0, 0), cA, voffA); PG8_STAGE(PG8_SA(0, 1), cA + hstepA, voffA);
        if (wr == 1) PG8_BAR;
        PG8_WAIT_V(2); PG8_BAR;
        PG8_STAGE(PG8_SB(1, 0), cB + kstep, voffB); PG8_STAGE(PG8_SA(1, 0), cA + kstep, voffA); PG8_STAGE(PG8_SB(1, 1), cB + hstepB + kstep, voffB);
        PG8_WAIT_V(6); PG8_BAR;
    } else {
        PG8_STAGE(PG8_SB(0, 0), cB, voffB); PG8_STAGE(PG8_SA(0, 0), cA, voffA); PG8_STAGE(PG8_SB(0, 1), cB + hstepB, voffB); PG8_STAGE(PG8_SA(0, 1), cA + hstepA, voffA);
        if (wr == 1) PG8_BAR;
        PG8_WAIT_V(4); PG8_BAR;
        PG8_STAGE(PG8_SB(1, 0), cB + kstep, voffB); PG8_STAGE(PG8_SA(1, 0), cA + kstep, voffA); PG8_STAGE(PG8_SB(1, 1), cB + hstepB + kstep, voffB);
        PG8_WAIT_V(6); PG8_BAR;
    }
    for (;;) {
        const bool has_next = S.next(ui + 1, nxt);
        const char* nA = has_next ? (const char*)g.A + (size_t)nxt.pm * tstepA + (size_t)nxt.kt0 * kstep : cA; const char* nB = has_next ? (const char*)g.Bt + (size_t)nxt.pn * tstepB + (size_t)nxt.kt0 * kstep : cB;
        const int nt = cur.nkt;
        for (int t = 0; t < nt; t += 2) {
            const bool last = (t == nt - 2);
            const char* a1 = cA + (size_t)(t + 1) * kstep;
            const char* a2 = last ? nA : cA + (size_t)(t + 2) * kstep; const char* b2 = last ? nB : cB + (size_t)(t + 2) * kstep;
            const char* a3 = a2 + kstep; const char* b3 = b2 + kstep;
            if (last && has_next) S.a_ready(nxt);
            if constexpr (Epi::MIDK) { if (t == (nt >> 1)) E.mid(acc, cur, wr, wc, fr, fq); }
            if constexpr (SP2) {
            PG8_LDB(B0, 0, 0); PG8_LDB(B1, 0, 1); PG8_SCHED; PG8_LDA(At, 0, 0); PG8_STAGE(PG8_SA(1, 1), a1 + hstepA, voffA);
            PG8_WAIT_V(8); PG8_WAIT_L(0); PG8_BAR; PG8_MMA(0, 0, At, B0); PG8_MMA(0, 1, At, B1); PG8_BAR; PG8_SCHED;
            PG8_LDA(At, 0, 1); PG8_STAGE(PG8_SB(0, 0), b2, voffB); PG8_STAGE(PG8_SB(0, 1), b2 + hstepB, voffB); PG8_STAGE(PG8_SA(0, 0), a2, voffA);
            PG8_WAIT_V(8); PG8_WAIT_L(0); PG8_BAR; PG8_MMA(1, 0, At, B0); PG8_MMA(1, 1, At, B1); PG8_BAR; PG8_SCHED;
            PG8_LDB(B0, 1, 0); PG8_LDB(B1, 1, 1); PG8_SCHED; PG8_LDA(At, 1, 0); PG8_STAGE(PG8_SA(0, 1), a2 + hstepA, voffA);
            PG8_WAIT_V(8); PG8_WAIT_L(0); PG8_BAR; PG8_MMA(0, 0, At, B0); PG8_MMA(0, 1, At, B1); PG8_BAR; PG8_SCHED;
            PG8_LDA(At, 1, 1); PG8_STAGE(PG8_SB(1, 0), b3, voffB); PG8_STAGE(PG8_SB(1, 1), b3 + hstepB, voffB); PG8_STAGE(PG8_SA(1, 0), a3, voffA);
            PG8_WAIT_V(8); PG8_WAIT_L(0); PG8_BAR; PG8_MMA(1, 0, At, B0); PG8_MMA(1, 1, At, B1); PG8_BAR; PG8_SCHED;
            } else {
            PG8_LDB(B0, 0, 0); PG8_SCHED; PG8_LDA(At, 0, 0); PG8_STAGE(PG8_SA(1, 1), a1 + hstepA, voffA);
            PG8_WAIT_L(8); PG8_BAR; PG8_WAIT_L(0); PG8_MMA(0, 0, At, B0); PG8_BAR; PG8_SCHED;
            PG8_LDB(B1, 0, 1); PG8_STAGE(PG8_SB(0, 0), b2, voffB);
            PG8_BAR; PG8_WAIT_L(0); PG8_MMA(0, 1, At, B1); PG8_BAR;
            PG8_LDA(At, 0, 1); PG8_STAGE(PG8_SA(0, 0), a2, voffA);
            PG8_BAR; PG8_WAIT_L(0); PG8_MMA(1, 0, At, B0); PG8_BAR; PG8_SCHED;
            PG8_STAGE(PG8_SB(0, 1), b2 + hstepB, voffB);
            PG8_WAIT_V(6); PG8_BAR; PG8_MMA(1, 1, At, B1); PG8_BAR;
            PG8_LDB(B0, 1, 0); PG8_SCHED; PG8_LDA(At, 1, 0); PG8_STAGE(PG8_SA(0, 1), a2 + hstepA, voffA);
            PG8_WAIT_L(8); PG8_BAR; PG8_WAIT_L(0); PG8_MMA(0, 0, At, B0); PG8_BAR; PG8_SCHED;
            PG8_LDB(B1, 1, 1); PG8_STAGE(PG8_SB(1, 0), b3, voffB);
            PG8_BAR; PG8_WAIT_L(0); PG8_MMA(0, 1, At, B1); PG8_BAR;
            PG8_LDA(At, 1, 1); PG8_STAGE(PG8_SA(1, 0), a3, voffA);
            PG8_BAR; PG8_WAIT_L(0); PG8_MMA(1, 0, At, B0); PG8_BAR; PG8_SCHED;
            PG8_STAGE(PG8_SB(1, 1), b3 + hstepB, voffB);
            PG8_WAIT_V(6); PG8_BAR; PG8_MMA(1, 1, At, B1); PG8_BAR;
            }
        }
        if constexpr (ALIGN_EPI) { if (wr == 0) PG8_BAR; }
        asm volatile("s_nop 7\n\ts_nop 7" ::: "memory");
        E(acc, cur, wr, wc, fr, fq); S.done(cur);
        if (!has_next) break;
#pragma unroll
        for (int a = 0; a < 2; ++a)
#pragma unroll
            for (int b = 0; b < 2; ++b)
#pragma unroll
                for (int m = 0; m < 4; ++m)
#pragma unroll
                    for (int n = 0; n < 2; ++n) acc[a][b][m][n] = (f32x4){0.f, 0.f, 0.f, 0.f};
        cur = nxt; cA = nA; cB = nB; ++ui;
        if constexpr (ALIGN_EPI) { if (wr == 1) PG8_BAR; }
    }
    PG8_WAIT_V(0);
    if constexpr (!ALIGN_EPI) { if (wr == 0) PG8_BAR; }
    PG8_BAR;
#undef PG8_SA
#undef PG8_SB
#undef PG8_STAGE
#undef PG8_LDA
#undef PG8_LDB
#undef PG8_MMA
#undef PG8_WAIT_V
#undef PG8_WAIT_L
#undef PG8_BAR
#undef PG8_SCHED
}
}

constexpr int NWAVES = 8;
constexpr int DM = 2048, BATCH = 4, SEQ = 2048, DEPTH = 2, CTXL = 256, DFF = 5632, DA = 1024, DBB = 1024, NHEAD = 8, HDIM = 128, NMOD = 9, NNORM = 6;
constexpr int INC = 2 * DA + 5 * DBB + 2 * DM;
constexpr int TX = BATCH * SEQ, TC = BATCH * CTXL, TT = TX + TC;
constexpr int NGRP = 5;
constexpr float EPS = 1e-6f;

constexpr size_t MiB = 1u << 20;
constexpr size_t WS_CTL = 0, WS_MOD = 1 * MiB, ZERO_BYTES = 32768;
constexpr size_t WS_LBT = 2 * MiB;
constexpr size_t WS_W = 4 * MiB, W_LAYER = 192 * MiB;
constexpr size_t WO_GU1 = 0, WO_D1 = 44 * MiB, WO_IN = 66 * MiB, WO_UP = 110 * MiB, WO_OUT = 118 * MiB, WO_GU2 = 126 * MiB, WO_D2 = 170 * MiB;
constexpr size_t WS_X = 388 * MiB;
constexpr size_t WS_H = 460 * MiB;
constexpr size_t WS_Y = 496 * MiB;
constexpr size_t WS_YS = 528 * MiB;
constexpr int NSLAB = 8, NSLAB_OUT = 4;
constexpr size_t WS_R = 592 * MiB;
constexpr size_t WS_ACT = WS_R;
constexpr size_t WS_U = WS_R, WS_V = WS_R + 18 * MiB, WS_Q = WS_R + 36 * MiB, WS_KF = WS_R + 54 * MiB, WS_KB = WS_R + 72 * MiB, WS_VI = WS_R + 90 * MiB;
constexpr size_t WS_LF = WS_R + 108 * MiB, WS_LB = WS_R + 144 * MiB;
constexpr size_t WS_M1 = WS_R, WS_MB = WS_R + 72 * MiB;
constexpr size_t WS_SG = WS_R + 180 * MiB;
constexpr size_t WS_SA = WS_R + 198 * MiB, WS_SB = WS_R + 234 * MiB;
constexpr size_t WS_OF = WS_R + 270 * MiB, WS_OB = WS_R + 306 * MiB;
constexpr size_t WS_YAB = WS_R + 342 * MiB;
constexpr size_t WS_SLOC = WS_R + 378 * MiB;
constexpr size_t WS_ATOT = WS_R + 394 * MiB;
constexpr size_t WS_VST = WS_R + 395 * MiB;
constexpr size_t WS_END = WS_R + 397 * MiB;
constexpr int CW_TMO = 0, CW_BAR = 4096;

constexpr int RING_OFF = 0, RING_BYTES = 131072;
constexpr int LDSCTL_OFF = RING_BYTES, MISC_OFF = LDSCTL_OFF + 320;
constexpr int LDS_BYTES = 147456;

#define GAS __attribute__((address_space(1)))
#define LAS __attribute__((address_space(3)))
typedef unsigned short bf16;
typedef unsigned v4u __attribute__((ext_vector_type(4)));
typedef unsigned v2u __attribute__((ext_vector_type(2)));
typedef float f32x4 __attribute__((ext_vector_type(4)));
typedef short bf16x8 __attribute__((ext_vector_type(8)));
typedef GAS unsigned gu32;
#define RLX_AGENT __ATOMIC_RELAXED, __HIP_MEMORY_SCOPE_AGENT
#define LDS_WAIT() asm volatile("s_waitcnt lgkmcnt(0)" ::: "memory")
#define VM_WAIT() asm volatile("s_waitcnt vmcnt(0)" ::: "memory")
__device__ __forceinline__ unsigned pk2(float lo, float hi) { return pg8::cvt_pk_bf16(lo, hi); }
__device__ __forceinline__ unsigned pk2_sw(float lo, float hi) { const unsigned a = __float_as_uint(lo), b = __float_as_uint(hi); return ((a + 0x7fffu + ((a >> 16) & 1u)) >> 16) | ((b + 0x7fffu + ((b >> 16) & 1u)) & 0xffff0000u); }
__device__ __forceinline__ float bflo(unsigned w) { return __uint_as_float(w << 16); }
__device__ __forceinline__ float bfhi(unsigned w) { return __uint_as_float(w & 0xffff0000u); }
__device__ __forceinline__ float bf2f(unsigned short b) { return __uint_as_float(((unsigned)b) << 16); }
__device__ __forceinline__ float fsigmoid(float x) { return __builtin_amdgcn_rcpf(1.0f + __expf(-x)); }
__device__ __forceinline__ float fsilu(float x) { return x * fsigmoid(x); }
__device__ __forceinline__ float fgelu_tanh(float x) { return x * fsigmoid(1.5957691216057308f * (x + 0.044715f * x * x * x)); }
__device__ __forceinline__ float wave_sum(float v) {
#pragma unroll
    for (int o = 1; o < 64; o <<= 1) v += __shfl_xor(v, o);
    return v;
}

#define XB_TMO      128
#define XB_XCNT(j)  (256  + 64 * (j))
#define XB_XSUB(j)  (1280 + 64 * (j))
#define XB_XGEN(j)  (2304 + 64 * (j))
#define XB_TOP      3328
#define XB_TOPGEN   3392
#define XCD_BAR_WORDS 3456
#define XB_SPIN_CAP (1u << 18)

__device__ __forceinline__ unsigned xb_ld(unsigned* p)              { return __hip_atomic_load(p, __ATOMIC_RELAXED, __HIP_MEMORY_SCOPE_AGENT); }
__device__ __forceinline__ unsigned xb_add(unsigned* p, unsigned v) { return __hip_atomic_fetch_add(p, v, __ATOMIC_RELAXED, __HIP_MEMORY_SCOPE_AGENT); }
__device__ __forceinline__ unsigned xb_xcc_id() { return (unsigned)__builtin_amdgcn_s_getreg((3 << 11) | 20) & 0xFu; }
#define XB_SPIN(cond, bar) do { unsigned _sp = 0; while (cond) { __builtin_amdgcn_s_sleep(1); \
    if ((++_sp & 255u) == 0u) { if (xb_ld(&(bar)[XB_TMO])) break; if (_sp > XB_SPIN_CAP) { atomicAdd(&(bar)[XB_TMO], 1u); break; } } } } while (0)

struct XcdBarrier {
    unsigned* bar; unsigned x;
    volatile LAS unsigned* st;
};
__device__ __forceinline__ XcdBarrier xcd_barrier_post(unsigned* bar, volatile LAS unsigned* st) {
    XcdBarrier b; b.bar = bar; b.x = xb_xcc_id(); b.st = st;
    if (threadIdx.x == 0) (void)xb_add(&bar[XB_XCNT(b.x)], 1u);
    return b;
}
__device__ __forceinline__ void xcd_barrier_complete(unsigned* bar, unsigned x, unsigned& nloc, unsigned& nx) {
    const unsigned G = gridDim.x * gridDim.y * gridDim.z;
    unsigned sum, cnt, mine, sp = 0u;
    for (;;) {
        sum = 0u; cnt = 0u; mine = 0u;
#pragma unroll
        for (unsigned j = 0; j < 16; ++j) { const unsigned c = xb_ld(&bar[XB_XCNT(j)]); sum += c; cnt += (c > 0u) ? 1u : 0u; mine = (j == x) ? c : mine; }
        if (sum == G) break;
        __builtin_amdgcn_s_sleep(1);
        if ((++sp & 255u) == 0u) { if (xb_ld(&bar[XB_TMO])) break; if (sp > XB_SPIN_CAP) { atomicAdd(&bar[XB_TMO], 1u); break; } }
    }
    nloc = mine > 0u ? mine : 1u; nx = cnt > 0u ? cnt : 1u;
}
__device__ __forceinline__ void xcd_barrier(const XcdBarrier& b) {
    asm volatile("s_waitcnt vmcnt(0)" ::: "memory");
    __syncthreads();
    if (threadIdx.x == 0) {
        unsigned* bar = b.bar;
        __builtin_amdgcn_s_waitcnt(0);
        unsigned nloc = b.st[0], nx = b.st[1];
        if (nloc == 0u) { xcd_barrier_complete(bar, b.x, nloc, nx); b.st[0] = nloc; b.st[1] = nx; }
        const unsigned old = xb_add(&bar[XB_XSUB(b.x)], 1u);
        const unsigned gen = old / nloc;
        if (old + 1u == (gen + 1u) * nloc) {
            __builtin_amdgcn_fence(__ATOMIC_RELEASE, "agent");
            asm volatile("s_waitcnt vmcnt(0)" ::: "memory");
            const unsigned og = xb_add(&bar[XB_TOP], 1u);
            const unsigned tg = og / nx;
            if (og + 1u == (tg + 1u) * nx) xb_add(&bar[XB_TOPGEN], 1u);
            else XB_SPIN(xb_ld(&bar[XB_TOPGEN]) == tg, bar);
            __builtin_amdgcn_fence(__ATOMIC_ACQUIRE, "agent");
            xb_add(&bar[XB_XGEN(b.x)], 1u);
            asm volatile("s_waitcnt vmcnt(0)" ::: "memory");
        } else {
            XB_SPIN(xb_ld(&bar[XB_XGEN(b.x)]) == gen, bar);
            __builtin_amdgcn_fence(__ATOMIC_ACQUIRE, "agent");
            asm volatile("s_waitcnt vmcnt(0)" ::: "memory");
        }
    }
    __syncthreads();
}

using pg8::Unit;
__device__ __forceinline__ v4u pack8(const f32x4 a, const f32x4 b) { v4u w; w.x = pk2(a[0], a[1]); w.y = pk2(a[2], a[3]); w.z = pk2(b[0], b[1]); w.w = pk2(b[2], b[3]); return w; }

struct EpiGU {
    static constexpr bool PERM = true, PERM2 = false, MIDK = false;
    bf16* O;
    __device__ __forceinline__ void operator()(const f32x4 (&acc)[2][2][4][2], const Unit& u, int wr, int wc, int fr, int fq) const {
        const int row0 = u.pm * 256 + wr * 64 + fr, col0 = u.pn * 128 + wc * 32 + 8 * fq;
#pragma unroll
        for (int ai = 0; ai < 2; ++ai)
#pragma unroll
            for (int m = 0; m < 4; ++m) {
                f32x4 v0, v1;
#pragma unroll
                for (int j = 0; j < 4; ++j) { v0[j] = fsilu(acc[ai][0][m][0][j]) * acc[ai][1][m][0][j]; v1[j] = fsilu(acc[ai][0][m][1][j]) * acc[ai][1][m][1][j]; }
                *(v4u*)(O + (size_t)(row0 + ai * 128 + m * 16) * DFF + col0) = pack8(v0, v1);
            }
    }
};
__device__ __forceinline__ v4u dpp_swap1(const v4u x) {
    v4u r; r.x = (unsigned)__builtin_amdgcn_update_dpp(0, (int)x.x, 0xB1, 0xF, 0xF, true); r.y = (unsigned)__builtin_amdgcn_update_dpp(0, (int)x.y, 0xB1, 0xF, 0xF, true);
    r.z = (unsigned)__builtin_amdgcn_update_dpp(0, (int)x.z, 0xB1, 0xF, 0xF, true); r.w = (unsigned)__builtin_amdgcn_update_dpp(0, (int)x.w, 0xB1, 0xF, 0xF, true); return r;
}
struct EpiY {
    static constexpr bool PERM = true, PERM2 = true, MIDK = false;
    bf16* Y16; bf16* YS;
    __device__ __forceinline__ void operator()(const f32x4 (&acc)[2][2][4][2], const Unit& u, int wr, int wc, int fr, int fq) const {
        bf16* base = (u.slab < 0) ? Y16 + (size_t)(u.pm * 256) * DM : YS + (size_t)u.slab * TC * DM + (size_t)(u.pm * 256 - TX) * DM;
        const bool odd = fr & 1;
        bf16* pA = base + (size_t)(wr * 64 + (fr & ~1)) * DM + u.pn * 256 + wc * 64 + 8 * fq + (odd ? 32 : 0);
        bf16* pB = base + (size_t)(wr * 64 + (fr | 1)) * DM + u.pn * 256 + wc * 64 + 8 * fq + (odd ? 32 : 0);
#pragma unroll
        for (int ai = 0; ai < 2; ++ai)
#pragma unroll
            for (int m = 0; m < 4; ++m) {
                const v4u P0 = pack8(acc[ai][0][m][0], acc[ai][0][m][1]), P1 = pack8(acc[ai][1][m][0], acc[ai][1][m][1]);
                v4u X; X.x = odd ? P0.x : P1.x; X.y = odd ? P0.y : P1.y; X.z = odd ? P0.z : P1.z; X.w = odd ? P0.w : P1.w;
                const v4u Y = dpp_swap1(X);
                v4u A, B; A.x = odd ? Y.x : P0.x; A.y = odd ? Y.y : P0.y; A.z = odd ? Y.z : P0.z; A.w = odd ? Y.w : P0.w;
                B.x = odd ? P1.x : Y.x; B.y = odd ? P1.y : Y.y; B.z = odd ? P1.z : Y.z; B.w = odd ? P1.w : Y.w;
                const size_t ro = (size_t)(ai * 128 + m * 16) * DM;
                *(v4u*)(pA + ro) = A; *(v4u*)(pB + ro) = B;
            }
    }
};
constexpr int SEQT = CTXL + SEQ;
__device__ __forceinline__ size_t hm_row(int row) {
    int b, tau; if (row < TX) { b = row >> 11; tau = CTXL + (row & (SEQ - 1)); } else { const int rc = row - TX; b = rc >> 8; tau = rc & (CTXL - 1); }
    return ((size_t)b * NHEAD * SEQT + tau) * HDIM;
}
template <class T>
__device__ __forceinline__ void store_lines(T* pE, T* pO, int second, const v4u C0, const v4u C1, bool odd) {
    v4u X; X.x = odd ? C0.x : C1.x; X.y = odd ? C0.y : C1.y; X.z = odd ? C0.z : C1.z; X.w = odd ? C0.w : C1.w;
    const v4u Y = dpp_swap1(X);
    v4u A, B; A.x = odd ? Y.x : C0.x; A.y = odd ? Y.y : C0.y; A.z = odd ? Y.z : C0.z; A.w = odd ? Y.w : C0.w;
    B.x = odd ? C1.x : Y.x; B.y = odd ? C1.y : Y.y; B.z = odd ? C1.z : Y.z; B.w = odd ? C1.w : Y.w;
    *(v4u*)(pE + (odd ? second : 0)) = A; *(v4u*)(pO + (odd ? second : 0)) = B;
}
struct EpiIN {
    static constexpr bool PERM = true, PERM2 = true, MIDK = false;
    bf16 *U, *V, *Q, *VI, *SG, *SA, *SB; float *LF, *LB; const float* lbt; float* VST;
    static __device__ __forceinline__ void elem_body(const f32x4 (&acc)[2][2][4][2], bf16* O, int ld, int rE, int rO, bool odd, float a1n, float a3n, float m1, float m0) {
#pragma unroll
        for (int ai = 0; ai < 2; ++ai)
#pragma unroll
            for (int m = 0; m < 4; ++m) {
                f32x4 v[2][2];
#pragma unroll
                for (int bj = 0; bj < 2; ++bj)
#pragma unroll
                    for (int n = 0; n < 2; ++n)
#pragma unroll
                        for (int j = 0; j < 4; ++j) { const float t = acc[ai][bj][m][n][j]; const float e = __builtin_amdgcn_exp2f(t * (a3n * (t * t) + a1n)); v[bj][n][j] = (m1 * t + m0) * __builtin_amdgcn_rcpf(1.0f + e); }
                store_lines(O + (size_t)(rE + ai * 128 + m * 16) * ld, O + (size_t)(rO + ai * 128 + m * 16) * ld, 32, pack8(v[0][0], v[0][1]), pack8(v[1][0], v[1][1]), odd);
            }
    }
    __device__ __forceinline__ void operator()(const f32x4 (&acc)[2][2][4][2], const Unit& u, int wr, int wc, int fr, int fq) const {
        const int rowb = u.pm * 256 + wr * 64;
        const int rE = rowb + (fr & ~1), rO = rowb + (fr | 1); const bool odd = fr & 1;
        const int grp = u.pn >> 2;
        const int cg = (u.pn & 3) * 256 + wc * 64 + 8 * fq;
        if (grp >= 2 && grp <= 5) {
            const size_t hoff = (size_t)(cg >> 7) * SEQT * HDIM + (cg & 127);
            if (grp == 3 || grp == 4) {
                const int dir = grp - 3; float* LO = (dir ? LB : LF) + hoff;
#pragma unroll
                for (int bj = 0; bj < 2; ++bj) {
                    const f32x4 l0 = *(const f32x4*)(lbt + dir * 1024 + cg + 32 * bj), l1 = *(const f32x4*)(lbt + dir * 1024 + cg + 32 * bj + 4);
#pragma unroll
                    for (int ai = 0; ai < 2; ++ai)
#pragma unroll
                        for (int m = 0; m < 4; ++m) {
                            f32x4 g0, g1;
#pragma unroll
                            for (int j = 0; j < 4; ++j) {
                                { const float z = fminf(fmaxf(acc[ai][bj][m][0][j], -80.f), 80.f), sg = __builtin_amdgcn_rcpf(1.0f + __expf(-z)), lb = l0[j]; g0[j] = __logf(fmaxf(lb + (1.0f - lb) * sg, 1e-30f)); }
                                { const float z = fminf(fmaxf(acc[ai][bj][m][1][j], -80.f), 80.f), sg = __builtin_amdgcn_rcpf(1.0f + __expf(-z)), lb = l1[j]; g1[j] = __logf(fmaxf(lb + (1.0f - lb) * sg, 1e-30f)); }
                            }
                            v4u c0, c1; __builtin_memcpy(&c0, &g0, 16); __builtin_memcpy(&c1, &g1, 16);
                            store_lines(LO + hm_row(rE + ai * 128 + m * 16) + 32 * bj, LO + hm_row(rO + ai * 128 + m * 16) + 32 * bj, 4, c0, c1, odd);
                        }
                }
            } else {
                bf16* O = ((grp == 2) ? Q : VI) + hoff;
#pragma unroll
                for (int ai = 0; ai < 2; ++ai)
#pragma unroll
                    for (int m = 0; m < 4; ++m)
                        store_lines(O + hm_row(rE + ai * 128 + m * 16), O + hm_row(rO + ai * 128 + m * 16), 32, pack8(acc[ai][0][m][0], acc[ai][0][m][1]), pack8(acc[ai][1][m][0], acc[ai][1][m][1]), odd);
            }
            return;
        }
        if (grp == 1) {
            bf16* O = V + cg;
#pragma unroll
            for (int ai = 0; ai < 2; ++ai)
#pragma unroll
                for (int m = 0; m < 4; ++m) {
                    float sm = 0.f, sq = 0.f; f32x4 v[2][2];
#pragma unroll
                    for (int bj = 0; bj < 2; ++bj)
#pragma unroll
                        for (int n = 0; n < 2; ++n)
#pragma unroll
                            for (int j = 0; j < 4; ++j) { const float t = fgelu_tanh(acc[ai][bj][m][n][j]); v[bj][n][j] = t; sm += t; sq += t * t; }
                    store_lines(O + (size_t)(rE + ai * 128 + m * 16) * 1024, O + (size_t)(rO + ai * 128 + m * 16) * 1024, 32, pack8(v[0][0], v[0][1]), pack8(v[1][0], v[1][1]), odd);
                    sm += __shfl_xor(sm, 16); sm += __shfl_xor(sm, 32); sq += __shfl_xor(sq, 16); sq += __shfl_xor(sq, 32);
                    if (fq == 0) { float* p = VST + ((size_t)(rowb + fr + ai * 128 + m * 16) * 16 + (u.pn & 3) * 4 + wc) * 2; p[0] = sm; p[1] = sq; }
                }
            return;
        }
        bf16* O; int ld, fn;
        if (grp == 0) { O = U + cg; ld = 1024; fn = 1; }
        else if (grp == 6) { O = SG + cg; ld = 1024; fn = 2; }
        else if (grp <= 8) { O = SA + (grp - 7) * 1024 + cg; ld = 2048; fn = 3; }
        else { O = SB + (grp - 9) * 1024 + cg; ld = 2048; fn = 3; }
        const float L2E = 1.4426950408889634f;
        elem_body(acc, O, ld, rE, rO, odd, fn == 1 ? -L2E * 1.5957691216057308f : -L2E, fn == 1 ? -L2E * 1.5957691216057308f * 0.044715f : 0.f, fn == 3 ? 0.f : 1.f, fn == 3 ? 1.f : 0.f);
    }
};
struct EpiMerge {
    static constexpr bool PERM = true, PERM2 = false, MIDK = true;
    const bf16* SA; const bf16* SB; bf16* MB;
    __device__ __forceinline__ void mid(f32x4 (&acc)[2][2][4][2], const Unit& u, int wr, int wc, int fr, int fq) const {
        int row0 = u.pm * 256 + wr * 64 + fr, col0 = u.pn * 256 + wc * 32 + 8 * fq;
        asm volatile("" : "+v"(row0), "+v"(col0));
#pragma unroll
        for (int ai = 0; ai < 2; ++ai)
#pragma unroll
            for (int m = 0; m < 4; ++m) {
#pragma unroll
                for (int bj = 0; bj < 2; ++bj) {
                    const size_t off = (size_t)(row0 + ai * 128 + m * 16) * 2048 + col0 + bj * 128;
                    const v4u a = *(const v4u*)(SA + off), b = *(const v4u*)(SB + off);
                    const unsigned aw[4] = {a.x, a.y, a.z, a.w}, bw[4] = {b.x, b.y, b.z, b.w};
#pragma unroll
                    for (int j = 0; j < 4; ++j) {
                        const float r0 = bflo(aw[j]) * __builtin_amdgcn_rcpf(fmaxf(bflo(bw[j]), 1e-30f)), r1 = bfhi(aw[j]) * __builtin_amdgcn_rcpf(fmaxf(bfhi(bw[j]), 1e-30f));
                        acc[ai][bj][m][j >> 1][2 * (j & 1)] *= r0; acc[ai][bj][m][j >> 1][2 * (j & 1) + 1] *= r1;
                    }
                }
                if (m & 1) asm volatile("" ::: "memory");
            }
    }
    __device__ __forceinline__ void operator()(const f32x4 (&acc)[2][2][4][2], const Unit& u, int wr, int wc, int fr, int fq) const {
        int row0 = u.pm * 256 + wr * 64 + fr, col0 = u.pn * 256 + wc * 32 + 8 * fq;
        asm volatile("" : "+v"(row0), "+v"(col0));
#pragma unroll
        for (int ai = 0; ai < 2; ++ai)
#pragma unroll
            for (int m = 0; m < 4; ++m)
#pragma unroll
                for (int bj = 0; bj < 2; ++bj) {
                    const size_t off = (size_t)(row0 + ai * 128 + m * 16) * 2048 + col0 + bj * 128;
                    const v4u s = *(const v4u*)(SB + off);
                    f32x4 v0 = acc[ai][bj][m][0], v1 = acc[ai][bj][m][1];
                    v0[0] *= fmaxf(bflo(s.x), 1e-30f); v0[1] *= fmaxf(bfhi(s.x), 1e-30f); v0[2] *= fmaxf(bflo(s.y), 1e-30f); v0[3] *= fmaxf(bfhi(s.y), 1e-30f);
                    v1[0] *= fmaxf(bflo(s.z), 1e-30f); v1[1] *= fmaxf(bfhi(s.z), 1e-30f); v1[2] *= fmaxf(bflo(s.w), 1e-30f); v1[3] *= fmaxf(bfhi(s.w), 1e-30f);
                    *(v4u*)(MB + off) = pack8(v0, v1);
                }
    }
};

struct Args { const float* in[20]; float* out; unsigned char* ws; int ph_lo, ph_hi; };

struct Frame {
    LAS unsigned char* lds;
    int wave, G, bx;
};
__device__ __forceinline__ int opaque_tid() { int t = threadIdx.x; asm volatile("" : "+v"(t)); return t; }
#define FTID (tid__)
#define FLANE (tid__ & 63)
#define TID_DECL() const int tid__ = opaque_tid()
__device__ __forceinline__ size_t opaque_zero() { size_t z = 0; asm volatile("" : "+s"(z)); return z; }
#define opaque_ptr(p) ((p) + opaque_zero())
__device__ __forceinline__ int opaque_int(int i) { asm volatile("" : "+s"(i)); return i; }
#define INP(i) (args.in[opaque_int(i)])

constexpr int I_GU = (DM / 64) * (2 * DFF / 32), I_D = (DFF / 64) * (DM / 32), I_IN = (DM / 64) * (INC / 32), I_UP = (DA / 64) * (DM / 32), I_OUT = (DM / 64) * (DM / 32);
constexpr int PER_LAYER = 2 * I_GU + 2 * I_D + I_IN + 2 * I_UP + I_OUT;
constexpr int IT_EARLY = I_GU + I_D + I_IN;
constexpr int SPARE_G = 227;
struct TrItem { const float* src; bf16* dst; int ldsrc, ldd; };
__device__ __forceinline__ TrItem tr_resolve(const Args& args, unsigned char* ws, int it) {
    const int l = it / PER_LAYER; int r = it % PER_LAYER;
    unsigned char* wl = ws + WS_W + (size_t)l * W_LAYER;
    const float* W; bf16* dst; int K, N, ldd, koff = 0; bool gu = false;
    if (r < I_GU) { W = INP(7) + (size_t)l * DM * 2 * DFF; K = DM; N = 2 * DFF; dst = (bf16*)(wl + WO_GU1); ldd = DM; gu = true; }
    else if ((r -= I_GU) < I_D) { W = INP(8) + (size_t)l * DFF * DM; K = DFF; N = DM; dst = (bf16*)(wl + WO_D1); ldd = DFF; }
    else if ((r -= I_D) < I_IN) { W = INP(11) + (size_t)l * DM * INC; K = DM; N = INC; dst = (bf16*)(wl + WO_IN); ldd = DM; }
    else if ((r -= I_IN) < I_UP) { W = INP(17) + (size_t)l * DA * DM; K = DA; N = DM; dst = (bf16*)(wl + WO_UP); ldd = 2 * DA; }
    else if ((r -= I_UP) < I_UP) { W = INP(18) + (size_t)l * DBB * DM; K = DBB; N = DM; dst = (bf16*)(wl + WO_UP); ldd = 2 * DA; koff = DA; }
    else if ((r -= I_UP) < I_OUT) { W = INP(19) + (size_t)l * DM * DM; K = DM; N = DM; dst = (bf16*)(wl + WO_OUT); ldd = DM; }
    else if ((r -= I_OUT) < I_GU) { W = INP(9) + (size_t)l * DM * 2 * DFF; K = DM; N = 2 * DFF; dst = (bf16*)(wl + WO_GU2); ldd = DM; gu = true; }
    else { r -= I_GU; W = INP(10) + (size_t)l * DFF * DM; K = DFF; N = DM; dst = (bf16*)(wl + WO_D2); ldd = DFF; }
    (void)K;
    const int nblk = N / 32, kb = r / nblk, nb = r % nblk;
    int sc0 = 32 * nb;
    if (gu) { const int tile = nb >> 3, within = 32 * (nb & 7); sc0 = (within < 128) ? (128 * tile + within) : (DFF + 128 * tile + within - 128); }
    TrItem t; t.src = W + (size_t)(64 * kb) * N + sc0; t.ldsrc = N; t.dst = dst + (size_t)(32 * nb) * ldd + koff + 64 * kb; t.ldd = ldd; return t;
}
__device__ __forceinline__ void tr_load(const TrItem& t, int lane, f32x4 (&v)[8]) {
    const int rr = lane >> 3, c4 = (lane & 7) * 4;
#pragma unroll
    for (int i = 0; i < 8; ++i) v[i] = __builtin_nontemporal_load((const f32x4*)(t.src + (size_t)(8 * i + rr) * t.ldsrc + c4));
}
__device__ __forceinline__ void tr_emit(const TrItem& t, int lane, const f32x4 (&v)[8], LAS float* scr) {
    const int rr = lane >> 3, c4 = (lane & 7) * 4;
#pragma unroll
    for (int i = 0; i < 8; ++i) { LAS float* s = scr + (8 * i + rr) * 33 + c4; s[0] = v[i][0]; s[1] = v[i][1]; s[2] = v[i][2]; s[3] = v[i][3]; }
    LDS_WAIT(); asm volatile("" ::: "memory");
    const int c = lane & 7;
#pragma unroll
    for (int j = 0; j < 4; ++j) { const int n = (lane >> 3) + 8 * j; const LAS float* s = scr + (8 * c) * 33 + n;
        v4u o; o.x = pk2(s[0 * 33], s[1 * 33]); o.y = pk2(s[2 * 33], s[3 * 33]); o.z = pk2(s[4 * 33], s[5 * 33]); o.w = pk2(s[6 * 33], s[7 * 33]);
        *(v4u*)(t.dst + (size_t)n * t.ldd + 8 * c) = o; }
    LDS_WAIT(); asm volatile("" ::: "memory");
}
__device__ __forceinline__ void convert_items(Frame& F, const Args& args, int it_lo, int it_hi, int iw, int nw) {
    TID_DECL();
    unsigned char* ws = opaque_ptr(args.ws);
    LAS float* scr = (LAS float*)(F.lds + RING_OFF + F.wave * 16384);
    int it = it_lo + iw;
    if (it < it_hi) {
        TrItem cur = tr_resolve(args, ws, it); f32x4 v[8]; tr_load(cur, FLANE, v);
        for (;;) {
            const int itn = it + nw; const bool more = itn < it_hi;
            TrItem nxt = cur; f32x4 vn[8];
            if (more) { nxt = tr_resolve(args, ws, itn); tr_load(nxt, FLANE, vn); }
            tr_emit(cur, FLANE, v, scr);
            if (!more) break;
#pragma unroll
            for (int i = 0; i < 8; ++i) v[i] = vn[i];
            cur = nxt; it = itn;
        }
    }
    __syncthreads();
}
__device__ __forceinline__ void mod_items(Frame& F, const Args& args, int iwg, int nwg) {
    TID_DECL();
    unsigned char* ws = opaque_ptr(args.ws);
    float* mod = (float*)(ws + WS_MOD);
    LAS float* sc = (LAS float*)(F.lds + RING_OFF);
    LAS float* red = (LAS float*)(F.lds + RING_OFF + 65536);
    for (int t = FTID; t < NGRP * DM; t += NWAVES * 64) { const int g = t >> 11, kk = t & (DM - 1);
        const float cv = (g < 4) ? INP(1)[g * DM + kk] : INP(3)[kk];
        sc[t] = cv / (1.0f + __expf(-cv)); }
    __syncthreads();
    constexpr int NB = NMOD * DM / 32;
    const int cg = FLANE & 7, kr = FLANE >> 3;
    for (int it = iwg; it < DEPTH * NB; it += nwg) {
        const int l = it / NB, nb = it % NB;
        const float* W = INP(4) + (size_t)l * DM * NMOD * DM + (size_t)(F.wave * 256 + kr) * (NMOD * DM) + nb * 32 + 4 * cg;
        f32x4 a[NGRP];
#pragma unroll
        for (int g = 0; g < NGRP; ++g) a[g] = (f32x4){0.f, 0.f, 0.f, 0.f};
#pragma unroll 8
        for (int i = 0; i < 32; ++i) { const f32x4 w = __builtin_nontemporal_load((const f32x4*)(W + (size_t)(8 * i) * (NMOD * DM)));
#pragma unroll
            for (int g = 0; g < NGRP; ++g) { const float sv = sc[g * DM + F.wave * 256 + 8 * i + kr]; a[g] += w * sv; } }
#pragma unroll
        for (int g = 0; g < NGRP; ++g)
#pragma unroll
            for (int c = 0; c < 4; ++c) { float v = a[g][c]; v += __shfl_xor(v, 8); v += __shfl_xor(v, 16); v += __shfl_xor(v, 32); a[g][c] = v; }
        if (kr == 0) {
#pragma unroll
            for (int g = 0; g < NGRP; ++g)
#pragma unroll
                for (int c = 0; c < 4; ++c) red[(F.wave * 8 + cg) * 20 + g * 4 + c] = a[g][c]; }
        __syncthreads();
        if (FTID < 160) { const int cgi = FTID / 20, v = FTID % 20, g = v >> 2, c = v & 3; float sum = 0.f;
#pragma unroll
            for (int w = 0; w < NWAVES; ++w) sum += red[(w * 8 + cgi) * 20 + v];
            const int n = nb * 32 + 4 * cgi + c;
            mod[(size_t)(l * NGRP + g) * NMOD * DM + n] = sum + INP(5)[(size_t)l * NMOD * DM + n]; }
        __syncthreads();
    }
}
__device__ __forceinline__ void p0_prologue(Frame& F, const Args& args) {
    TID_DECL();
    unsigned char* ws = opaque_ptr(args.ws);
    convert_items(F, args, 0, IT_EARLY, F.bx * NWAVES + F.wave, F.G * NWAVES);
    mod_items(F, args, F.bx, F.G);
    if (F.bx == 0) {
        float* lbt = (float*)(ws + WS_LBT);
        for (int idx = FTID; idx < 2 * DBB; idx += NWAVES * 64) {
            float z[DEPTH], mx = -3.0e38f, den = 0.f;
#pragma unroll
            for (int l = 0; l < DEPTH; ++l) { z[l] = INP(15)[l * 2 * DBB + idx]; mx = fmaxf(mx, z[l]); }
#pragma unroll
            for (int l = 0; l < DEPTH; ++l) { z[l] = __expf(z[l] - mx); den += z[l]; }
            float cum = 0.f; const float s0 = z[0] / den;
#pragma unroll
            for (int l = 0; l < DEPTH; ++l) { cum += z[l] / den; lbt[l * 2 * DBB + idx] = (l == 0) ? 0.f : (cum - s0); }
        }
    }
}
__device__ __forceinline__ void background_work(Frame& F, const Args& args, int slot) {
    const int iwg = F.bx - SPARE_G, nwg = F.G - SPARE_G, iw = iwg * NWAVES + F.wave, nw = nwg * NWAVES;
    constexpr int L1_HALF = PER_LAYER + PER_LAYER / 2;
    if (slot == 0) convert_items(F, args, IT_EARLY, PER_LAYER, iw, nw);
    else if (slot == 1) convert_items(F, args, PER_LAYER, L1_HALF, iw, nw);
    else convert_items(F, args, L1_HALF, 2 * PER_LAYER, iw, nw);
}

__device__ __forceinline__ int row_grp(int row) { return row < TX ? (row >> 11) : 4; }
template <int MODE, bool XIN = false>
__device__ __forceinline__ void thin_phase(Frame& F, const Args& args, int nrows, int nslab, const float* gpost, const float* mod_r, int gate_i, float w,
                                           const float* gpre, const float* mod_m, int shift_i, int scale_i) {
    TID_DECL();
    unsigned char* ws = opaque_ptr(args.ws);
    bf16* X = (bf16*)(ws + WS_X); bf16* H = (bf16*)(ws + WS_H);
    const int rpw = nrows / F.G, g0 = row_grp(32 * F.bx), g1 = 4;
    LAS float* VA = (LAS float*)(F.lds + RING_OFF);
    LAS float* VB = VA + 2 * DM;
    LAS float* VC = VB + 2 * DM;
    for (int t = FTID; t < 2 * DM; t += NWAVES * 64) { const int gi = t >> 11, n = t & (DM - 1), g = gi ? g1 : g0;
        if (MODE != 0) VA[t] = w * mod_r[(size_t)(g * NMOD + gate_i) * DM + n] * gpost[n];
        if (MODE != 2) { VB[t] = gpre[n] * (1.0f + mod_m[(size_t)(g * NMOD + scale_i) * DM + n]); VC[t] = mod_m[(size_t)(g * NMOD + shift_i) * DM + n]; } }
    __syncthreads();
    for (int rr = F.wave; rr < rpw; rr += NWAVES) {
        const int row = rr < 32 ? 32 * F.bx + rr : TX + 4 * F.bx + (rr - 32), gi = rr < 32 ? 0 : 1;
        f32x4 x[8];
        if (MODE == 0) {
            const float* src = row < TX ? INP(0) + (size_t)row * DM : INP(2) + (size_t)(row - TX) * DM;
#pragma unroll
            for (int j = 0; j < 8; ++j) x[j] = *(const f32x4*)(src + 4 * FLANE + 256 * j);
        } else {
            f32x4 y[8]; float s = 0.f;
            if (row < TX) {
                const bf16* Y16 = (const bf16*)(ws + WS_Y) + (size_t)row * DM + 4 * FLANE;
#pragma unroll
                for (int j = 0; j < 8; ++j) { const v2u w2 = *(const v2u*)(Y16 + 256 * j); y[j] = (f32x4){bflo(w2.x), bfhi(w2.x), bflo(w2.y), bfhi(w2.y)}; }
            } else {
                const bf16* YS = (const bf16*)(ws + WS_YS) + (size_t)(row - TX) * DM + 4 * FLANE;
#pragma unroll
                for (int j = 0; j < 8; ++j) { const v2u w2 = *(const v2u*)(YS + 256 * j); y[j] = (f32x4){bflo(w2.x), bfhi(w2.x), bflo(w2.y), bfhi(w2.y)}; }
#pragma unroll 1
                for (int sl = 1; sl < nslab; ++sl)
#pragma unroll
                    for (int j = 0; j < 8; ++j) { const v2u w2 = *(const v2u*)(YS + (size_t)sl * TC * DM + 256 * j); y[j] += (f32x4){bflo(w2.x), bfhi(w2.x), bflo(w2.y), bfhi(w2.y)}; }
            }
#pragma unroll
            for (int j = 0; j < 8; ++j) s += (y[j][0] * y[j][0] + y[j][1] * y[j][1]) + (y[j][2] * y[j][2] + y[j][3] * y[j][3]);
            const float r = 1.0f / sqrtf(wave_sum(s) * (1.0f / DM) + EPS);
            if (XIN) {
                const float* xs = row < TX ? INP(0) + (size_t)row * DM : INP(2) + (size_t)(row - TX) * DM;
#pragma unroll
                for (int j = 0; j < 8; ++j) x[j] = *(const f32x4*)(xs + 4 * FLANE + 256 * j);
            } else {
#pragma unroll
                for (int j = 0; j < 8; ++j) { const v2u w2 = *(const v2u*)(X + (size_t)row * DM + 4 * FLANE + 256 * j); x[j] = (f32x4){bflo(w2.x), bfhi(w2.x), bflo(w2.y), bfhi(w2.y)}; }
            }
#pragma unroll
            for (int j = 0; j < 8; ++j) { const f32x4 a = *(const LAS f32x4*)(VA + gi * DM + 4 * FLANE + 256 * j); x[j] += a * y[j] * r; }
        }
        if (MODE == 2) {
#pragma unroll
            for (int j = 0; j < 8; ++j) *(f32x4*)(args.out + (size_t)row * DM + 4 * FLANE + 256 * j) = x[j];
        } else {
            float s = 0.f;
#pragma unroll
            for (int j = 0; j < 8; ++j) { if (MODE != 0) { v2u o; o.x = pk2(x[j][0], x[j][1]); o.y = pk2(x[j][2], x[j][3]); *(v2u*)(X + (size_t)row * DM + 4 * FLANE + 256 * j) = o; }
                s += (x[j][0] * x[j][0] + x[j][1] * x[j][1]) + (x[j][2] * x[j][2] + x[j][3] * x[j][3]); }
            const float r = 1.0f / sqrtf(wave_sum(s) * (1.0f / DM) + EPS);
#pragma unroll
            for (int j = 0; j < 8; ++j) { const f32x4 b = *(const LAS f32x4*)(VB + gi * DM + 4 * FLANE + 256 * j), c = *(const LAS f32x4*)(VC + gi * DM + 4 * FLANE + 256 * j);
                const f32x4 h = x[j] * r * b + c; v2u o; o.x = pk2(h[0], h[1]); o.y = pk2(h[2], h[3]);
                *(v2u*)(H + (size_t)row * DM + 4 * FLANE + 256 * j) = o; }
        }
    }
    __syncthreads();
}

__device__ __forceinline__ void readout_phase(Frame& F, const Args& args, int nrows, const float* gain) {
    TID_DECL();
    unsigned char* ws = opaque_ptr(args.ws);
    const bf16* OF = (const bf16*)(ws + WS_OF); const bf16* OB = (const bf16*)(ws + WS_OB); const bf16* SG = (const bf16*)(ws + WS_SG); bf16* YAB = (bf16*)(ws + WS_YAB);
    const int gw = F.bx * NWAVES + F.wave, NGW = F.G * NWAVES;
    for (int row = gw; row < nrows; row += NGW) {
        const size_t off = (size_t)row * DBB + 16 * FLANE;
        const size_t hoff = hm_row(row) + (size_t)(FLANE >> 3) * SEQT * HDIM + 16 * (FLANE & 7);
        f32x4 o[4]; float s = 0.f;
#pragma unroll
        for (int j = 0; j < 4; ++j) { const v2u a2 = *(const v2u*)(OF + hoff + 4 * j), b2 = *(const v2u*)(OB + hoff + 4 * j);
            o[j] = (f32x4){bflo(a2.x) + bflo(b2.x), bfhi(a2.x) + bfhi(b2.x), bflo(a2.y) + bflo(b2.y), bfhi(a2.y) + bfhi(b2.y)}; s += (o[j][0] * o[j][0] + o[j][1] * o[j][1]) + (o[j][2] * o[j][2] + o[j][3] * o[j][3]); }
        s += __shfl_xor(s, 1); s += __shfl_xor(s, 2); s += __shfl_xor(s, 4);
        const float r = 1.0f / sqrtf(s * (1.0f / HDIM) + EPS);
        const v4u g0 = *(const v4u*)(SG + off), g1 = *(const v4u*)(SG + off + 8);
        const unsigned gw_[8] = {g0.x, g0.y, g0.z, g0.w, g1.x, g1.y, g1.z, g1.w};
        unsigned ow[8];
#pragma unroll
        for (int j = 0; j < 4; ++j) { const f32x4 gn = *(const f32x4*)(gain + 16 * FLANE + 4 * j);
            const float a0 = o[j][0] * r * gn[0] * bflo(gw_[2 * j]), a1 = o[j][1] * r * gn[1] * bfhi(gw_[2 * j]), a2 = o[j][2] * r * gn[2] * bflo(gw_[2 * j + 1]), a3 = o[j][3] * r * gn[3] * bfhi(gw_[2 * j + 1]);
            ow[2 * j] = pk2(a0, a1); ow[2 * j + 1] = pk2(a2, a3); }
        bf16* dst = YAB + (size_t)row * (2 * DA) + DA + 16 * FLANE;
        *(v4u*)dst = (v4u){ow[0], ow[1], ow[2], ow[3]}; *(v4u*)(dst + 8) = (v4u){ow[4], ow[5], ow[6], ow[7]};
    }
}

constexpr int GM_VNT = 0, GM_STAT = 128 * 272;
__device__ __forceinline__ void gmlp_unit(Frame& F, const Args& args, int row0, int g, const float* cng, const float* wsp, const float* bsp) {
    TID_DECL();
    unsigned char* ws = opaque_ptr(args.ws);
    const bf16* U = (const bf16*)(ws + WS_U); const bf16* V = (const bf16*)(ws + WS_V); bf16* YAB = (bf16*)(ws + WS_YAB);
    LAS unsigned char* vnT = F.lds + RING_OFF + GM_VNT; LAS float* stat = (LAS float*)(F.lds + RING_OFF + GM_STAT);
    if (FTID < 128) {
        const f32x4* p = (const f32x4*)((const float*)(ws + WS_VST) + (size_t)(row0 + FTID) * 32);
        float sm = 0.f, sq = 0.f;
#pragma unroll
        for (int k = 0; k < 8; ++k) { const f32x4 t = p[k]; sm += t[0] + t[2]; sq += t[1] + t[3]; }
        const float mean = sm * (1.0f / DA), var = fmaxf(sq * (1.0f / DA) - mean * mean, 0.f);
        stat[2 * FTID] = mean; stat[2 * FTID + 1] = 1.0f / sqrtf(var + EPS);
    }
    __syncthreads();
    for (int it = FTID; it < 128 * 16; it += NWAVES * 64) {
        const int s = it & 127, dd = it >> 7;
        const v4u a = *(const v4u*)(V + (size_t)(row0 + s) * DA + g * 128 + 8 * dd);
        const float mean = stat[2 * s], rstd = stat[2 * s + 1];
        const f32x4 g0 = *(const f32x4*)(cng + g * 128 + 8 * dd), g1 = *(const f32x4*)(cng + g * 128 + 8 * dd + 4);
        const unsigned wv[4] = {a.x, a.y, a.z, a.w};
#pragma unroll
        for (int j = 0; j < 4; ++j) {
            const float lo = (bflo(wv[j]) - mean) * rstd * (j < 2 ? g0[2 * j] : g1[2 * j - 4]), hi = (bfhi(wv[j]) - mean) * rstd * (j < 2 ? g0[2 * j + 1] : g1[2 * j - 3]);
            const unsigned p = pk2(lo, hi);
            *(LAS unsigned short*)(vnT + (8 * dd + 2 * j) * 272 + 2 * s) = (unsigned short)(p & 0xffffu);
            *(LAS unsigned short*)(vnT + (8 * dd + 2 * j + 1) * 272 + 2 * s) = (unsigned short)(p >> 16);
        }
    }
    __syncthreads();
    const int i = FLANE & 15, gq = FLANE >> 4;
    f32x4 acc[8];
#pragma unroll
    for (int md = 0; md < 8; ++md) acc[md] = (f32x4){0.f, 0.f, 0.f, 0.f};
    const float* wrow = wsp + ((size_t)g * 128 + 16 * F.wave + i) * 128;
#pragma unroll
    for (int kk = 0; kk < 4; ++kk) {
        const f32x4 w0 = *(const f32x4*)(wrow + 32 * kk + 8 * gq), w1 = *(const f32x4*)(wrow + 32 * kk + 8 * gq + 4);
        const v4u wb = pack8(w0, w1); bf16x8 bfrag; __builtin_memcpy(&bfrag, &wb, 16);
#pragma unroll
        for (int md = 0; md < 8; ++md) {
            const bf16x8 afrag = *(const LAS bf16x8*)(vnT + (16 * md + i) * 272 + (32 * kk + 8 * gq) * 2);
            acc[md] = __builtin_amdgcn_mfma_f32_16x16x32_bf16(afrag, bfrag, acc[md], 0, 0, 0);
        }
    }
    const int t = 16 * F.wave + i; const float bias = bsp[g * 128 + t];
#pragma unroll
    for (int md = 0; md < 8; ++md) {
        const size_t col = (size_t)g * 128 + 16 * md + 4 * gq;
        const v2u uu = *(const v2u*)(U + (size_t)(row0 + t) * DA + col);
        v2u o; o.x = pk2(bflo(uu.x) * (acc[md][0] + bias), bfhi(uu.x) * (acc[md][1] + bias)); o.y = pk2(bflo(uu.y) * (acc[md][2] + bias), bfhi(uu.y) * (acc[md][3] + bias));
        *(v2u*)(YAB + (size_t)(row0 + t) * (2 * DA) + col) = o;
    }
    __syncthreads();
}

constexpr int SC_QS = 0, SC_KS = 17408, SC_KET = 34816, SC_VT = 53248, SC_DD = 71680, SC_AT = 73728;
constexpr int SEGLEN = (CTXL + SEQ) / 4, SEG_GROUPS = SEGLEN / 64;
__device__ __forceinline__ int scan_tau(int dir, int sigma) { return dir ? (sigma < CTXL ? CTXL - 1 - sigma : SEQT + CTXL - 1 - sigma) : sigma; }
struct ScanRegs { f32x4 lf[4]; v2u qv[4], vv[4]; };
template <bool FULL>
__device__ __forceinline__ void scan_load(ScanRegs& R, const float* LG, const bf16* Q, const bf16* VI, int dir, int sigma0, int c0) {
#pragma unroll
    for (int p = 0; p < 4; ++p) { const size_t ro = (size_t)scan_tau(dir, sigma0 + p) * HDIM + c0;
        R.lf[p] = *(const f32x4*)(LG + ro); R.vv[p] = *(const v2u*)(VI + ro); if (FULL) R.qv[p] = *(const v2u*)(Q + ro); }
}
template <bool FULL>
__device__ __forceinline__ void scan_stage1(const ScanRegs& R, LAS unsigned char* L, int sb1, int c0, int qi, int lane, f32x4& atot) {
    f32x4 a[4]; a[0] = R.lf[0]; a[1] = a[0] + R.lf[1]; a[2] = a[1] + R.lf[2]; a[3] = a[2] + R.lf[3];
    f32x4 inc = a[3], a15;
#pragma unroll
    for (int c = 0; c < 4; ++c) { float v = inc[c]; float t = __shfl_up(v, 16); if (qi >= 1) v += t; t = __shfl_up(v, 32); if (qi >= 2) v += t; inc[c] = v; a15[c] = __shfl(v, 48 + (lane & 15)); }
    const f32x4 excl = inc - a[3];
    float kef[4][4];
#pragma unroll
    for (int p = 0; p < 4; ++p) {
        const f32x4 ap = a[p] + excl;
        f32x4 kf4;
#pragma unroll
        for (int c = 0; c < 4; ++c) { kf4[c] = 1.0f - __expf(R.lf[p][c]); kef[p][c] = kf4[c] * __expf(a15[c] - ap[c]); }
        if (FULL) {
            const f32x4 qf4 = (f32x4){bflo(R.qv[p].x), bfhi(R.qv[p].x), bflo(R.qv[p].y), bfhi(R.qv[p].y)};
            f32x4 qs, ks;
#pragma unroll
            for (int c = 0; c < 4; ++c) { qs[c] = qf4[c] * __expf(ap[c]); ks[c] = kf4[c] * __expf(fminf(-ap[c], 80.f)); }
            const int ro = (sb1 * 16 + 4 * qi + p) * 272 + 2 * c0;
            *(LAS v2u*)(L + SC_QS + ro) = (v2u){pk2(qs[0], qs[1]), pk2(qs[2], qs[3])};
            *(LAS v2u*)(L + SC_KS + ro) = (v2u){pk2(ks[0], ks[1]), pk2(ks[2], ks[3])};
        }
    }
    const int to = sb1 * 4608 + qi * 1152 + c0 * 8;
    *(LAS v4u*)(L + SC_KET + to) = (v4u){pk2(kef[0][0], kef[1][0]), pk2(kef[2][0], kef[3][0]), pk2(kef[0][1], kef[1][1]), pk2(kef[2][1], kef[3][1])};
    *(LAS v4u*)(L + SC_KET + to + 16) = (v4u){pk2(kef[0][2], kef[1][2]), pk2(kef[2][2], kef[3][2]), pk2(kef[0][3], kef[1][3]), pk2(kef[2][3], kef[3][3])};
    const unsigned v00 = R.vv[0].x, v01 = R.vv[0].y, v10 = R.vv[1].x, v11 = R.vv[1].y, v20 = R.vv[2].x, v21 = R.vv[2].y, v30 = R.vv[3].x, v31 = R.vv[3].y;
    *(LAS v4u*)(L + SC_VT + to) = (v4u){(v00 & 0xffffu) | (v10 << 16), (v20 & 0xffffu) | (v30 << 16), (v00 >> 16) | (v10 & 0xffff0000u), (v20 >> 16) | (v30 & 0xffff0000u)};
    *(LAS v4u*)(L + SC_VT + to + 16) = (v4u){(v01 & 0xffffu) | (v11 << 16), (v21 & 0xffffu) | (v31 << 16), (v01 >> 16) | (v11 & 0xffff0000u), (v21 >> 16) | (v31 & 0xffff0000u)};
    if (qi == 3) *(LAS f32x4*)(L + SC_DD + (sb1 * 128 + c0) * 4) = (f32x4){__expf(a15[0]), __expf(a15[1]), __expf(a15[2]), __expf(a15[3])};
    atot += a15;
}
template <bool FULL>
__device__ __forceinline__ void scan_stage2(f32x4 (&S)[8], LAS unsigned char* L, bf16* O, int dir, int sigma0, bool do_out, int i, int gq, int eb) {
#pragma unroll 1
    for (int sb = 0; sb < 4; ++sb) {
        const v2u vraw = *(const LAS v2u*)(L + SC_VT + sb * 4608 + gq * 1152 + (eb + i) * 8);
        const v4u vw = (v4u){vraw.x, vraw.y, 0u, 0u}; bf16x8 vf; __builtin_memcpy(&vf, &vw, 16);
        if (FULL && do_out) {
            f32x4 P = (f32x4){0.f, 0.f, 0.f, 0.f};
#pragma unroll
            for (int kk = 0; kk < 4; ++kk) {
                const bf16x8 af = *(const LAS bf16x8*)(L + SC_KS + (sb * 16 + i) * 272 + (32 * kk + 8 * gq) * 2);
                const bf16x8 bfr = *(const LAS bf16x8*)(L + SC_QS + (sb * 16 + i) * 272 + (32 * kk + 8 * gq) * 2);
                P = __builtin_amdgcn_mfma_f32_16x16x32_bf16(af, bfr, P, 0, 0, 0);
            }
#pragma unroll
            for (int r = 0; r < 4; ++r) P[r] = (4 * gq + r <= i) ? P[r] : 0.f;
            const v4u pw = (v4u){pk2(P[0], P[1]), pk2(P[2], P[3]), 0u, 0u}; bf16x8 pb; __builtin_memcpy(&pb, &pw, 16);
            f32x4 Oa = __builtin_amdgcn_mfma_f32_16x16x32_bf16(vf, pb, (f32x4){0.f, 0.f, 0.f, 0.f}, 0, 0, 0);
#pragma unroll
            for (int kk = 0; kk < 4; ++kk) {
                const v4u sw = (v4u){pk2(S[2 * kk][0], S[2 * kk][1]), pk2(S[2 * kk][2], S[2 * kk][3]), pk2(S[2 * kk + 1][0], S[2 * kk + 1][1]), pk2(S[2 * kk + 1][2], S[2 * kk + 1][3])};
                bf16x8 sf; __builtin_memcpy(&sf, &sw, 16);
                const v2u q0 = *(const LAS v2u*)(L + SC_QS + (sb * 16 + i) * 272 + (32 * kk + 4 * gq) * 2), q1 = *(const LAS v2u*)(L + SC_QS + (sb * 16 + i) * 272 + (32 * kk + 16 + 4 * gq) * 2);
                const v4u qw = (v4u){q0.x, q0.y, q1.x, q1.y}; bf16x8 qb; __builtin_memcpy(&qb, &qw, 16);
                Oa = __builtin_amdgcn_mfma_f32_16x16x32_bf16(sf, qb, Oa, 0, 0, 0);
            }
            *(v2u*)(O + (size_t)scan_tau(dir, sigma0 + sb * 16 + i) * HDIM + eb + 4 * gq) = (v2u){pk2_sw(Oa[0], Oa[1]), pk2_sw(Oa[2], Oa[3])};
        }
#pragma unroll
        for (int tt = 0; tt < 8; ++tt) {
            const f32x4 dd = *(const LAS f32x4*)(L + SC_DD + (sb * 128 + 16 * tt + 4 * gq) * 4);
            const v2u kraw = *(const LAS v2u*)(L + SC_KET + sb * 4608 + gq * 1152 + (16 * tt + i) * 8);
            const v4u kw = (v4u){kraw.x, kraw.y, 0u, 0u}; bf16x8 kf; __builtin_memcpy(&kf, &kw, 16);
            S[tt] = __builtin_amdgcn_mfma_f32_16x16x32_bf16(kf, vf, S[tt] * dd, 0, 0, 0);
        }
    }
}
template <bool FULL>
__device__ __forceinline__ void scan_pass(Frame& F, const Args& args, int b, int h, int dir, int seg, bool ctx_out) {
    TID_DECL();
    unsigned char* ws = opaque_ptr(args.ws);
    const size_t hb = (size_t)(b * NHEAD + h) * SEQT * HDIM;
    const bf16* Q = (const bf16*)(ws + WS_Q) + hb; const bf16* VI = (const bf16*)(ws + WS_VI) + hb;
    const float* LG = (const float*)(ws + (dir ? WS_LB : WS_LF)) + hb; bf16* O = (bf16*)(ws + (dir ? WS_OB : WS_OF)) + hb;
    f32x4* SLOC = (f32x4*)(ws + WS_SLOC); float* ATOT = (float*)(ws + WS_ATOT);
    const int unit = ((seg * 2 + dir) * NHEAD + h) * BATCH + b;
    LAS unsigned char* L = F.lds + RING_OFF;
    const int sb1 = F.wave >> 1, c0 = 64 * (F.wave & 1) + 4 * (FLANE & 15), qi = FLANE >> 4;
    const int i = FLANE & 15, gq = FLANE >> 4, eb = 16 * F.wave;
    f32x4 S[8];
#pragma unroll
    for (int tt = 0; tt < 8; ++tt) S[tt] = (f32x4){0.f, 0.f, 0.f, 0.f};
    if (FULL) {
        for (int j = 0; j < seg; ++j) { const int uj = ((j * 2 + dir) * NHEAD + h) * BATCH + b;
#pragma unroll
            for (int tt = 0; tt < 8; ++tt) { const f32x4 at = *(const f32x4*)(ATOT + (size_t)uj * HDIM + 16 * tt + 4 * gq);
                const f32x4 dec = (f32x4){__expf(at[0]), __expf(at[1]), __expf(at[2]), __expf(at[3])};
                S[tt] = S[tt] * dec + SLOC[((size_t)(uj * 8 + F.wave) * 8 + tt) * 64 + FLANE]; } }
    }
    f32x4 atot = (f32x4){0.f, 0.f, 0.f, 0.f};
    const int g_lo = seg * SEG_GROUPS, g_hi = g_lo + SEG_GROUPS, pos1 = sb1 * 16 + 4 * qi;
    ScanRegs RA, RB;
    scan_load<FULL>(RA, LG, Q, VI, dir, g_lo * 64 + pos1, c0);
    scan_load<FULL>(RB, LG, Q, VI, dir, (g_lo + 1) * 64 + pos1, c0);
    for (int gi = g_lo; gi < g_hi; gi += 2) {
        __syncthreads();
        scan_stage1<FULL>(RA, L, sb1, c0, qi, FLANE, atot);
        if (gi + 2 < g_hi) scan_load<FULL>(RA, LG, Q, VI, dir, (gi + 2) * 64 + pos1, c0);
        __syncthreads();
        scan_stage2<FULL>(S, L, O, dir, gi * 64, ctx_out || gi >= CTXL / 64, i, gq, eb);
        if (gi + 1 >= g_hi) break;
        __syncthreads();
        scan_stage1<FULL>(RB, L, sb1, c0, qi, FLANE, atot);
        if (gi + 3 < g_hi) scan_load<FULL>(RB, LG, Q, VI, dir, (gi + 3) * 64 + pos1, c0);
        __syncthreads();
        scan_stage2<FULL>(S, L, O, dir, (gi + 1) * 64, ctx_out || gi + 1 >= CTXL / 64, i, gq, eb);
    }
    if (!FULL) {
#pragma unroll
        for (int tt = 0; tt < 8; ++tt) SLOC[((size_t)(unit * 8 + F.wave) * 8 + tt) * 64 + FLANE] = S[tt];
        __syncthreads();
        LAS float* AT = (LAS float*)(L + SC_AT);
        if (qi == 0) *(LAS f32x4*)(AT + F.wave * 64 + 4 * (FLANE & 15)) = atot;
        __syncthreads();
        if (FTID < HDIM) { const int chh = FTID >> 6, cc = FTID & 63; ATOT[(size_t)unit * HDIM + FTID] = (AT[(0 + chh) * 64 + cc] + AT[(2 + chh) * 64 + cc]) + (AT[(4 + chh) * 64 + cc] + AT[(6 + chh) * 64 + cc]); }
    }
    __syncthreads();
}

constexpr int NPH_LAYER = 13, NPHASES = 2 + DEPTH * NPH_LAYER;
__global__ void __launch_bounds__(NWAVES * 64, 2) mk_fwd(Args args) {
    TID_DECL();
    extern __shared__ __attribute__((aligned(16))) unsigned char lds[];
    Frame F;
    F.lds = (LAS unsigned char*)lds;
    F.wave = __builtin_amdgcn_readfirstlane(FTID >> 6);
    F.G = gridDim.x; F.bx = blockIdx.x;
    for (int u = FTID; u < (LDS_BYTES - LDSCTL_OFF) / 4; u += NWAVES * 64) ((LAS unsigned*)(F.lds + LDSCTL_OFF))[u] = 0u;
    __syncthreads();
    XcdBarrier bar = xcd_barrier_post((unsigned*)(args.ws + WS_CTL) + CW_BAR, (volatile LAS unsigned*)(F.lds + MISC_OFF) + 8);
    const int lo = args.ph_lo, hi = args.ph_hi;
#define IN(k) (lo <= (k) && (k) < hi)
    unsigned long long probe_t = (PROBE_PHASE >= 0) ? __builtin_amdgcn_s_memrealtime() : 0ull; const unsigned long long probe_t0 = probe_t;
#define SEAM(k) do { if (IN(k) && IN((k) + 1)) xcd_barrier(bar); \
        if (PROBE_PHASE >= 0) { const unsigned long long tn_ = __builtin_amdgcn_s_memrealtime(); \
            if ((k) == PROBE_PHASE) { const unsigned long long w_ = (unsigned long long)PROBE_MULT * (tn_ - probe_t); while (__builtin_amdgcn_s_memrealtime() - tn_ < w_) __builtin_amdgcn_s_sleep(8); } \
            probe_t = __builtin_amdgcn_s_memrealtime(); } } while (0)
    using pg8::Gemm; using pg8::RectOrder; using pg8::gemm_phase;
    LAS unsigned char* ring = F.lds + RING_OFF;
#define WSB() unsigned char* ws = opaque_ptr(args.ws)
#define MODALL ((const float*)(ws + WS_MOD))
#define NORMG(l_) (INP(6) + (size_t)(l_) * NNORM * DM)
#define MODL(l_) (MODALL + (size_t)(l_) * NGRP * NMOD * DM)
#define WL(l_) (ws + WS_W + (size_t)(l_) * W_LAYER)

    if (IN(0)) { _Pragma("nounroll") for (int rep = 0; rep < REP_P0; ++rep) { p0_prologue(F, args); __syncthreads(); } }
    SEAM(0);
    if (IN(1)) { WSB(); _Pragma("nounroll") for (int rep = 0; rep < REP_THIN; ++rep) thin_phase<0>(F, args, TT, 0, nullptr, nullptr, 0, 0.f, NORMG(0), MODALL, 0, 1); }
    SEAM(1);
#pragma nounroll
    for (int l = 0; l < DEPTH; ++l) {
        const int pb = 2 + l * NPH_LAYER; const bool lastl = (l == DEPTH - 1);
        const int npan_late = lastl ? TX / 256 : TT / 256;
        const int gG = (l == 0) ? SPARE_G : F.G;
        if (IN(pb + 0)) { if (F.bx >= gG) background_work(F, args, 0); else {
            WSB(); Gemm g{(const bf16*)(ws + WS_H), (const bf16*)(WL(l) + WO_GU1), DM, DM}; RectOrder S{0, TT / 256, 0, 2 * DFF / 256, 0, 0, 0, 0, 1, 0, 0, DM / 64, gG, F.bx}; EpiGU E{(bf16*)(ws + WS_ACT)};
            _Pragma("nounroll") for (int rep = 0; rep < REP_GEMM; ++rep) gemm_phase<EpiGU, RectOrder, true, true>(ring, g, S, E, (unsigned)(F.bx & 7) * STAG_GU); } }
        SEAM(pb + 0);
        if (IN(pb + 1)) { WSB(); Gemm g{(const bf16*)(ws + WS_ACT), (const bf16*)(WL(l) + WO_D1), DFF, DFF}; RectOrder S{0, TX / 256, 0, DM / 256, TX / 256, TC / 256, 0, DM / 256, NSLAB, 12, 10, DFF / 64, F.G, F.bx}; EpiY E{(bf16*)(ws + WS_Y), (bf16*)(ws + WS_YS)};
            _Pragma("nounroll") for (int rep = 0; rep < REP_GEMM; ++rep) gemm_phase<EpiY, RectOrder, true, true>(ring, g, S, E); }
        SEAM(pb + 1);
        if (IN(pb + 2)) { WSB(); _Pragma("nounroll") for (int rep = 0; rep < REP_THIN; ++rep) { if (l == 0 && rep == 0) thin_phase<1, true>(F, args, TT, NSLAB, NORMG(l) + 1 * DM, MODL(l), 2, 0.5f, NORMG(l) + 2 * DM, MODL(l), 3, 4);
            else thin_phase<1>(F, args, TT, NSLAB, NORMG(l) + 1 * DM, MODL(l), 2, rep ? 0.f : 0.5f, NORMG(l) + 2 * DM, MODL(l), 3, 4); } }
        SEAM(pb + 2);
        if (IN(pb + 3)) { if (F.bx >= gG) background_work(F, args, 1); else {
            WSB(); Gemm g{(const bf16*)(ws + WS_H), (const bf16*)(WL(l) + WO_IN), DM, DM};
            RectOrder S{0, lastl ? TX / 256 : TT / 256, 0, INC / 256, TX / 256, lastl ? TC / 256 : 0, 12, 12, 1, 0, 0, DM / 64, gG, F.bx};
            EpiIN E{(bf16*)(ws + WS_U), (bf16*)(ws + WS_V), (bf16*)(ws + WS_Q), (bf16*)(ws + WS_VI), (bf16*)(ws + WS_SG), (bf16*)(ws + WS_SA), (bf16*)(ws + WS_SB),
                    (float*)(ws + WS_LF), (float*)(ws + WS_LB), (const float*)(ws + WS_LBT) + (size_t)l * 2 * DBB, (float*)(ws + WS_VST)};
            _Pragma("nounroll") for (int rep = 0; rep < REP_GEMM; ++rep) gemm_phase<EpiIN, RectOrder, true, true>(ring, g, S, E, (unsigned)(F.bx & 7) * STAG_IN); } }
        SEAM(pb + 3);
        if (IN(pb + 4)) {
            if (F.bx < 192) { _Pragma("nounroll") for (int rep = 0; rep < REP_S1 * REP_SA; ++rep)
                scan_pass<false>(F, args, F.bx & 3, (F.bx >> 2) & 7, (F.bx >> 5) & 1, F.bx >> 6, !lastl); }
            _Pragma("nounroll") for (int rep = 0; rep < REP_S1 * REP_GMLP; ++rep) {
            const int n3 = lastl ? 5 : 6;
            const int u_lo = F.bx >= 192 ? (F.bx - 192) * n3 : 64 * n3 + F.bx, u_hi = u_lo + (F.bx >= 192 ? n3 : 1);
            for (int it = u_lo; it < u_hi; ++it)
                gmlp_unit(F, args, (it >> 3) * 128, it & 7, INP(12) + (size_t)l * DA, INP(13) + (size_t)l * 8 * 128 * 128, INP(14) + (size_t)l * 8 * 128);
            }
        }
        SEAM(pb + 4);
        if (IN(pb + 5)) { _Pragma("nounroll") for (int rep = 0; rep < REP_S1 * REP_SB; ++rep) scan_pass<true>(F, args, F.bx & 3, (F.bx >> 2) & 7, (F.bx >> 5) & 1, F.bx >> 6, !lastl); }
        SEAM(pb + 5);
        if (IN(pb + 6)) { _Pragma("nounroll") for (int rep = 0; rep < REP_THIN; ++rep) readout_phase(F, args, npan_late * 256, INP(16) + (size_t)l * DBB); }
        SEAM(pb + 6);
        if (IN(pb + 7)) { WSB(); RectOrder S{0, npan_late, 0, DM / 256, 0, 0, 0, 0, 1, 0, 0, 2 * DA / 64, F.G, F.bx};
            Gemm g{(const bf16*)(ws + WS_YAB), (const bf16*)(WL(l) + WO_UP), 2 * DA, 2 * DA}; EpiMerge E{(const bf16*)(ws + WS_SA), (const bf16*)(ws + WS_SB), (bf16*)(ws + WS_MB)};
            _Pragma("nounroll") for (int rep = 0; rep < REP_GEMM; ++rep) gemm_phase<EpiMerge, RectOrder, true, true>(ring, g, S, E); }
        SEAM(pb + 7);
        if (IN(pb + 8)) { WSB(); Gemm g{(const bf16*)(ws + WS_MB), (const bf16*)(WL(l) + WO_OUT), DM, DM}; RectOrder S{0, TX / 256, 0, DM / 256, TX / 256, lastl ? 0 : TC / 256, 0, DM / 256, NSLAB_OUT, 8, 8, DM / 64, F.G, F.bx}; EpiY E{(bf16*)(ws + WS_Y), (bf16*)(ws + WS_YS)};
            _Pragma("nounroll") for (int rep = 0; rep < REP_GEMM; ++rep) gemm_phase<EpiY, RectOrder, true, true>(ring, g, S, E); }
        SEAM(pb + 8);
        if (IN(pb + 9)) { WSB(); _Pragma("nounroll") for (int rep = 0; rep < REP_THIN; ++rep) thin_phase<1>(F, args, npan_late * 256, NSLAB_OUT, NORMG(l) + 3 * DM, MODL(l), 5, rep ? 0.f : 1.0f, NORMG(l) + 4 * DM, MODL(l), 6, 7); }
        SEAM(pb + 9);
        if (IN(pb + 10)) { if (F.bx >= gG) background_work(F, args, 2); else {
            WSB(); Gemm g{(const bf16*)(ws + WS_H), (const bf16*)(WL(l) + WO_GU2), DM, DM}; RectOrder S{0, npan_late, 0, 2 * DFF / 256, 0, 0, 0, 0, 1, 0, 0, DM / 64, gG, F.bx}; EpiGU E{(bf16*)(ws + WS_ACT)};
            _Pragma("nounroll") for (int rep = 0; rep < REP_GEMM; ++rep) gemm_phase<EpiGU, RectOrder, true, true>(ring, g, S, E, (unsigned)(F.bx & 7) * STAG_GU); } }
        SEAM(pb + 10);
        if (IN(pb + 11)) { WSB(); Gemm g{(const bf16*)(ws + WS_ACT), (const bf16*)(WL(l) + WO_D2), DFF, DFF}; RectOrder S{0, TX / 256, 0, DM / 256, TX / 256, lastl ? 0 : TC / 256, 0, DM / 256, NSLAB, 12, 10, DFF / 64, F.G, F.bx}; EpiY E{(bf16*)(ws + WS_Y), (bf16*)(ws + WS_YS)};
            _Pragma("nounroll") for (int rep = 0; rep < REP_GEMM; ++rep) gemm_phase<EpiY, RectOrder, true, true>(ring, g, S, E); }
        SEAM(pb + 11);
        if (IN(pb + 12)) { WSB();
            if (lastl) _Pragma("nounroll") for (int rep = 0; rep < REP_THIN; ++rep) thin_phase<2>(F, args, TX, 0, NORMG(l) + 5 * DM, MODL(l), 8, 0.5f, nullptr, nullptr, 0, 0);
            else _Pragma("nounroll") for (int rep = 0; rep < REP_THIN; ++rep) thin_phase<1>(F, args, TT, NSLAB, NORMG(l) + 5 * DM, MODL(l), 8, rep ? 0.f : 0.5f, NORMG(l + 1), MODL(l + 1), 0, 1);
        }
        if (!lastl) SEAM(pb + 12);
    }
    if (PROBE_PHASE == 99 && F.bx == 0) { const unsigned long long tn_ = __builtin_amdgcn_s_memrealtime(), w_ = tn_ - probe_t0; while (__builtin_amdgcn_s_memrealtime() - tn_ < w_) __builtin_amdgcn_s_sleep(8); }
#undef IN
#undef SEAM
}

extern "C" void kernel_launch(void* const* d_in, const int* in_sizes, int n_in, void* d_out, int out_size, void* d_ws, size_t ws_size, hipStream_t stream) {
    static int grid = 0;
    if (grid == 0) {
        if (n_in != 20 || in_sizes[0] != TX * DM || out_size != TX * DM || ws_size < WS_END) {
            fprintf(stderr, "kernel_launch: unexpected shapes / workspace (n_in %d, in0 %d, out %d, ws %zu, need %zu); nothing launched\n", n_in, n_in > 0 ? in_sizes[0] : -1, out_size, ws_size, (size_t)WS_END); grid = -1; return; }
        int dev = 0, cus = 0, per_cu = 0;
        if (hipGetDevice(&dev) != hipSuccess || hipDeviceGetAttribute(&cus, hipDeviceAttributeMultiprocessorCount, dev) != hipSuccess) { grid = -1; return; }
        if (hipFuncSetAttribute((const void*)mk_fwd, hipFuncAttributeMaxDynamicSharedMemorySize, LDS_BYTES) != hipSuccess) { fprintf(stderr, "kernel_launch: hipFuncSetAttribute failed\n"); grid = -1; return; }
        if (hipOccupancyMaxActiveBlocksPerMultiprocessor(&per_cu, (const void*)mk_fwd, NWAVES * 64, LDS_BYTES) != hipSuccess || per_cu < 1)
            fprintf(stderr, "kernel_launch: note: occupancy query reports %d workgroups per CU\n", per_cu);
        (void)hipGetLastError();
        grid = cus;
        if (grid != 256) fprintf(stderr, "kernel_launch: note: %d CUs\n", grid);
    }
    if (grid < 0) return;
    if (hipMemsetAsync((char*)d_ws, 0, ZERO_BYTES, stream) != hipSuccess) { fprintf(stderr, "kernel_launch: memset failed\n"); return; }
    Args a{};
    for (int i = 0; i < 20; ++i) a.in[i] = (const float*)d_in[i];
    a.out = (float*)d_out; a.ws = (unsigned char*)d_ws;
#if MK_PER_PHASE
    for (int p = 0; p < NPHASES; ++p) { a.ph_lo = p; a.ph_hi = p + 1; hipLaunchKernelGGL(mk_fwd, dim3(grid), dim3(NWAVES * 64), LDS_BYTES, stream, a); }
#else
    a.ph_lo = 0; a.ph_hi = NPHASES;
    hipLaunchKernelGGL(mk_fwd, dim3(grid), dim3(NWAVES * 64), LDS_BYTES, stream, a);
#endif
    const hipError_t le = hipPeekAtLastError();
    if (le != hipSuccess) fprintf(stderr, "kernel_launch: launch failed: %s\n", hipGetErrorName(le));
}
```

```cpp
#include <hip/hip_runtime.h>
#include <cstdio>
#include <cstdint>

#ifndef STAG_GU
#define STAG_GU 0
#endif
#ifndef STAG_IN
#define STAG_IN 0
#endif
#ifndef REP_GEMM
#define REP_GEMM 1
#endif
#ifndef REP_P0
#define REP_P0 1
#endif
#ifndef REP_S1
#define REP_S1 1
#endif
#ifndef REP_GMLP
#define REP_GMLP 1
#endif
#ifndef REP_SA
#define REP_SA 1
#endif
#ifndef REP_SB
#define REP_SB 1
#endif
#ifndef REP_THIN
#define REP_THIN 1
#endif
#ifndef PROBE_PHASE
#define PROBE_PHASE (-1)
#endif
#ifndef PROBE_MULT
#define PROBE_MULT 9
#endif
#ifndef MK_PER_PHASE
#define MK_PER_PHASE 0
#endif

namespace pg8 {
#define PG8_LAS __attribute__((address_space(3)))
typedef unsigned short bf16_t;
typedef short bf16x8 __attribute__((ext_vector_type(8)));
typedef float f32x4 __attribute__((ext_vector_type(4)));
typedef unsigned u32x4 __attribute__((ext_vector_type(4)));
constexpr int BM = 256, BK = 64, HALF = 128, HTB = HALF * BK * 2, STAGE_BYTES = 8 * HTB, NXCD = 8, WGM = 8;

__host__ __device__ __forceinline__ int lds_byte(int r, int c) { const int st = (r >> 4) * 2 + (c >> 5), rr = r & 15, cc = c & 31, ob = rr * 64 + cc * 2; return st * 1024 + (ob ^ (((ob >> 9) & 1) << 5)); }
__host__ __device__ __forceinline__ void stage_rc(int b, int& R, int& C) { const int st = b / 1024, sb = b % 1024, swz = sb ^ (((sb >> 9) & 1) << 5); R = (st >> 1) * 16 + swz / 64; C = (st & 1) * 32 + (swz % 64) / 2; }
__host__ __device__ __forceinline__ int perm32(int rho) { const int n = rho >> 4, i = rho & 15; return 8 * (i >> 2) + 4 * n + (i & 3); }

struct Unit { int pm, pn, kt0, nkt, slab; };
struct Gemm { const bf16_t* A; const bf16_t* Bt; int lda, ldb; };

struct RectOrder {
    int pma, nma, pna, nna, pmb, nmb, pnb, nnb, nsl, kA, kB, KT, G, c;
    __device__ __forceinline__ void map(int wgid, int nM, int nN, int pm0, int pn0, Unit& u) const {
        const int nwg = nM * nN;
        { const int q = nwg / NXCD, r = nwg % NXCD, xcd = wgid % NXCD, off = wgid / NXCD; wgid = (xcd < r ? xcd * (q + 1) : r * (q + 1) + (xcd - r) * q) + off; }
        const int nig = WGM * nN, gid = wgid / nig, fm = gid * WGM, gsz = (nM - fm) < WGM ? (nM - fm) : WGM;
        u.pm = pm0 + fm + ((wgid % nig) % gsz); u.pn = pn0 + (wgid % nig) / gsz;
    }
    __device__ __forceinline__ bool next(int i, Unit& u) const {
        long L = (long)i * G + c; const int na = nma * nna;
        if (L < na) { map((int)L, nma, nna, pma, pna, u); u.kt0 = 0; u.nkt = KT; u.slab = -1; return true; }
        L -= na; const int nb1 = nmb * nnb;
        if (L < (long)nb1 * nsl) { const int sl = (int)(L / nb1); map((int)(L % nb1), nmb, nnb, pmb, pnb, u);
            if (nsl > 1) { u.kt0 = (sl >> 1) * (kA + kB) + (sl & 1) * kA; u.nkt = (sl & 1) ? kB : kA; u.slab = sl; } else { u.kt0 = 0; u.nkt = KT; u.slab = -1; }
            return true; }
        return false;
    }
    __device__ __forceinline__ void a_ready(const Unit&) const {}
    __device__ __forceinline__ void done(const Unit&) const {}
};

__device__ __forceinline__ unsigned cvt_pk_bf16(float lo, float hi) { unsigned r; asm volatile("v_cvt_pk_bf16_f32 %0, %1, %2" : "=v"(r) : "v"(lo), "v"(hi)); return r; }

template <class Epi, class Sched, bool ALIGN_EPI = false, bool SP2 = false>
__device__ __forceinline__ void gemm_phase(PG8_LAS unsigned char* lds, const Gemm g, const Sched& S, const Epi& E, unsigned stagger = 0u) {
    int tid_ = threadIdx.x; asm volatile("" : "+v"(tid_));
    const int tid = tid_, wid = __builtin_amdgcn_readfirstlane(tid >> 6), lane = tid & 63, wr = wid >> 2, wc = wid & 3, fr = lane & 15, fq = lane >> 4;
    unsigned voffA[2], voffB[2];
#pragma unroll
    for (int i = 0; i < 2; ++i) { int R, C; stage_rc(tid * 16 + i * 8192, R, C);
        const int Rb = Epi::PERM2 ? (64 * (R >> 5) + perm32(R & 31)) : (Epi::PERM ? ((R & ~31) + perm32(R & 31)) : R);
        voffA[i] = (unsigned)(R * g.lda + C) * 2u; voffB[i] = (unsigned)(Rb * g.ldb + C) * 2u; }
    const size_t kstep = (size_t)(BK * 2);
    const size_t hstepA = (size_t)HALF * g.lda * 2, hstepB = (size_t)(Epi::PERM2 ? 32 : HALF) * g.ldb * 2;
    const size_t tstepA = 2 * hstepA, tstepB = (size_t)BM * g.ldb * 2;
    const unsigned ldsw = (unsigned)wid * 1024u;
    const int aoff = lds_byte(wr * 64 + fr, fq * 8), boff = lds_byte(wc * 32 + fr, fq * 8);
#define PG8_SA(b, h) (((b) * 2 + (h)) * HTB)
#define PG8_SB(b, h) ((4 + (b) * 2 + (h)) * HTB)
#define PG8_STAGE(bufoff, gbase, voff) do { _Pragma("unroll") for (int _i = 0; _i < 2; ++_i) \
        __builtin_amdgcn_global_load_lds((const unsigned*)((const char*)(gbase) + (voff)[_i]), (PG8_LAS unsigned*)(lds + (bufoff) + ldsw + _i * 8192), 16, 0, 0); } while (0)
#define PG8_LDA(dst, b, h) do { _Pragma("unroll") for (int m = 0; m < 4; ++m) _Pragma("unroll") for (int k = 0; k < 2; ++k) dst[m][k] = *(const PG8_LAS bf16x8*)(lds + PG8_SA(b, h) + aoff + m * 2048 + k * 1024); } while (0)
#define PG8_LDB(dst, b, h) do { _Pragma("unroll") for (int n = 0; n < 2; ++n) _Pragma("unroll") for (int k = 0; k < 2; ++k) dst[n][k] = *(const PG8_LAS bf16x8*)(lds + PG8_SB(b, h) + boff + n * 2048 + k * 1024); } while (0)
#define PG8_MMA(ai, bj, At, Bt) do { __builtin_amdgcn_s_setprio(1); _Pragma("unroll") for (int m = 0; m < 4; ++m) _Pragma("unroll") for (int n = 0; n < 2; ++n) _Pragma("unroll") for (int k = 0; k < 2; ++k) \
        acc[ai][bj][m][n] = __builtin_amdgcn_mfma_f32_16x16x32_bf16(Bt[n][k], At[m][k], acc[ai][bj][m][n], 0, 0, 0); __builtin_amdgcn_s_setprio(0); } while (0)
#define PG8_WAIT_V(n) asm volatile("s_waitcnt vmcnt(" #n ")" ::: "memory")
#define PG8_WAIT_L(n) asm volatile("s_waitcnt lgkmcnt(" #n ")" ::: "memory")
#define PG8_BAR __builtin_amdgcn_s_barrier()
#define PG8_SCHED __builtin_amdgcn_sched_barrier(0)
    Unit cur, nxt; int ui = 0;
    if (!S.next(0, cur)) return;
    if (stagger) { const unsigned long long t0_ = __builtin_amdgcn_s_memrealtime(); while (__builtin_amdgcn_s_memrealtime() - t0_ < stagger) __builtin_amdgcn_s_sleep(4); }
    f32x4 acc[2][2][4][2];
#pragma unroll
    for (int a = 0; a < 2; ++a)
#pragma unroll
        for (int b = 0; b < 2; ++b)
#pragma unroll
            for (int m = 0; m < 4; ++m)
#pragma unroll
                for (int n = 0; n < 2; ++n) acc[a][b][m][n] = (f32x4){0.f, 0.f, 0.f, 0.f};
    bf16x8 At[4][2], B0[2][2], B1[2][2];
    const char* cA = (const char*)g.A + (size_t)cur.pm * tstepA + (size_t)cur.kt0 * kstep; const char* cB = (const char*)g.Bt + (size_t)cur.pn * tstepB + (size_t)cur.kt0 * kstep;
    S.a_ready(cur);
    if constexpr (SP2) {
        PG8_STAGE(PG8_SB(0, 0), cB, voffB); PG8_STAGE(PG8_SB(0, 1), cB + hstepB, voffB); PG8_STAGE(PG8_SA(0, 0), cA, voffA); PG8_STAGE(PG8_SA(0, 1), cA + hstepA, voffA);
        if (wr == 1) PG8_BAR;
        PG8_WAIT_V(2); PG8_BAR;
        PG8_STAGE(PG8_SB(1, 0), cB + kstep, voffB); PG8_STAGE(PG8_SA(1, 0), cA + kstep, voffA); PG8_STAGE(PG8_SB(1, 1), cB + hstepB + kstep, voffB);
        PG8_WAIT_V(6); PG8_BAR;
    } else {
        PG8_STAGE(PG8_SB(0, 0), cB, voffB); PG8_STAGE(PG8_SA(0, 0), cA, voffA); PG8_STAGE(PG8_SB(0, 1), cB + hstepB, voffB); PG8_STAGE(PG8_SA(0, 1), cA + hstepA, voffA);
        if (wr == 1) PG8_BAR;
        PG8_WAIT_V(4); PG8_BAR;
        PG8_STAGE(PG8_SB(1, 0), cB + kstep, voffB); PG8_STAGE(PG8_SA(1, 0), cA + kstep, voffA); PG8_STAGE(PG8_SB(1, 1), cB + hstepB + kstep, voffB);
        PG8_WAIT_V(6); PG8_BAR;
    }
    for (;;) {
        const bool has_next = S.next(ui + 1, nxt);
        const char* nA = has_next ? (const char*)g.A + (size_t)nxt.pm * tstepA + (size_t)nxt.kt0 * kstep : cA; const char* nB = has_next ? (const char*)g.Bt + (size_t)nxt.pn * tstepB + (size_t)nxt.kt0 * kstep : cB;
        const int nt = cur.nkt;
        for (int t = 0; t < nt; t += 2) {
            const bool last = (t == nt - 2);
            const char* a1 = cA + (size_t)(t + 1) * kstep;
            const char* a2 = last ? nA : cA + (size_t)(t + 2) * kstep; const char* b2 = last ? nB : cB + (size_t)(t + 2) * kstep;
            const char* a3 = a2 + kstep; const char* b3 = b2 + kstep;
            if (last && has_next) S.a_ready(nxt);
            if constexpr (Epi::MIDK) { if (t == (nt >> 1)) E.mid(acc, cur, wr, wc, fr, fq); }
            if constexpr (SP2) {
            PG8_LDB(B0, 0, 0); PG8_LDB(B1, 0, 1); PG8_SCHED; PG8_LDA(At, 0, 0); PG8_STAGE(PG8_SA(1, 1), a1 + hstepA, voffA);
            PG8_WAIT_V(8); PG8_WAIT_L(0); PG8_BAR; PG8_MMA(0, 0, At, B0); PG8_MMA(0, 1, At, B1); PG8_BAR; PG8_SCHED;
            PG8_LDA(At, 0, 1); PG8_STAGE(PG8_SB(0, 0), b2, voffB); PG8_STAGE(PG8_SB(0, 1), b2 + hstepB, voffB); PG8_STAGE(PG8_SA(0, 0), a2, voffA);
            PG8_WAIT_V(8); PG8_WAIT_L(0); PG8_BAR; PG8_MMA(1, 0, At, B0); PG8_MMA(1, 1, At, B1); PG8_BAR; PG8_SCHED;
            PG8_LDB(B0, 1, 0); PG8_LDB(B1, 1, 1); PG8_SCHED; PG8_LDA(At, 1, 0); PG8_STAGE(PG8_SA(0, 1), a2 + hstepA, voffA);
            PG8_WAIT_V(8); PG8_WAIT_L(0); PG8_BAR; PG8_MMA(0, 0, At, B0); PG8_MMA(0, 1, At, B1); PG8_BAR; PG8_SCHED;
            PG8_LDA(At, 1, 1); PG8_STAGE(PG8_SB(1, 0), b3, voffB); PG8_STAGE(PG8_SB(1, 1), b3 + hstepB, voffB); PG8_STAGE(PG8_SA(1, 0), a3, voffA);
            PG8_WAIT_V(8); PG8_WAIT_L(0); PG8_BAR; PG8_MMA(1, 0, At, B0); PG8_MMA(1, 1, At, B1); PG8_BAR; PG8_SCHED;
            } else {
            PG8_LDB(B0, 0, 0); PG8_SCHED; PG8_LDA(At, 0, 0); PG8_STAGE(PG8_SA(1, 1), a1 + hstepA, voffA);
            PG8_WAIT_L(8); PG8_BAR; PG8_WAIT_L(0); PG8_MMA(0, 0, At, B0); PG8_BAR; PG8_SCHED;
            PG8_LDB(B1, 0, 1); PG8_STAGE(PG8_SB(0, 0), b2, voffB);
            PG8_BAR; PG8_WAIT_L(0); PG8_MMA(0, 1, At, B1); PG8_BAR;
            PG8_LDA(At, 0, 1); PG8_STAGE(PG8_SA(0, 0), a2, voffA);
            PG8_BAR; PG8_WAIT_L(0); PG8_MMA(1, 0, At, B0); PG8_BAR; PG8_SCHED;
            PG8_STAGE(PG8_SB(0, 1), b2 + hstepB, voffB);
            PG8_WAIT_V(6); PG8_BAR; PG8_MMA(1, 1, At, B1); PG8_BAR;
            PG8_LDB(B0, 1, 0); PG8_SCHED; PG8_LDA(At, 1, 0); PG8_STAGE(PG8_SA(0, 1), a2 + hstepA, voffA);
            PG8_WAIT_L(8); PG8_BAR; PG8_WAIT_L(0); PG8_MMA(0, 0, At, B0); PG8_BAR; PG8_SCHED;
            PG8_LDB(B1, 1, 1); PG8_STAGE(PG8_SB(1, 0), b3, voffB);
            PG8_BAR; PG8_WAIT_L(0); PG8_MMA(0, 1, At, B1); PG8_BAR;
            PG8_LDA(At, 1, 1); PG8_STAGE(PG8_SA(1, 0), a3, voffA);
            PG8_BAR; PG8_WAIT_L(0); PG8_MMA(1, 0, At, B0); PG8_BAR; PG8_SCHED;
            PG8_STAGE(PG8_SB(1, 1), b3 + hstepB, voffB);
            PG8_WAIT_V(6); PG8_BAR; PG8_MMA(1, 1, At, B1); PG8_BAR;
            }
        }
        if constexpr (ALIGN_EPI) { if (wr == 0) PG8_BAR; }
        asm volatile("s_nop 7\n\ts_nop 7" ::: "memory");
        E(acc, cur, wr, wc, fr, fq); S.done(cur);
        if (!has_next) break;
#pragma unroll
        for (int a = 0; a < 2; ++a)
#pragma unroll
            for (int b = 0; b < 2; ++b)
#pragma unroll
                for (int m = 0; m < 4; ++m)
#pragma unroll
                    for (int n = 0; n < 2; ++n) acc[a][b][m][n] = (f32x4){0.f, 0.f, 0.f, 0.f};
        cur = nxt; cA = nA; cB = nB; ++ui;
        if constexpr (ALIGN_EPI) { if (wr == 1) PG8_BAR; }
    }
    PG8_WAIT_V(0);
    if constexpr (!ALIGN_EPI) { if (wr == 0) PG8_BAR; }
    PG8_BAR;
#undef PG8_SA
#undef PG8_SB
#undef PG8_STAGE
#undef PG8_LDA
#undef PG8_LDB
#undef PG8_MMA
#undef PG8_WAIT_V
#undef PG8_WAIT_L
#undef PG8_BAR
#undef PG8_SCHED
}
}

constexpr int NWAVES = 8;
constexpr int DM = 2048, BATCH = 4, SEQ = 2048, DEPTH = 2, CTXL = 256, DFF = 5632, DA = 1024, DBB = 1024, NHEAD = 8, HDIM = 128, NMOD = 9, NNORM = 6;
constexpr int INC = 2 * DA + 5 * DBB + 2 * DM;
constexpr int TX = BATCH * SEQ, TC = BATCH * CTXL, TT = TX + TC;
constexpr int NGRP = 5;
constexpr float EPS = 1e-6f;

constexpr size_t MiB = 1u << 20;
constexpr size_t WS_CTL = 0, WS_MOD = 1 * MiB, ZERO_BYTES = 32768;
constexpr size_t WS_LBT = 2 * MiB;
constexpr size_t WS_W = 4 * MiB, W_LAYER = 192 * MiB;
constexpr size_t WO_GU1 = 0, WO_D1 = 44 * MiB, WO_IN = 66 * MiB, WO_UP = 110 * MiB, WO_OUT = 118 * MiB, WO_GU2 = 126 * MiB, WO_D2 = 170 * MiB;
constexpr size_t WS_X = 388 * MiB;
constexpr size_t WS_H = 460 * MiB;
constexpr size_t WS_Y = 496 * MiB;
constexpr size_t WS_YS = 528 * MiB;
constexpr int NSLAB = 8, NSLAB_OUT = 4;
constexpr size_t WS_R = 592 * MiB;
constexpr size_t WS_ACT = WS_R;
constexpr size_t WS_U = WS_R, WS_V = WS_R + 18 * MiB, WS_Q = WS_R + 36 * MiB, WS_KF = WS_R + 54 * MiB, WS_KB = WS_R + 72 * MiB, WS_VI = WS_R + 90 * MiB;
constexpr size_t WS_LF = WS_R + 108 * MiB, WS_LB = WS_R + 144 * MiB;
constexpr size_t WS_M1 = WS_R, WS_MB = WS_R + 72 * MiB;
constexpr size_t WS_SG = WS_R + 180 * MiB;
constexpr size_t WS_SA = WS_R + 198 * MiB, WS_SB = WS_R + 234 * MiB;
constexpr size_t WS_OF = WS_R + 270 * MiB, WS_OB = WS_R + 306 * MiB;
constexpr size_t WS_YAB = WS_R + 342 * MiB;
constexpr size_t WS_SLOC = WS_R + 378 * MiB;
constexpr size_t WS_ATOT = WS_R + 394 * MiB;
constexpr size_t WS_VST = WS_R + 395 * MiB;
constexpr size_t WS_END = WS_R + 397 * MiB;
constexpr int CW_TMO = 0, CW_BAR = 4096;

constexpr int RING_OFF = 0, RING_BYTES = 131072;
constexpr int LDSCTL_OFF = RING_BYTES, MISC_OFF = LDSCTL_OFF + 320;
constexpr int LDS_BYTES = 147456;

#define GAS __attribute__((address_space(1)))
#define LAS __attribute__((address_space(3)))
typedef unsigned short bf16;
typedef unsigned v4u __attribute__((ext_vector_type(4)));
typedef unsigned v2u __attribute__((ext_vector_type(2)));
typedef float f32x4 __attribute__((ext_vector_type(4)));
typedef short bf16x8 __attribute__((ext_vector_type(8)));
typedef GAS unsigned gu32;
#define RLX_AGENT __ATOMIC_RELAXED, __HIP_MEMORY_SCOPE_AGENT
#define LDS_WAIT() asm volatile("s_waitcnt lgkmcnt(0)" ::: "memory")
#define VM_WAIT() asm volatile("s_waitcnt vmcnt(0)" ::: "memory")
__device__ __forceinline__ unsigned pk2(float lo, float hi) { return pg8::cvt_pk_bf16(lo, hi); }
__device__ __forceinline__ unsigned pk2_sw(float lo, float hi) { const unsigned a = __float_as_uint(lo), b = __float_as_uint(hi); return ((a + 0x7fffu + ((a >> 16) & 1u)) >> 16) | ((b + 0x7fffu + ((b >> 16) & 1u)) & 0xffff0000u); }
__device__ __forceinline__ float bflo(unsigned w) { return __uint_as_float(w << 16); }
__device__ __forceinline__ float bfhi(unsigned w) { return __uint_as_float(w & 0xffff0000u); }
__device__ __forceinline__ float bf2f(unsigned short b) { return __uint_as_float(((unsigned)b) << 16); }
__device__ __forceinline__ float fsigmoid(float x) { return __builtin_amdgcn_rcpf(1.0f + __expf(-x)); }
__device__ __forceinline__ float fsilu(float x) { return x * fsigmoid(x); }
__device__ __forceinline__ float fgelu_tanh(float x) { return x * fsigmoid(1.5957691216057308f * (x + 0.044715f * x * x * x)); }
__device__ __forceinline__ float wave_sum(float v) {
#pragma unroll
    for (int o = 1; o < 64; o <<= 1) v += __shfl_xor(v, o);
    return v;
}

#define XB_TMO      128
#define XB_XCNT(j)  (256  + 64 * (j))
#define XB_XSUB(j)  (1280 + 64 * (j))
#define XB_XGEN(j)  (2304 + 64 * (j))
#define XB_TOP      3328
#define XB_TOPGEN   3392
#define XCD_BAR_WORDS 3456
#define XB_SPIN_CAP (1u << 18)

__device__ __forceinline__ unsigned xb_ld(unsigned* p)              { return __hip_atomic_load(p, __ATOMIC_RELAXED, __HIP_MEMORY_SCOPE_AGENT); }
__device__ __forceinline__ unsigned xb_add(unsigned* p, unsigned v) { return __hip_atomic_fetch_add(p, v, __ATOMIC_RELAXED, __HIP_MEMORY_SCOPE_AGENT); }
__device__ __forceinline__ unsigned xb_xcc_id() { return (unsigned)__builtin_amdgcn_s_getreg((3 << 11) | 20) & 0xFu; }
#define XB_SPIN(cond, bar) do { unsigned _sp = 0; while (cond) { __builtin_amdgcn_s_sleep(1); \
    if ((++_sp & 255u) == 0u) { if (xb_ld(&(bar)[XB_TMO])) break; if (_sp > XB_SPIN_CAP) { atomicAdd(&(bar)[XB_TMO], 1u); break; } } } } while (0)

struct XcdBarrier {
    unsigned* bar; unsigned x;
    volatile LAS unsigned* st;
};
__device__ __forceinline__ XcdBarrier xcd_barrier_post(unsigned* bar, volatile LAS unsigned* st) {
    XcdBarrier b; b.bar = bar; b.x = xb_xcc_id(); b.st = st;
    if (threadIdx.x == 0) (void)xb_add(&bar[XB_XCNT(b.x)], 1u);
    return b;
}
__device__ __forceinline__ void xcd_barrier_complete(unsigned* bar, unsigned x, unsigned& nloc, unsigned& nx) {
    const unsigned G = gridDim.x * gridDim.y * gridDim.z;
    unsigned sum, cnt, mine, sp = 0u;
    for (;;) {
        sum = 0u; cnt = 0u; mine = 0u;
#pragma unroll
        for (unsigned j = 0; j < 16; ++j) { const unsigned c = xb_ld(&bar[XB_XCNT(j)]); sum += c; cnt += (c > 0u) ? 1u : 0u; mine = (j == x) ? c : mine; }
        if (sum == G) break;
        __builtin_amdgcn_s_sleep(1);
        if ((++sp & 255u) == 0u) { if (xb_ld(&bar[XB_TMO])) break; if (sp > XB_SPIN_CAP) { atomicAdd(&bar[XB_TMO], 1u); break; } }
    }
    nloc = mine > 0u ? mine : 1u; nx = cnt > 0u ? cnt : 1u;
}
__device__ __forceinline__ void xcd_barrier(const XcdBarrier& b) {
    asm volatile("s_waitcnt vmcnt(0)" ::: "memory");
    __syncthreads();
    if (threadIdx.x == 0) {
        unsigned* bar = b.bar;
        __builtin_amdgcn_s_waitcnt(0);
        unsigned nloc = b.st[0], nx = b.st[1];
        if (nloc == 0u) { xcd_barrier_complete(bar, b.x, nloc, nx); b.st[0] = nloc; b.st[1] = nx; }
        const unsigned old = xb_add(&bar[XB_XSUB(b.x)], 1u);
        const unsigned gen = old / nloc;
        if (old + 1u == (gen + 1u) * nloc) {
            __builtin_amdgcn_fence(__ATOMIC_RELEASE, "agent");
            asm volatile("s_waitcnt vmcnt(0)" ::: "memory");
            const unsigned og = xb_add(&bar[XB_TOP], 1u);
            const unsigned tg = og / nx;
            if (og + 1u == (tg + 1u) * nx) xb_add(&bar[XB_TOPGEN], 1u);
            else XB_SPIN(xb_ld(&bar[XB_TOPGEN]) == tg, bar);
            __builtin_amdgcn_fence(__ATOMIC_ACQUIRE, "agent");
            xb_add(&bar[XB_XGEN(b.x)], 1u);
            asm volatile("s_waitcnt vmcnt(0)" ::: "memory");
        } else {
            XB_SPIN(xb_ld(&bar[XB_XGEN(b.x)]) == gen, bar);
            __builtin_amdgcn_fence(__ATOMIC_ACQUIRE, "agent");
            asm volatile("s_waitcnt vmcnt(0)" ::: "memory");
        }
    }
    __syncthreads();
}

using pg8::Unit;
__device__ __forceinline__ v4u pack8(const f32x4 a, const f32x4 b) { v4u w; w.x = pk2(a[0], a[1]); w.y = pk2(a[2], a[3]); w.z = pk2(b[0], b[1]); w.w = pk2(b[2], b[3]); return w; }

struct EpiGU {
    static constexpr bool PERM = true, PERM2 = false, MIDK = false;
    bf16* O;
    __device__ __forceinline__ void operator()(const f32x4 (&acc)[2][2][4][2], const Unit& u, int wr, int wc, int fr, int fq) const {
        const int row0 = u.pm * 256 + wr * 64 + fr, col0 = u.pn * 128 + wc * 32 + 8 * fq;
#pragma unroll
        for (int ai = 0; ai < 2; ++ai)
#pragma unroll
            for (int m = 0; m < 4; ++m) {
                f32x4 v0, v1;
#pragma unroll
                for (int j = 0; j < 4; ++j) { v0[j] = fsilu(acc[ai][0][m][0][j]) * acc[ai][1][m][0][j]; v1[j] = fsilu(acc[ai][0][m][1][j]) * acc[ai][1][m][1][j]; }
                *(v4u*)(O + (size_t)(row0 + ai * 128 + m * 16) * DFF + col0) = pack8(v0, v1);
            }
    }
};
__device__ __forceinline__ v4u dpp_swap1(const v4u x) {
    v4u r; r.x = (unsigned)__builtin_amdgcn_update_dpp(0, (int)x.x, 0xB1, 0xF, 0xF, true); r.y = (unsigned)__builtin_amdgcn_update_dpp(0, (int)x.y, 0xB1, 0xF, 0xF, true);
    r.z = (unsigned)__builtin_amdgcn_update_dpp(0, (int)x.z, 0xB1, 0xF, 0xF, true); r.w = (unsigned)__builtin_amdgcn_update_dpp(0, (int)x.w, 0xB1, 0xF, 0xF, true); return r;
}
struct EpiY {
    static constexpr bool PERM = true, PERM2 = true, MIDK = false;
    bf16* Y16; bf16* YS;
    __device__ __forceinline__ void operator()(const f32x4 (&acc)[2][2][4][2], const Unit& u, int wr, int wc, int fr, int fq) const {
        bf16* base = (u.slab < 0) ? Y16 + (size_t)(u.pm * 256) * DM : YS + (size_t)u.slab * TC * DM + (size_t)(u.pm * 256 - TX) * DM;
        const bool odd = fr & 1;
        bf16* pA = base + (size_t)(wr * 64 + (fr & ~1)) * DM + u.pn * 256 + wc * 64 + 8 * fq + (odd ? 32 : 0);
        bf16* pB = base + (size_t)(wr * 64 + (fr | 1)) * DM + u.pn * 256 + wc * 64 + 8 * fq + (odd ? 32 : 0);
#pragma unroll
        for (int ai = 0; ai < 2; ++ai)
#pragma unroll
            for (int m = 0; m < 4; ++m) {
                const v4u P0 = pack8(acc[ai][0][m][0], acc[ai][0][m][1]), P1 = pack8(acc[ai][1][m][0], acc[ai][1][m][1]);
                v4u X; X.x = odd ? P0.x : P1.x; X.y = odd ? P0.y : P1.y; X.z = odd ? P0.z : P1.z; X.w = odd ? P0.w : P1.w;
                const v4u Y = dpp_swap1(X);
                v4u A, B; A.x = odd ? Y.x : P0.x; A.y = odd ? Y.y : P0.y; A.z = odd ? Y.z : P0.z; A.w = odd ? Y.w : P0.w;
                B.x = odd ? P1.x : Y.x; B.y = odd ? P1.y : Y.y; B.z = odd ? P1.z : Y.z; B.w = odd ? P1.w : Y.w;
                const size_t ro = (size_t)(ai * 128 + m * 16) * DM;
                *(v4u*)(pA + ro) = A; *(v4u*)(pB + ro) = B;
            }
    }
};
constexpr int SEQT = CTXL + SEQ;
__device__ __forceinline__ size_t hm_row(int row) {
    int b, tau; if (row < TX) { b = row >> 11; tau = CTXL + (row & (SEQ - 1)); } else { const int rc = row - TX; b = rc >> 8; tau = rc & (CTXL - 1); }
    return ((size_t)b * NHEAD * SEQT + tau) * HDIM;
}
template <class T>
__device__ __forceinline__ void store_lines(T* pE, T* pO, int second, const v4u C0, const v4u C1, bool odd) {
    v4u X; X.x = odd ? C0.x : C1.x; X.y = odd ? C0.y : C1.y; X.z = odd ? C0.z : C1.z; X.w = odd ? C0.w : C1.w;
    const v4u Y = dpp_swap1(X);
    v4u A, B; A.x = odd ? Y.x : C0.x; A.y = odd ? Y.y : C0.y; A.z = odd ? Y.z : C0.z; A.w = odd ? Y.w : C0.w;
    B.x = odd ? C1.x : Y.x; B.y = odd ? C1.y : Y.y; B.z = odd ? C1.z : Y.z; B.w = odd ? C1.w : Y.w;
    *(v4u*)(pE + (odd ? second : 0)) = A; *(v4u*)(pO + (odd ? second : 0)) = B;
}
struct EpiIN {
    static constexpr bool PERM = true, PERM2 = true, MIDK = false;
    bf16 *U, *V, *Q, *VI, *SG, *SA, *SB; float *LF, *LB; const float* lbt; float* VST;
    static __device__ __forceinline__ void elem_body(const f32x4 (&acc)[2][2][4][2], bf16* O, int ld, int rE, int rO, bool odd, float a1n, float a3n, float m1, float m0) {
#pragma unroll
        for (int ai = 0; ai < 2; ++ai)
#pragma unroll
            for (int m = 0; m < 4; ++m) {
                f32x4 v[2][2];
#pragma unroll
                for (int bj = 0; bj < 2; ++bj)
#pragma unroll
                    for (int n = 0; n < 2; ++n)
#pragma unroll
                        for (int j = 0; j < 4; ++j) { const float t = acc[ai][bj][m][n][j]; const float e = __builtin_amdgcn_exp2f(t * (a3n * (t * t) + a1n)); v[bj][n][j] = (m1 * t + m0) * __builtin_amdgcn_rcpf(1.0f + e); }
                store_lines(O + (size_t)(rE + ai * 128 + m * 16) * ld, O + (size_t)(rO + ai * 128 + m * 16) * ld, 32, pack8(v[0][0], v[0][1]), pack8(v[1][0], v[1][1]), odd);
            }
    }
    __device__ __forceinline__ void operator()(const f32x4 (&acc)[2][2][4][2], const Unit& u, int wr, int wc, int fr, int fq) const {
        const int rowb = u.pm * 256 + wr * 64;
        const int rE = rowb + (fr & ~1), rO = rowb + (fr | 1); const bool odd = fr & 1;
        const int grp = u.pn >> 2;
        const int cg = (u.pn & 3) * 256 + wc * 64 + 8 * fq;
        if (grp >= 2 && grp <= 5) {
            const size_t hoff = (size_t)(cg >> 7) * SEQT * HDIM + (cg & 127);
            if (grp == 3 || grp == 4) {
                const int dir = grp - 3; float* LO = (dir ? LB : LF) + hoff;
#pragma unroll
                for (int bj = 0; bj < 2; ++bj) {
                    const f32x4 l0 = *(const f32x4*)(lbt + dir * 1024 + cg + 32 * bj), l1 = *(const f32x4*)(lbt + dir * 1024 + cg + 32 * bj + 4);
#pragma unroll
                    for (int ai = 0; ai < 2; ++ai)
#pragma unroll
                        for (int m = 0; m < 4; ++m) {
                            f32x4 g0, g1;
#pragma unroll
                            for (int j = 0; j < 4; ++j) {
                                { const float z = fminf(fmaxf(acc[ai][bj][m][0][j], -80.f), 80.f), sg = __builtin_amdgcn_rcpf(1.0f + __expf(-z)), lb = l0[j]; g0[j] = __logf(fmaxf(lb + (1.0f - lb) * sg, 1e-30f)); }
                                { const float z = fminf(fmaxf(acc[ai][bj][m][1][j], -80.f), 80.f), sg = __builtin_amdgcn_rcpf(1.0f + __expf(-z)), lb = l1[j]; g1[j] = __logf(fmaxf(lb + (1.0f - lb) * sg, 1e-30f)); }
                            }
                            v4u c0, c1; __builtin_memcpy(&c0, &g0, 16); __builtin_memcpy(&c1, &g1, 16);
                            store_lines(LO + hm_row(rE + ai * 128 + m * 16) + 32 * bj, LO + hm_row(rO + ai * 128 + m * 16) + 32 * bj, 4, c0, c1, odd);
                        }
                }
            } else {
                bf16* O = ((grp == 2) ? Q : VI) + hoff;
#pragma unroll
                for (int ai = 0; ai < 2; ++ai)
#pragma unroll
                    for (int m = 0; m < 4; ++m)
                        store_lines(O + hm_row(rE + ai * 128 + m * 16), O + hm_row(rO + ai * 128 + m * 16), 32, pack8(acc[ai][0][m][0], acc[ai][0][m][1]), pack8(acc[ai][1][m][0], acc[ai][1][m][1]), odd);
            }
            return;
        }
        if (grp == 1) {
            bf16* O = V + cg;
#pragma unroll
            for (int ai = 0; ai < 2; ++ai)
#pragma unroll
                for (int m = 0; m < 4; ++m) {
                    float sm = 0.f, sq = 0.f; f32x4 v[2][2];
#pragma unroll
                    for (int bj = 0; bj < 2; ++bj)
#pragma unroll
                        for (int n = 0; n < 2; ++n)
#pragma unroll
                            for (int j = 0; j < 4; ++j) { const float t = fgelu_tanh(acc[ai][bj][m][n][j]); v[bj][n][j] = t; sm += t; sq += t * t; }
                    store_lines(O + (size_t)(rE + ai * 128 + m * 16) * 1024, O + (size_t)(rO + ai * 128 + m * 16) * 1024, 32, pack8(v[0][0], v[0][1]), pack8(v[1][0], v[1][1]), odd);
                    sm += __shfl_xor(sm, 16); sm += __shfl_xor(sm, 32); sq += __shfl_xor(sq, 16); sq += __shfl_xor(sq, 32);
                    if (fq == 0) { float* p = VST + ((size_t)(rowb + fr + ai * 128 + m * 16) * 16 + (u.pn & 3) * 4 + wc) * 2; p[0] = sm; p[1] = sq; }
                }
            return;
        }
        bf16* O; int ld, fn;
        if (grp == 0) { O = U + cg; ld = 1024; fn = 1; }
        else if (grp == 6) { O = SG + cg; ld = 1024; fn = 2; }
        else if (grp <= 8) { O = SA + (grp - 7) * 1024 + cg; ld = 2048; fn = 3; }
        else { O = SB + (grp - 9) * 1024 + cg; ld = 2048; fn = 3; }
        const float L2E = 1.4426950408889634f;
        elem_body(acc, O, ld, rE, rO, odd, fn == 1 ? -L2E * 1.5957691216057308f : -L2E, fn == 1 ? -L2E * 1.5957691216057308f * 0.044715f : 0.f, fn == 3 ? 0.f : 1.f, fn == 3 ? 1.f : 0.f);
    }
};
struct EpiMerge {
    static constexpr bool PERM = true, PERM2 = false, MIDK = true;
    const bf16* SA; const bf16* SB; bf16* MB;
    __device__ __forceinline__ void mid(f32x4 (&acc)[2][2][4][2], const Unit& u, int wr, int wc, int fr, int fq) const {
        int row0 = u.pm * 256 + wr * 64 + fr, col0 = u.pn * 256 + wc * 32 + 8 * fq;
        asm volatile("" : "+v"(row0), "+v"(col0));
#pragma unroll
        for (int ai = 0; ai < 2; ++ai)
#pragma unroll
            for (int m = 0; m < 4; ++m) {
#pragma unroll
                for (int bj = 0; bj < 2; ++bj) {
                    const size_t off = (size_t)(row0 + ai * 128 + m * 16) * 2048 + col0 + bj * 128;
                    const v4u a = *(const v4u*)(SA + off), b = *(const v4u*)(SB + off);
                    const unsigned aw[4] = {a.x, a.y, a.z, a.w}, bw[4] = {b.x, b.y, b.z, b.w};
#pragma unroll
                    for (int j = 0; j < 4; ++j) {
                        const float r0 = bflo(aw[j]) * __builtin_amdgcn_rcpf(fmaxf(bflo(bw[j]), 1e-30f)), r1 = bfhi(aw[j]) * __builtin_amdgcn_rcpf(fmaxf(bfhi(bw[j]), 1e-30f));
                        acc[ai][bj][m][j >> 1][2 * (j & 1)] *= r0; acc[ai][bj][m][j >> 1][2 * (j & 1) + 1] *= r1;
                    }
                }
                if (m & 1) asm volatile("" ::: "memory");
            }
    }
    __device__ __forceinline__ void operator()(const f32x4 (&acc)[2][2][4][2], const Unit& u, int wr, int wc, int fr, int fq) const {
        int row0 = u.pm * 256 + wr * 64 + fr, col0 = u.pn * 256 + wc * 32 + 8 * fq;
        asm volatile("" : "+v"(row0), "+v"(col0));
#pragma unroll
        for (int ai = 0; ai < 2; ++ai)
#pragma unroll
            for (int m = 0; m < 4; ++m)
#pragma unroll
                for (int bj = 0; bj < 2; ++bj) {
                    const size_t off = (size_t)(row0 + ai * 128 + m * 16) * 2048 + col0 + bj * 128;
                    const v4u s = *(const v4u*)(SB + off);
                    f32x4 v0 = acc[ai][bj][m][0], v1 = acc[ai][bj][m][1];
                    v0[0] *= fmaxf(bflo(s.x), 1e-30f); v0[1] *= fmaxf(bfhi(s.x), 1e-30f); v0[2] *= fmaxf(bflo(s.y), 1e-30f); v0[3] *= fmaxf(bfhi(s.y), 1e-30f);
                    v1[0] *= fmaxf(bflo(s.z), 1e-30f); v1[1] *= fmaxf(bfhi(s.z), 1e-30f); v1[2] *= fmaxf(bflo(s.w), 1e-30f); v1[3] *= fmaxf(bfhi(s.w), 1e-30f);
                    *(v4u*)(MB + off) = pack8(v0, v1);
                }
    }
};

struct Args { const float* in[20]; float* out; unsigned char* ws; int ph_lo, ph_hi; };

struct Frame {
    LAS unsigned char* lds;
    int wave, G, bx;
};
__device__ __forceinline__ int opaque_tid() { int t = threadIdx.x; asm volatile("" : "+v"(t)); return t; }
#define FTID (tid__)
#define FLANE (tid__ & 63)
#define TID_DECL() const int tid__ = opaque_tid()
__device__ __forceinline__ size_t opaque_zero() { size_t z = 0; asm volatile("" : "+s"(z)); return z; }
#define opaque_ptr(p) ((p) + opaque_zero())
__device__ __forceinline__ int opaque_int(int i) { asm volatile("" : "+s"(i)); return i; }
#define INP(i) (args.in[opaque_int(i)])

constexpr int I_GU = (DM / 64) * (2 * DFF / 32), I_D = (DFF / 64) * (DM / 32), I_IN = (DM / 64) * (INC / 32), I_UP = (DA / 64) * (DM / 32), I_OUT = (DM / 64) * (DM / 32);
constexpr int PER_LAYER = 2 * I_GU + 2 * I_D + I_IN + 2 * I_UP + I_OUT;
constexpr int IT_EARLY = I_GU + I_D + I_IN;
constexpr int SPARE_G = 227;
struct TrItem { const float* src; bf16* dst; int ldsrc, ldd; };
__device__ __forceinline__ TrItem tr_resolve(const Args& args, unsigned char* ws, int it) {
    const int l = it / PER_LAYER; int r = it % PER_LAYER;
    unsigned char* wl = ws + WS_W + (size_t)l * W_LAYER;
    const float* W; bf16* dst; int K, N, ldd, koff = 0; bool gu = false;
    if (r < I_GU) { W = INP(7) + (size_t)l * DM * 2 * DFF; K = DM; N = 2 * DFF; dst = (bf16*)(wl + WO_GU1); ldd = DM; gu = true; }
    else if ((r -= I_GU) < I_D) { W = INP(8) + (size_t)l * DFF * DM; K = DFF; N = DM; dst = (bf16*)(wl + WO_D1); ldd = DFF; }
    else if ((r -= I_D) < I_IN) { W = INP(11) + (size_t)l * DM * INC; K = DM; N = INC; dst = (bf16*)(wl + WO_IN); ldd = DM; }
    else if ((r -= I_IN) < I_UP) { W = INP(17) + (size_t)l * DA * DM; K = DA; N = DM; dst = (bf16*)(wl + WO_UP); ldd = 2 * DA; }
    else if ((r -= I_UP) < I_UP) { W = INP(18) + (size_t)l * DBB * DM; K = DBB; N = DM; dst = (bf16*)(wl + WO_UP); ldd = 2 * DA; koff = DA; }
    else if ((r -= I_UP) < I_OUT) { W = INP(19) + (size_t)l * DM * DM; K = DM; N = DM; dst = (bf16*)(wl + WO_OUT); ldd = DM; }
    else if ((r -= I_OUT) < I_GU) { W = INP(9) + (size_t)l * DM * 2 * DFF; K = DM; N = 2 * DFF; dst = (bf16*)(wl + WO_GU2); ldd = DM; gu = true; }
    else { r -= I_GU; W = INP(10) + (size_t)l * DFF * DM; K = DFF; N = DM; dst = (bf16*)(wl + WO_D2); ldd = DFF; }
    (void)K;
    const int nblk = N / 32, kb = r / nblk, nb = r % nblk;
    int sc0 = 32 * nb;
    if (gu) { const int tile = nb >> 3, within = 32 * (nb & 7); sc0 = (within < 128) ? (128 * tile + within) : (DFF + 128 * tile + within - 128); }
    TrItem t; t.src = W + (size_t)(64 * kb) * N + sc0; t.ldsrc = N; t.dst = dst + (size_t)(32 * nb) * ldd + koff + 64 * kb; t.ldd = ldd; return t;
}
__device__ __forceinline__ void tr_load(const TrItem& t, int lane, f32x4 (&v)[8]) {
    const int rr = lane >> 3, c4 = (lane & 7) * 4;
#pragma unroll
    for (int i = 0; i < 8; ++i) v[i] = __builtin_nontemporal_load((const f32x4*)(t.src + (size_t)(8 * i + rr) * t.ldsrc + c4));
}
__device__ __forceinline__ void tr_emit(const TrItem& t, int lane, const f32x4 (&v)[8], LAS float* scr) {
    const int rr = lane >> 3, c4 = (lane & 7) * 4;
#pragma unroll
    for (int i = 0; i < 8; ++i) { LAS float* s = scr + (8 * i + rr) * 33 + c4; s[0] = v[i][0]; s[1] = v[i][1]; s[2] = v[i][2]; s[3] = v[i][3]; }
    LDS_WAIT(); asm volatile("" ::: "memory");
    const int c = lane & 7;
#pragma unroll
    for (int j = 0; j < 4; ++j) { const int n = (lane >> 3) + 8 * j; const LAS float* s = scr + (8 * c) * 33 + n;
        v4u o; o.x = pk2(s[0 * 33], s[1 * 33]); o.y = pk2(s[2 * 33], s[3 * 33]); o.z = pk2(s[4 * 33], s[5 * 33]); o.w = pk2(s[6 * 33], s[7 * 33]);
        *(v4u*)(t.dst + (size_t)n * t.ldd + 8 * c) = o; }
    LDS_WAIT(); asm volatile("" ::: "memory");
}
__device__ __forceinline__ void convert_items(Frame& F, const Args& args, int it_lo, int it_hi, int iw, int nw) {
    TID_DECL();
    unsigned char* ws = opaque_ptr(args.ws);
    LAS float* scr = (LAS float*)(F.lds + RING_OFF + F.wave * 16384);
    int it = it_lo + iw;
    if (it < it_hi) {
        TrItem cur = tr_resolve(args, ws, it); f32x4 v[8]; tr_load(cur, FLANE, v);
        for (;;) {
            const int itn = it + nw; const bool more = itn < it_hi;
            TrItem nxt = cur; f32x4 vn[8];
            if (more) { nxt = tr_resolve(args, ws, itn); tr_load(nxt, FLANE, vn); }
            tr_emit(cur, FLANE, v, scr);
            if (!more) break;
#pragma unroll
            for (int i = 0; i < 8; ++i) v[i] = vn[i];
            cur = nxt; it = itn;
        }
    }
    __syncthreads();
}
__device__ __forceinline__ void mod_items(Frame& F, const Args& args, int iwg, int nwg) {
    TID_DECL();
    unsigned char* ws = opaque_ptr(args.ws);
    float* mod = (float*)(ws + WS_MOD);
    LAS float* sc = (LAS float*)(F.lds + RING_OFF);
    LAS float* red = (LAS float*)(F.lds + RING_OFF + 65536);
    for (int t = FTID; t < NGRP * DM; t += NWAVES * 64) { const int g = t >> 11, kk = t & (DM - 1);
        const float cv = (g < 4) ? INP(1)[g * DM + kk] : INP(3)[kk];
        sc[t] = cv / (1.0f + __expf(-cv)); }
    __syncthreads();
    constexpr int NB = NMOD * DM / 32;
    const int cg = FLANE & 7, kr = FLANE >> 3;
    for (int it = iwg; it < DEPTH * NB; it += nwg) {
        const int l = it / NB, nb = it % NB;
        const float* W = INP(4) + (size_t)l * DM * NMOD * DM + (size_t)(F.wave * 256 + kr) * (NMOD * DM) + nb * 32 + 4 * cg;
        f32x4 a[NGRP];
#pragma unroll
        for (int g = 0; g < NGRP; ++g) a[g] = (f32x4){0.f, 0.f, 0.f, 0.f};
#pragma unroll 8
        for (int i = 0; i < 32; ++i) { const f32x4 w = __builtin_nontemporal_load((const f32x4*)(W + (size_t)(8 * i) * (NMOD * DM)));
#pragma unroll
            for (int g = 0; g < NGRP; ++g) { const float sv = sc[g * DM + F.wave * 256 + 8 * i + kr]; a[g] += w * sv; } }
#pragma unroll
        for (int g = 0; g < NGRP; ++g)
#pragma unroll
            for (int c = 0; c < 4; ++c) { float v = a[g][c]; v += __shfl_xor(v, 8); v += __shfl_xor(v, 16); v += __shfl_xor(v, 32); a[g][c] = v; }
        if (kr == 0) {
#pragma unroll
            for (int g = 0; g < NGRP; ++g)
#pragma unroll
                for (int c = 0; c < 4; ++c) red[(F.wave * 8 + cg) * 20 + g * 4 + c] = a[g][c]; }
        __syncthreads();
        if (FTID < 160) { const int cgi = FTID / 20, v = FTID % 20, g = v >> 2, c = v & 3; float sum = 0.f;
#pragma unroll
            for (int w = 0; w < NWAVES; ++w) sum += red[(w * 8 + cgi) * 20 + v];
            const int n = nb * 32 + 4 * cgi + c;
            mod[(size_t)(l * NGRP + g) * NMOD * DM + n] = sum + INP(5)[(size_t)l * NMOD * DM + n]; }
        __syncthreads();
    }
}
__device__ __forceinline__ void p0_prologue(Frame& F, const Args& args) {
    TID_DECL();
    unsigned char* ws = opaque_ptr(args.ws);
    convert_items(F, args, 0, I_GU, F.bx * NWAVES + F.wave, F.G * NWAVES);
    mod_items(F, args, F.bx, F.G);
    if (F.bx == 0) {
        float* lbt = (float*)(ws + WS_LBT);
        for (int idx = FTID; idx < 2 * DBB; idx += NWAVES * 64) {
            float z[DEPTH], mx = -3.0e38f, den = 0.f;
#pragma unroll
            for (int l = 0; l < DEPTH; ++l) { z[l] = INP(15)[l * 2 * DBB + idx]; mx = fmaxf(mx, z[l]); }
#pragma unroll
            for (int l = 0; l < DEPTH; ++l) { z[l] = __expf(z[l] - mx); den += z[l]; }
            float cum = 0.f; const float s0 = z[0] / den;
#pragma unroll
            for (int l = 0; l < DEPTH; ++l) { cum += z[l] / den; lbt[l * 2 * DBB + idx] = (l == 0) ? 0.f : (cum - s0); }
        }
    }
}
constexpr int BG_E0 = 34764, BG_E1 = 64264, BG_E2 = 86264, BG_D2_L1 = 2 * PER_LAYER - I_D;
static_assert(BG_E0 >= IT_EARLY && BG_E1 >= PER_LAYER + I_GU && BG_E2 >= PER_LAYER + IT_EARLY + 2 * I_UP + I_OUT && BG_E2 <= BG_D2_L1, "each slot ends after what the next phases need");
constexpr int BG_S2_END = BG_E2;
__device__ __forceinline__ void background_work(Frame& F, const Args& args, int slot) {
    const int iwg = F.bx - SPARE_G, nwg = F.G - SPARE_G, iw = iwg * NWAVES + F.wave, nw = nwg * NWAVES;
    if (slot == 0) convert_items(F, args, I_GU, BG_E0, iw, nw);
    else if (slot == 1) convert_items(F, args, BG_E0, BG_E1, iw, nw);
    else convert_items(F, args, BG_E1, BG_E2, iw, nw);
}
__device__ __forceinline__ void tail_work(Frame& F, const Args& args, int U, int lo, int hi) {
    const int r = U % F.G; if (r == 0 || F.bx < r) return;
    convert_items(F, args, lo, hi, (F.bx - r) * NWAVES + F.wave, (F.G - r) * NWAVES);
}

__device__ __forceinline__ int row_grp(int row) { return row < TX ? (row >> 11) : 4; }
template <int MODE, bool XIN = false>
__device__ __forceinline__ void thin_phase(Frame& F, const Args& args, int nrows, int nslab, const float* gpost, const float* mod_r, int gate_i, float w,
                                           const float* gpre, const float* mod_m, int shift_i, int scale_i) {
    TID_DECL();
    unsigned char* ws = opaque_ptr(args.ws);
    bf16* X = (bf16*)(ws + WS_X); bf16* H = (bf16*)(ws + WS_H);
    const int rpw = nrows / F.G, g0 = row_grp(32 * F.bx), g1 = 4;
    LAS float* VA = (LAS float*)(F.lds + RING_OFF);
    LAS float* VB = VA + 2 * DM;
    LAS float* VC = VB + 2 * DM;
    for (int t = FTID; t < 2 * DM; t += NWAVES * 64) { const int gi = t >> 11, n = t & (DM - 1), g = gi ? g1 : g0;
        if (MODE != 0) VA[t] = w * mod_r[(size_t)(g * NMOD + gate_i) * DM + n] * gpost[n];
        if (MODE != 2) { VB[t] = gpre[n] * (1.0f + mod_m[(size_t)(g * NMOD + scale_i) * DM + n]); VC[t] = mod_m[(size_t)(g * NMOD + shift_i) * DM + n]; } }
    __syncthreads();
    for (int rr = F.wave; rr < rpw; rr += NWAVES) {
        const int row = rr < 32 ? 32 * F.bx + rr : TX + 4 * F.bx + (rr - 32), gi = rr < 32 ? 0 : 1;
        const int e0 = 8 * FLANE;
        f32x4 x[4][2];
        if (MODE == 0 || XIN) {
            const float* src = (row < TX ? INP(0) + (size_t)row * DM : INP(2) + (size_t)(row - TX) * DM) + e0;
#pragma unroll
            for (int j = 0; j < 4; ++j) { x[j][0] = *(const f32x4*)(src + 512 * j); x[j][1] = *(const f32x4*)(src + 512 * j + 4); }
        } else {
#pragma unroll
            for (int j = 0; j < 4; ++j) { const v4u w4 = *(const v4u*)(X + (size_t)row * DM + e0 + 512 * j);
                x[j][0] = (f32x4){bflo(w4.x), bfhi(w4.x), bflo(w4.y), bfhi(w4.y)}; x[j][1] = (f32x4){bflo(w4.z), bfhi(w4.z), bflo(w4.w), bfhi(w4.w)}; }
        }
        if (MODE != 0) {
            f32x4 y[4][2]; float s = 0.f;
            if (row < TX) {
                const bf16* Y16 = (const bf16*)(ws + WS_Y) + (size_t)row * DM + e0;
#pragma unroll
                for (int j = 0; j < 4; ++j) { const v4u w4 = *(const v4u*)(Y16 + 512 * j);
                    y[j][0] = (f32x4){bflo(w4.x), bfhi(w4.x), bflo(w4.y), bfhi(w4.y)}; y[j][1] = (f32x4){bflo(w4.z), bfhi(w4.z), bflo(w4.w), bfhi(w4.w)}; }
            } else {
                const bf16* YS = (const bf16*)(ws + WS_YS) + (size_t)(row - TX) * DM + e0;
#pragma unroll
                for (int j = 0; j < 4; ++j) { const v4u w4 = *(const v4u*)(YS + 512 * j);
                    y[j][0] = (f32x4){bflo(w4.x), bfhi(w4.x), bflo(w4.y), bfhi(w4.y)}; y[j][1] = (f32x4){bflo(w4.z), bfhi(w4.z), bflo(w4.w), bfhi(w4.w)}; }
#pragma unroll 1
                for (int sl = 1; sl < nslab; ++sl)
#pragma unroll
                    for (int j = 0; j < 4; ++j) { const v4u w4 = *(const v4u*)(YS + (size_t)sl * TC * DM + 512 * j);
                        y[j][0] += (f32x4){bflo(w4.x), bfhi(w4.x), bflo(w4.y), bfhi(w4.y)}; y[j][1] += (f32x4){bflo(w4.z), bfhi(w4.z), bflo(w4.w), bfhi(w4.w)}; }
            }
#pragma unroll
            for (int j = 0; j < 4; ++j)
#pragma unroll
                for (int q = 0; q < 2; ++q) s += (y[j][q][0] * y[j][q][0] + y[j][q][1] * y[j][q][1]) + (y[j][q][2] * y[j][q][2] + y[j][q][3] * y[j][q][3]);
            const float r = 1.0f / sqrtf(wave_sum(s) * (1.0f / DM) + EPS);
#pragma unroll
            for (int j = 0; j < 4; ++j)
#pragma unroll
                for (int q = 0; q < 2; ++q) { const f32x4 a = *(const LAS f32x4*)(VA + gi * DM + e0 + 512 * j + 4 * q); x[j][q] += a * y[j][q] * r; }
        }
        if (MODE == 2) {
#pragma unroll
            for (int j = 0; j < 4; ++j) { *(f32x4*)(args.out + (size_t)row * DM + e0 + 512 * j) = x[j][0]; *(f32x4*)(args.out + (size_t)row * DM + e0 + 512 * j + 4) = x[j][1]; }
        } else {
            float s = 0.f;
#pragma unroll
            for (int j = 0; j < 4; ++j) {
                if (MODE != 0) *(v4u*)(X + (size_t)row * DM + e0 + 512 * j) = pack8(x[j][0], x[j][1]);
#pragma unroll
                for (int q = 0; q < 2; ++q) s += (x[j][q][0] * x[j][q][0] + x[j][q][1] * x[j][q][1]) + (x[j][q][2] * x[j][q][2] + x[j][q][3] * x[j][q][3]); }
            const float r = 1.0f / sqrtf(wave_sum(s) * (1.0f / DM) + EPS);
#pragma unroll
            for (int j = 0; j < 4; ++j) { f32x4 h[2];
#pragma unroll
                for (int q = 0; q < 2; ++q) { const f32x4 bb = *(const LAS f32x4*)(VB + gi * DM + e0 + 512 * j + 4 * q), cc = *(const LAS f32x4*)(VC + gi * DM + e0 + 512 * j + 4 * q); h[q] = x[j][q] * r * bb + cc; }
                *(v4u*)(H + (size_t)row * DM + e0 + 512 * j) = pack8(h[0], h[1]); }
        }
    }
    __syncthreads();
}

__device__ __forceinline__ void readout_phase(Frame& F, const Args& args, int nrows, const float* gain) {
    TID_DECL();
    unsigned char* ws = opaque_ptr(args.ws);
    const bf16* OF = (const bf16*)(ws + WS_OF); const bf16* OB = (const bf16*)(ws + WS_OB); const bf16* SG = (const bf16*)(ws + WS_SG); bf16* YAB = (bf16*)(ws + WS_YAB);
    const int gw = F.bx * NWAVES + F.wave, NGW = F.G * NWAVES;
    for (int row = gw; row < nrows; row += NGW) {
        const size_t off = (size_t)row * DBB + 16 * FLANE;
        const size_t hoff = hm_row(row) + (size_t)(FLANE >> 3) * SEQT * HDIM + 16 * (FLANE & 7);
        f32x4 o[4]; float s = 0.f;
#pragma unroll
        for (int j = 0; j < 4; ++j) { const v2u a2 = *(const v2u*)(OF + hoff + 4 * j), b2 = *(const v2u*)(OB + hoff + 4 * j);
            o[j] = (f32x4){bflo(a2.x) + bflo(b2.x), bfhi(a2.x) + bfhi(b2.x), bflo(a2.y) + bflo(b2.y), bfhi(a2.y) + bfhi(b2.y)}; s += (o[j][0] * o[j][0] + o[j][1] * o[j][1]) + (o[j][2] * o[j][2] + o[j][3] * o[j][3]); }
        s += __shfl_xor(s, 1); s += __shfl_xor(s, 2); s += __shfl_xor(s, 4);
        const float r = 1.0f / sqrtf(s * (1.0f / HDIM) + EPS);
        const v4u g0 = *(const v4u*)(SG + off), g1 = *(const v4u*)(SG + off + 8);
        const unsigned gw_[8] = {g0.x, g0.y, g0.z, g0.w, g1.x, g1.y, g1.z, g1.w};
        unsigned ow[8];
#pragma unroll
        for (int j = 0; j < 4; ++j) { const f32x4 gn = *(const f32x4*)(gain + 16 * FLANE + 4 * j);
            const float a0 = o[j][0] * r * gn[0] * bflo(gw_[2 * j]), a1 = o[j][1] * r * gn[1] * bfhi(gw_[2 * j]), a2 = o[j][2] * r * gn[2] * bflo(gw_[2 * j + 1]), a3 = o[j][3] * r * gn[3] * bfhi(gw_[2 * j + 1]);
            ow[2 * j] = pk2(a0, a1); ow[2 * j + 1] = pk2(a2, a3); }
        bf16* dst = YAB + (size_t)row * (2 * DA) + DA + 16 * FLANE;
        *(v4u*)dst = (v4u){ow[0], ow[1], ow[2], ow[3]}; *(v4u*)(dst + 8) = (v4u){ow[4], ow[5], ow[6], ow[7]};
    }
}

constexpr int GM_VNT = 0, GM_STAT = 128 * 272;
__device__ __forceinline__ void gmlp_unit(Frame& F, const Args& args, int row0, int g, const float* cng, const float* wsp, const float* bsp) {
    TID_DECL();
    unsigned char* ws = opaque_ptr(args.ws);
    const bf16* U = (const bf16*)(ws + WS_U); const bf16* V = (const bf16*)(ws + WS_V); bf16* YAB = (bf16*)(ws + WS_YAB);
    LAS unsigned char* vnT = F.lds + RING_OFF + GM_VNT; LAS float* stat = (LAS float*)(F.lds + RING_OFF + GM_STAT);
    if (FTID < 128) {
        const f32x4* p = (const f32x4*)((const float*)(ws + WS_VST) + (size_t)(row0 + FTID) * 32);
        float sm = 0.f, sq = 0.f;
#pragma unroll
        for (int k = 0; k < 8; ++k) { const f32x4 t = p[k]; sm += t[0] + t[2]; sq += t[1] + t[3]; }
        const float mean = sm * (1.0f / DA), var = fmaxf(sq * (1.0f / DA) - mean * mean, 0.f);
        stat[2 * FTID] = mean; stat[2 * FTID + 1] = 1.0f / sqrtf(var + EPS);
    }
    __syncthreads();
    for (int it = FTID; it < 128 * 16; it += NWAVES * 64) {
        const int s = it & 127, dd = it >> 7;
        const v4u a = *(const v4u*)(V + (size_t)(row0 + s) * DA + g * 128 + 8 * dd);
        const float mean = stat[2 * s], rstd = stat[2 * s + 1];
        const f32x4 g0 = *(const f32x4*)(cng + g * 128 + 8 * dd), g1 = *(const f32x4*)(cng + g * 128 + 8 * dd + 4);
        const unsigned wv[4] = {a.x, a.y, a.z, a.w};
#pragma unroll
        for (int j = 0; j < 4; ++j) {
            const float lo = (bflo(wv[j]) - mean) * rstd * (j < 2 ? g0[2 * j] : g1[2 * j - 4]), hi = (bfhi(wv[j]) - mean) * rstd * (j < 2 ? g0[2 * j + 1] : g1[2 * j - 3]);
            const unsigned p = pk2(lo, hi);
            *(LAS unsigned short*)(vnT + (8 * dd + 2 * j) * 272 + 2 * s) = (unsigned short)(p & 0xffffu);
            *(LAS unsigned short*)(vnT + (8 * dd + 2 * j + 1) * 272 + 2 * s) = (unsigned short)(p >> 16);
        }
    }
    __syncthreads();
    const int i = FLANE & 15, gq = FLANE >> 4;
    f32x4 acc[8];
#pragma unroll
    for (int md = 0; md < 8; ++md) acc[md] = (f32x4){0.f, 0.f, 0.f, 0.f};
    const float* wrow = wsp + ((size_t)g * 128 + 16 * F.wave + i) * 128;
#pragma unroll
    for (int kk = 0; kk < 4; ++kk) {
        const f32x4 w0 = *(const f32x4*)(wrow + 32 * kk + 8 * gq), w1 = *(const f32x4*)(wrow + 32 * kk + 8 * gq + 4);
        const v4u wb = pack8(w0, w1); bf16x8 bfrag; __builtin_memcpy(&bfrag, &wb, 16);
#pragma unroll
        for (int md = 0; md < 8; ++md) {
            const bf16x8 afrag = *(const LAS bf16x8*)(vnT + (16 * md + i) * 272 + (32 * kk + 8 * gq) * 2);
            acc[md] = __builtin_amdgcn_mfma_f32_16x16x32_bf16(afrag, bfrag, acc[md], 0, 0, 0);
        }
    }
    const int t = 16 * F.wave + i; const float bias = bsp[g * 128 + t];
#pragma unroll
    for (int md = 0; md < 8; ++md) {
        const size_t col = (size_t)g * 128 + 16 * md + 4 * gq;
        const v2u uu = *(const v2u*)(U + (size_t)(row0 + t) * DA + col);
        v2u o; o.x = pk2(bflo(uu.x) * (acc[md][0] + bias), bfhi(uu.x) * (acc[md][1] + bias)); o.y = pk2(bflo(uu.y) * (acc[md][2] + bias), bfhi(uu.y) * (acc[md][3] + bias));
        *(v2u*)(YAB + (size_t)(row0 + t) * (2 * DA) + col) = o;
    }
    __syncthreads();
}

constexpr int SC_QS = 0, SC_KS = 17408, SC_KET = 34816, SC_VT = 53248, SC_DD = 71680, SC_AT = 73728;
constexpr int SEGLEN = (CTXL + SEQ) / 4, SEG_GROUPS = SEGLEN / 64;
__device__ __forceinline__ int scan_tau(int dir, int sigma) { return dir ? (sigma < CTXL ? CTXL - 1 - sigma : SEQT + CTXL - 1 - sigma) : sigma; }
struct ScanRegs { f32x4 lf[4]; v2u qv[4], vv[4]; };
template <bool FULL>
__device__ __forceinline__ void scan_load(ScanRegs& R, const float* LG, const bf16* Q, const bf16* VI, int dir, int sigma0, int c0) {
#pragma unroll
    for (int p = 0; p < 4; ++p) { const size_t ro = (size_t)scan_tau(dir, sigma0 + p) * HDIM + c0;
        R.lf[p] = *(const f32x4*)(LG + ro); R.vv[p] = *(const v2u*)(VI + ro); if (FULL) R.qv[p] = *(const v2u*)(Q + ro); }
}
template <bool FULL>
__device__ __forceinline__ void scan_stage1(const ScanRegs& R, LAS unsigned char* L, int sb1, int c0, int qi, int lane, f32x4& atot) {
    f32x4 a[4]; a[0] = R.lf[0]; a[1] = a[0] + R.lf[1]; a[2] = a[1] + R.lf[2]; a[3] = a[2] + R.lf[3];
    f32x4 inc = a[3], a15;
#pragma unroll
    for (int c = 0; c < 4; ++c) { float v = inc[c]; float t = __shfl_up(v, 16); if (qi >= 1) v += t; t = __shfl_up(v, 32); if (qi >= 2) v += t; inc[c] = v; a15[c] = __shfl(v, 48 + (lane & 15)); }
    const f32x4 excl = inc - a[3];
    float kef[4][4];
#pragma unroll
    for (int p = 0; p < 4; ++p) {
        const f32x4 ap = a[p] + excl;
        f32x4 kf4;
#pragma unroll
        for (int c = 0; c < 4; ++c) { kf4[c] = 1.0f - __expf(R.lf[p][c]); kef[p][c] = kf4[c] * __expf(a15[c] - ap[c]); }
        if (FULL) {
            const f32x4 qf4 = (f32x4){bflo(R.qv[p].x), bfhi(R.qv[p].x), bflo(R.qv[p].y), bfhi(R.qv[p].y)};
            f32x4 qs, ks;
#pragma unroll
            for (int c = 0; c < 4; ++c) { qs[c] = qf4[c] * __expf(ap[c]); ks[c] = kf4[c] * __expf(fminf(-ap[c], 80.f)); }
            const int ro = (sb1 * 16 + 4 * qi + p) * 272 + 2 * c0;
            *(LAS v2u*)(L + SC_QS + ro) = (v2u){pk2(qs[0], qs[1]), pk2(qs[2], qs[3])};
            *(LAS v2u*)(L + SC_KS + ro) = (v2u){pk2(ks[0], ks[1]), pk2(ks[2], ks[3])};
        }
    }
    const int to = sb1 * 4608 + qi * 1152 + c0 * 8;
    *(LAS v4u*)(L + SC_KET + to) = (v4u){pk2(kef[0][0], kef[1][0]), pk2(kef[2][0], kef[3][0]), pk2(kef[0][1], kef[1][1]), pk2(kef[2][1], kef[3][1])};
    *(LAS v4u*)(L + SC_KET + to + 16) = (v4u){pk2(kef[0][2], kef[1][2]), pk2(kef[2][2], kef[3][2]), pk2(kef[0][3], kef[1][3]), pk2(kef[2][3], kef[3][3])};
    const unsigned v00 = R.vv[0].x, v01 = R.vv[0].y, v10 = R.vv[1].x, v11 = R.vv[1].y, v20 = R.vv[2].x, v21 = R.vv[2].y, v30 = R.vv[3].x, v31 = R.vv[3].y;
    *(LAS v4u*)(L + SC_VT + to) = (v4u){(v00 & 0xffffu) | (v10 << 16), (v20 & 0xffffu) | (v30 << 16), (v00 >> 16) | (v10 & 0xffff0000u), (v20 >> 16) | (v30 & 0xffff0000u)};
    *(LAS v4u*)(L + SC_VT + to + 16) = (v4u){(v01 & 0xffffu) | (v11 << 16), (v21 & 0xffffu) | (v31 << 16), (v01 >> 16) | (v11 & 0xffff0000u), (v21 >> 16) | (v31 & 0xffff0000u)};
    if (qi == 3) *(LAS f32x4*)(L + SC_DD + (sb1 * 128 + c0) * 4) = (f32x4){__expf(a15[0]), __expf(a15[1]), __expf(a15[2]), __expf(a15[3])};
    atot += a15;
}
template <bool FULL>
__device__ __forceinline__ void scan_stage2(f32x4 (&S)[8], LAS unsigned char* L, bf16* O, int dir, int sigma0, bool do_out, int i, int gq, int eb) {
#pragma unroll 1
    for (int sb = 0; sb < 4; ++sb) {
        const v2u vraw = *(const LAS v2u*)(L + SC_VT + sb * 4608 + gq * 1152 + (eb + i) * 8);
        const v4u vw = (v4u){vraw.x, vraw.y, 0u, 0u}; bf16x8 vf; __builtin_memcpy(&vf, &vw, 16);
        if (FULL && do_out) {
            f32x4 P = (f32x4){0.f, 0.f, 0.f, 0.f};
#pragma unroll
            for (int kk = 0; kk < 4; ++kk) {
                const bf16x8 af = *(const LAS bf16x8*)(L + SC_KS + (sb * 16 + i) * 272 + (32 * kk + 8 * gq) * 2);
                const bf16x8 bfr = *(const LAS bf16x8*)(L + SC_QS + (sb * 16 + i) * 272 + (32 * kk + 8 * gq) * 2);
                P = __builtin_amdgcn_mfma_f32_16x16x32_bf16(af, bfr, P, 0, 0, 0);
            }
#pragma unroll
            for (int r = 0; r < 4; ++r) P[r] = (4 * gq + r <= i) ? P[r] : 0.f;
            const v4u pw = (v4u){pk2(P[0], P[1]), pk2(P[2], P[3]), 0u, 0u}; bf16x8 pb; __builtin_memcpy(&pb, &pw, 16);
            f32x4 Oa = __builtin_amdgcn_mfma_f32_16x16x32_bf16(vf, pb, (f32x4){0.f, 0.f, 0.f, 0.f}, 0, 0, 0);
#pragma unroll
            for (int kk = 0; kk < 4; ++kk) {
                const v4u sw = (v4u){pk2(S[2 * kk][0], S[2 * kk][1]), pk2(S[2 * kk][2], S[2 * kk][3]), pk2(S[2 * kk + 1][0], S[2 * kk + 1][1]), pk2(S[2 * kk + 1][2], S[2 * kk + 1][3])};
                bf16x8 sf; __builtin_memcpy(&sf, &sw, 16);
                const v2u q0 = *(const LAS v2u*)(L + SC_QS + (sb * 16 + i) * 272 + (32 * kk + 4 * gq) * 2), q1 = *(const LAS v2u*)(L + SC_QS + (sb * 16 + i) * 272 + (32 * kk + 16 + 4 * gq) * 2);
                const v4u qw = (v4u){q0.x, q0.y, q1.x, q1.y}; bf16x8 qb; __builtin_memcpy(&qb, &qw, 16);
                Oa = __builtin_amdgcn_mfma_f32_16x16x32_bf16(sf, qb, Oa, 0, 0, 0);
            }
            *(v2u*)(O + (size_t)scan_tau(dir, sigma0 + sb * 16 + i) * HDIM + eb + 4 * gq) = (v2u){pk2_sw(Oa[0], Oa[1]), pk2_sw(Oa[2], Oa[3])};
        }
#pragma unroll
        for (int tt = 0; tt < 8; ++tt) {
            const f32x4 dd = *(const LAS f32x4*)(L + SC_DD + (sb * 128 + 16 * tt + 4 * gq) * 4);
            const v2u kraw = *(const LAS v2u*)(L + SC_KET + sb * 4608 + gq * 1152 + (16 * tt + i) * 8);
            const v4u kw = (v4u){kraw.x, kraw.y, 0u, 0u}; bf16x8 kf; __builtin_memcpy(&kf, &kw, 16);
            S[tt] = __builtin_amdgcn_mfma_f32_16x16x32_bf16(kf, vf, S[tt] * dd, 0, 0, 0);
        }
    }
}
template <bool FULL>
__device__ __forceinline__ void scan_pass(Frame& F, const Args& args, int b, int h, int dir, int seg, bool ctx_out) {
    TID_DECL();
    unsigned char* ws = opaque_ptr(args.ws);
    const size_t hb = (size_t)(b * NHEAD + h) * SEQT * HDIM;
    const bf16* Q = (const bf16*)(ws + WS_Q) + hb; const bf16* VI = (const bf16*)(ws + WS_VI) + hb;
    const float* LG = (const float*)(ws + (dir ? WS_LB : WS_LF)) + hb; bf16* O = (bf16*)(ws + (dir ? WS_OB : WS_OF)) + hb;
    f32x4* SLOC = (f32x4*)(ws + WS_SLOC); float* ATOT = (float*)(ws + WS_ATOT);
    const int unit = ((seg * 2 + dir) * NHEAD + h) * BATCH + b;
    LAS unsigned char* L = F.lds + RING_OFF;
    const int sb1 = F.wave >> 1, c0 = 64 * (F.wave & 1) + 4 * (FLANE & 15), qi = FLANE >> 4;
    const int i = FLANE & 15, gq = FLANE >> 4, eb = 16 * F.wave;
    f32x4 S[8];
#pragma unroll
    for (int tt = 0; tt < 8; ++tt) S[tt] = (f32x4){0.f, 0.f, 0.f, 0.f};
    if (FULL) {
        for (int j = 0; j < seg; ++j) { const int uj = ((j * 2 + dir) * NHEAD + h) * BATCH + b;
#pragma unroll
            for (int tt = 0; tt < 8; ++tt) { const f32x4 at = *(const f32x4*)(ATOT + (size_t)uj * HDIM + 16 * tt + 4 * gq);
                const f32x4 dec = (f32x4){__expf(at[0]), __expf(at[1]), __expf(at[2]), __expf(at[3])};
                S[tt] = S[tt] * dec + SLOC[((size_t)(uj * 8 + F.wave) * 8 + tt) * 64 + FLANE]; } }
    }
    f32x4 atot = (f32x4){0.f, 0.f, 0.f, 0.f};
    const int g_lo = seg * SEG_GROUPS, g_hi = g_lo + SEG_GROUPS, pos1 = sb1 * 16 + 4 * qi;
    ScanRegs RA, RB;
    scan_load<FULL>(RA, LG, Q, VI, dir, g_lo * 64 + pos1, c0);
    scan_load<FULL>(RB, LG, Q, VI, dir, (g_lo + 1) * 64 + pos1, c0);
    for (int gi = g_lo; gi < g_hi; gi += 2) {
        __syncthreads();
        scan_stage1<FULL>(RA, L, sb1, c0, qi, FLANE, atot);
        if (gi + 2 < g_hi) scan_load<FULL>(RA, LG, Q, VI, dir, (gi + 2) * 64 + pos1, c0);
        __syncthreads();
        scan_stage2<FULL>(S, L, O, dir, gi * 64, ctx_out || gi >= CTXL / 64, i, gq, eb);
        if (gi + 1 >= g_hi) break;
        __syncthreads();
        scan_stage1<FULL>(RB, L, sb1, c0, qi, FLANE, atot);
        if (gi + 3 < g_hi) scan_load<FULL>(RB, LG, Q, VI, dir, (gi + 3) * 64 + pos1, c0);
        __syncthreads();
        scan_stage2<FULL>(S, L, O, dir, (gi + 1) * 64, ctx_out || gi + 1 >= CTXL / 64, i, gq, eb);
    }
    if (!FULL) {
#pragma unroll
        for (int tt = 0; tt < 8; ++tt) SLOC[((size_t)(unit * 8 + F.wave) * 8 + tt) * 64 + FLANE] = S[tt];
        __syncthreads();
        LAS float* AT = (LAS float*)(L + SC_AT);
        if (qi == 0) *(LAS f32x4*)(AT + F.wave * 64 + 4 * (FLANE & 15)) = atot;
        __syncthreads();
        if (FTID < HDIM) { const int chh = FTID >> 6, cc = FTID & 63; ATOT[(size_t)unit * HDIM + FTID] = (AT[(0 + chh) * 64 + cc] + AT[(2 + chh) * 64 + cc]) + (AT[(4 + chh) * 64 + cc] + AT[(6 + chh) * 64 + cc]); }
    }
    __syncthreads();
}

constexpr int NPH_LAYER = 13, NPHASES = 2 + DEPTH * NPH_LAYER;
__global__ void __launch_bounds__(NWAVES * 64, 2) mk_fwd(Args args) {
    TID_DECL();
    extern __shared__ __attribute__((aligned(16))) unsigned char lds[];
    Frame F;
    F.lds = (LAS unsigned char*)lds;
    F.wave = __builtin_amdgcn_readfirstlane(FTID >> 6);
    F.G = gridDim.x; F.bx = blockIdx.x;
    for (int u = FTID; u < (LDS_BYTES - LDSCTL_OFF) / 4; u += NWAVES * 64) ((LAS unsigned*)(F.lds + LDSCTL_OFF))[u] = 0u;
    __syncthreads();
    XcdBarrier bar = xcd_barrier_post((unsigned*)(args.ws + WS_CTL) + CW_BAR, (volatile LAS unsigned*)(F.lds + MISC_OFF) + 8);
    const int lo = args.ph_lo, hi = args.ph_hi;
#define IN(k) (lo <= (k) && (k) < hi)
    unsigned long long probe_t = (PROBE_PHASE >= 0) ? __builtin_amdgcn_s_memrealtime() : 0ull; const unsigned long long probe_t0 = probe_t;
#define SEAM(k) do { if (IN(k) && IN((k) + 1)) xcd_barrier(bar); \
        if (PROBE_PHASE >= 0) { const unsigned long long tn_ = __builtin_amdgcn_s_memrealtime(); \
            if ((k) == PROBE_PHASE) { const unsigned long long w_ = (unsigned long long)PROBE_MULT * (tn_ - probe_t); while (__builtin_amdgcn_s_memrealtime() - tn_ < w_) __builtin_amdgcn_s_sleep(8); } \
            probe_t = __builtin_amdgcn_s_memrealtime(); } } while (0)
    using pg8::Gemm; using pg8::RectOrder; using pg8::gemm_phase;
    LAS unsigned char* ring = F.lds + RING_OFF;
#define WSB() unsigned char* ws = opaque_ptr(args.ws)
#define MODALL ((const float*)(ws + WS_MOD))
#define NORMG(l_) (INP(6) + (size_t)(l_) * NNORM * DM)
#define MODL(l_) (MODALL + (size_t)(l_) * NGRP * NMOD * DM)
#define WL(l_) (ws + WS_W + (size_t)(l_) * W_LAYER)

    if (IN(0)) { _Pragma("nounroll") for (int rep = 0; rep < REP_P0; ++rep) { p0_prologue(F, args); __syncthreads(); } }
    SEAM(0);
    if (IN(1)) { WSB(); _Pragma("nounroll") for (int rep = 0; rep < REP_THIN; ++rep) thin_phase<0>(F, args, TT, 0, nullptr, nullptr, 0, 0.f, NORMG(0), MODALL, 0, 1); }
    SEAM(1);
#pragma nounroll
    for (int l = 0; l < DEPTH; ++l) {
        const int pb = 2 + l * NPH_LAYER; const bool lastl = (l == DEPTH - 1);
        const int npan_late = lastl ? TX / 256 : TT / 256;
        const int gG = (l == 0) ? SPARE_G : F.G;
        if (IN(pb + 0)) { if (F.bx >= gG) background_work(F, args, 0); else {
            WSB(); Gemm g{(const bf16*)(ws + WS_H), (const bf16*)(WL(l) + WO_GU1), DM, DM}; RectOrder S{0, TT / 256, 0, 2 * DFF / 256, 0, 0, 0, 0, 1, 0, 0, DM / 64, gG, F.bx}; EpiGU E{(bf16*)(ws + WS_ACT)};
            _Pragma("nounroll") for (int rep = 0; rep < REP_GEMM; ++rep) gemm_phase<EpiGU, RectOrder, true, true>(ring, g, S, E);
            if (l == 1) tail_work(F, args, (TT / 256) * (2 * DFF / 256), BG_S2_END, BG_D2_L1); } }
        SEAM(pb + 0);
        if (IN(pb + 1)) { WSB(); Gemm g{(const bf16*)(ws + WS_ACT), (const bf16*)(WL(l) + WO_D1), DFF, DFF}; RectOrder S{0, TX / 256, 0, DM / 256, TX / 256, TC / 256, 0, DM / 256, NSLAB, 12, 10, DFF / 64, F.G, F.bx}; EpiY E{(bf16*)(ws + WS_Y), (bf16*)(ws + WS_YS)};
            _Pragma("nounroll") for (int rep = 0; rep < REP_GEMM; ++rep) gemm_phase<EpiY, RectOrder, true, true>(ring, g, S, E); }
        SEAM(pb + 1);
        if (IN(pb + 2)) { WSB(); _Pragma("nounroll") for (int rep = 0; rep < REP_THIN; ++rep) { if (l == 0 && rep == 0) thin_phase<1, true>(F, args, TT, NSLAB, NORMG(l) + 1 * DM, MODL(l), 2, 0.5f, NORMG(l) + 2 * DM, MODL(l), 3, 4);
            else thin_phase<1>(F, args, TT, NSLAB, NORMG(l) + 1 * DM, MODL(l), 2, rep ? 0.f : 0.5f, NORMG(l) + 2 * DM, MODL(l), 3, 4); } }
        SEAM(pb + 2);
        if (IN(pb + 3)) { if (F.bx >= gG) background_work(F, args, 1); else {
            WSB(); Gemm g{(const bf16*)(ws + WS_H), (const bf16*)(WL(l) + WO_IN), DM, DM};
            RectOrder S{0, lastl ? TX / 256 : TT / 256, 0, INC / 256, TX / 256, lastl ? TC / 256 : 0, 12, 12, 1, 0, 0, DM / 64, gG, F.bx};
            EpiIN E{(bf16*)(ws + WS_U), (bf16*)(ws + WS_V), (bf16*)(ws + WS_Q), (bf16*)(ws + WS_VI), (bf16*)(ws + WS_SG), (bf16*)(ws + WS_SA), (bf16*)(ws + WS_SB),
                    (float*)(ws + WS_LF), (float*)(ws + WS_LB), (const float*)(ws + WS_LBT) + (size_t)l * 2 * DBB, (float*)(ws + WS_VST)};
            _Pragma("nounroll") for (int rep = 0; rep < REP_GEMM; ++rep) gemm_phase<EpiIN, RectOrder, true, true>(ring, g, S, E); } }
        SEAM(pb + 3);
        if (IN(pb + 4)) {
            if (F.bx < 192) { _Pragma("nounroll") for (int rep = 0; rep < REP_S1 * REP_SA; ++rep)
                scan_pass<false>(F, args, F.bx & 3, (F.bx >> 2) & 7, (F.bx >> 5) & 1, F.bx >> 6, !lastl); }
            _Pragma("nounroll") for (int rep = 0; rep < REP_S1 * REP_GMLP; ++rep) {
            const int n3 = lastl ? 5 : 6;
            const int u_lo = F.bx >= 192 ? (F.bx - 192) * n3 : 64 * n3 + F.bx, u_hi = u_lo + (F.bx >= 192 ? n3 : 1);
            for (int it = u_lo; it < u_hi; ++it)
                gmlp_unit(F, args, (it >> 3) * 128, it & 7, INP(12) + (size_t)l * DA, INP(13) + (size_t)l * 8 * 128 * 128, INP(14) + (size_t)l * 8 * 128);
            }
        }
        SEAM(pb + 4);
        if (IN(pb + 5)) { _Pragma("nounroll") for (int rep = 0; rep < REP_S1 * REP_SB; ++rep) scan_pass<true>(F, args, F.bx & 3, (F.bx >> 2) & 7, (F.bx >> 5) & 1, F.bx >> 6, !lastl); }
        SEAM(pb + 5);
        if (IN(pb + 6)) { _Pragma("nounroll") for (int rep = 0; rep < REP_THIN; ++rep) readout_phase(F, args, npan_late * 256, INP(16) + (size_t)l * DBB); }
        SEAM(pb + 6);
        if (IN(pb + 7)) { WSB(); RectOrder S{0, npan_late, 0, DM / 256, 0, 0, 0, 0, 1, 0, 0, 2 * DA / 64, F.G, F.bx};
            Gemm g{(const bf16*)(ws + WS_YAB), (const bf16*)(WL(l) + WO_UP), 2 * DA, 2 * DA}; EpiMerge E{(const bf16*)(ws + WS_SA), (const bf16*)(ws + WS_SB), (bf16*)(ws + WS_MB)};
            _Pragma("nounroll") for (int rep = 0; rep < REP_GEMM; ++rep) gemm_phase<EpiMerge, RectOrder, true, true>(ring, g, S, E); }
        SEAM(pb + 7);
        if (IN(pb + 8)) { WSB(); Gemm g{(const bf16*)(ws + WS_MB), (const bf16*)(WL(l) + WO_OUT), DM, DM}; RectOrder S{0, TX / 256, 0, DM / 256, TX / 256, lastl ? 0 : TC / 256, 0, DM / 256, NSLAB_OUT, 8, 8, DM / 64, F.G, F.bx}; EpiY E{(bf16*)(ws + WS_Y), (bf16*)(ws + WS_YS)};
            _Pragma("nounroll") for (int rep = 0; rep < REP_GEMM; ++rep) gemm_phase<EpiY, RectOrder, true, true>(ring, g, S, E); }
        SEAM(pb + 8);
        if (IN(pb + 9)) { WSB(); _Pragma("nounroll") for (int rep = 0; rep < REP_THIN; ++rep) thin_phase<1>(F, args, npan_late * 256, NSLAB_OUT, NORMG(l) + 3 * DM, MODL(l), 5, rep ? 0.f : 1.0f, NORMG(l) + 4 * DM, MODL(l), 6, 7); }
        SEAM(pb + 9);
        if (IN(pb + 10)) { if (F.bx >= gG) background_work(F, args, 2); else {
            WSB(); Gemm g{(const bf16*)(ws + WS_H), (const bf16*)(WL(l) + WO_GU2), DM, DM}; RectOrder S{0, npan_late, 0, 2 * DFF / 256, 0, 0, 0, 0, 1, 0, 0, DM / 64, gG, F.bx}; EpiGU E{(bf16*)(ws + WS_ACT)};
            _Pragma("nounroll") for (int rep = 0; rep < REP_GEMM; ++rep) gemm_phase<EpiGU, RectOrder, true, true>(ring, g, S, E);
            if (l == 1) tail_work(F, args, npan_late * (2 * DFF / 256), BG_D2_L1, 2 * PER_LAYER); } }
        SEAM(pb + 10);
        if (IN(pb + 11)) { WSB(); Gemm g{(const bf16*)(ws + WS_ACT), (const bf16*)(WL(l) + WO_D2), DFF, DFF}; RectOrder S{0, TX / 256, 0, DM / 256, TX / 256, lastl ? 0 : TC / 256, 0, DM / 256, NSLAB, 12, 10, DFF / 64, F.G, F.bx}; EpiY E{(bf16*)(ws + WS_Y), (bf16*)(ws + WS_YS)};
            _Pragma("nounroll") for (int rep = 0; rep < REP_GEMM; ++rep) gemm_phase<EpiY, RectOrder, true, true>(ring, g, S, E); }
        SEAM(pb + 11);
        if (IN(pb + 12)) { WSB();
            if (lastl) _Pragma("nounroll") for (int rep = 0; rep < REP_THIN; ++rep) thin_phase<2>(F, args, TX, 0, NORMG(l) + 5 * DM, MODL(l), 8, 0.5f, nullptr, nullptr, 0, 0);
            else _Pragma("nounroll") for (int rep = 0; rep < REP_THIN; ++rep) thin_phase<1>(F, args, TT, NSLAB, NORMG(l) + 5 * DM, MODL(l), 8, rep ? 0.f : 0.5f, NORMG(l + 1), MODL(l + 1), 0, 1);
        }
        if (!lastl) SEAM(pb + 12);
    }
    if (PROBE_PHASE == 99 && F.bx == 0) { const unsigned long long tn_ = __builtin_amdgcn_s_memrealtime(), w_ = tn_ - probe_t0; while (__builtin_amdgcn_s_memrealtime() - tn_ < w_) __builtin_amdgcn_s_sleep(8); }
#undef IN
#undef SEAM
}

extern "C" void kernel_launch(void* const* d_in, const int* in_sizes, int n_in, void* d_out, int out_size, void* d_ws, size_t ws_size, hipStream_t stream) {
    static int grid = 0;
    if (grid == 0) {
        if (n_in != 20 || in_sizes[0] != TX * DM || out_size != TX * DM || ws_size < WS_END) {
            fprintf(stderr, "kernel_launch: unexpected shapes / workspace (n_in %d, in0 %d, out %d, ws %zu, need %zu); nothing launched\n", n_in, n_in > 0 ? in_sizes[0] : -1, out_size, ws_size, (size_t)WS_END); grid = -1; return; }
        int dev = 0, cus = 0, per_cu = 0;
        if (hipGetDevice(&dev) != hipSuccess || hipDeviceGetAttribute(&cus, hipDeviceAttributeMultiprocessorCount, dev) != hipSuccess) { grid = -1; return; }
        if (hipFuncSetAttribute((const void*)mk_fwd, hipFuncAttributeMaxDynamicSharedMemorySize, LDS_BYTES) != hipSuccess) { fprintf(stderr, "kernel_launch: hipFuncSetAttribute failed\n"); grid = -1; return; }
        if (hipOccupancyMaxActiveBlocksPerMultiprocessor(&per_cu, (const void*)mk_fwd, NWAVES * 64, LDS_BYTES) != hipSuccess || per_cu < 1)
            fprintf(stderr, "kernel_launch: note: occupancy query reports %d workgroups per CU\n", per_cu);
        (void)hipGetLastError();
        grid = cus;
        if (grid != 256) fprintf(stderr, "kernel_launch: note: %d CUs\n", grid);
    }
    if (grid < 0) return;
    if (hipMemsetAsync((char*)d_ws, 0, ZERO_BYTES, stream) != hipSuccess) { fprintf(stderr, "kernel_launch: memset failed\n"); return; }
    Args a{};
    for (int i = 0; i < 20; ++i) a.in[i] = (const float*)d_in[i];
    a.out = (float*)d_out; a.ws = (unsigned char*)d_ws;
#if MK_PER_PHASE
    for (int p = 0; p < NPHASES; ++p) { a.ph_lo = p; a.ph_hi = p + 1; hipLaunchKernelGGL(mk_fwd, dim3(grid), dim3(NWAVES * 64), LDS_BYTES, stream, a); }
#else
    a.ph_lo = 0; a.ph_hi = NPHASES;
    hipLaunchKernelGGL(mk_fwd, dim3(grid), dim3(NWAVES * 64), LDS_BYTES, stream, a);
#endif
    const hipError_t le = hipPeekAtLastError();
    if (le != hipSuccess) fprintf(stderr, "kernel_launch: launch failed: %s\n", hipGetErrorName(le));
}
```

```cpp
#include <hip/hip_runtime.h>
#include <cstdio>
#include <cstdint>

#ifndef STAG_GU
#define STAG_GU 0
#endif
#ifndef STAG_IN
#define STAG_IN 0
#endif
#ifndef REP_GEMM
#define REP_GEMM 1
#endif
#ifndef REP_P0
#define REP_P0 1
#endif
#ifndef REP_S1
#define REP_S1 1
#endif
#ifndef REP_GMLP
#define REP_GMLP 1
#endif
#ifndef REP_SA
#define REP_SA 1
#endif
#ifndef REP_SB
#define REP_SB 1
#endif
#ifndef REP_THIN
#define REP_THIN 1
#endif
#ifndef PROBE_PHASE
#define PROBE_PHASE (-1)
#endif
#ifndef PROBE_MULT
#define PROBE_MULT 9
#endif
#ifndef MK_PER_PHASE
#define MK_PER_PHASE 0
#endif

namespace pg8 {
#define PG8_LAS __attribute__((address_space(3)))
typedef unsigned short bf16_t;
typedef short bf16x8 __attribute__((ext_vector_type(8)));
typedef float f32x4 __attribute__((ext_vector_type(4)));
typedef unsigned u32x4 __attribute__((ext_vector_type(4)));
constexpr int BM = 256, BK = 64, HALF = 128, HTB = HALF * BK * 2, STAGE_BYTES = 8 * HTB, NXCD = 8, WGM = 8;

__host__ __device__ __forceinline__ int lds_byte(int r, int c) { const int st = (r >> 4) * 2 + (c >> 5), rr = r & 15, cc = c & 31, ob = rr * 64 + cc * 2; return st * 1024 + (ob ^ (((ob >> 9) & 1) << 5)); }
__host__ __device__ __forceinline__ void stage_rc(int b, int& R, int& C) { const int st = b / 1024, sb = b % 1024, swz = sb ^ (((sb >> 9) & 1) << 5); R = (st >> 1) * 16 + swz / 64; C = (st & 1) * 32 + (swz % 64) / 2; }
__host__ __device__ __forceinline__ int perm32(int rho) { const int n = rho >> 4, i = rho & 15; return 8 * (i >> 2) + 4 * n + (i & 3); }

struct Unit { int pm, pn, kt0, nkt, slab; };
struct Gemm { const bf16_t* A; const bf16_t* Bt; int lda, ldb; };

struct RectOrder {
    int pma, nma, pna, nna, pmb, nmb, pnb, nnb, nsl, kA, kB, KT, G, c;
    __device__ __forceinline__ void map(int wgid, int nM, int nN, int pm0, int pn0, Unit& u) const {
        const int nwg = nM * nN;
        { const int q = nwg / NXCD, r = nwg % NXCD, xcd = wgid % NXCD, off = wgid / NXCD; wgid = (xcd < r ? xcd * (q + 1) : r * (q + 1) + (xcd - r) * q) + off; }
        const int nig = WGM * nN, gid = wgid / nig, fm = gid * WGM, gsz = (nM - fm) < WGM ? (nM - fm) : WGM;
        u.pm = pm0 + fm + ((wgid % nig) % gsz); u.pn = pn0 + (wgid % nig) / gsz;
    }
    __device__ __forceinline__ bool next(int i, Unit& u) const {
        long L = (long)i * G + c; const int na = nma * nna;
        if (L < na) { map((int)L, nma, nna, pma, pna, u); u.kt0 = 0; u.nkt = KT; u.slab = -1; return true; }
        L -= na; const int nb1 = nmb * nnb;
        if (L < (long)nb1 * nsl) { const int sl = (int)(L / nb1); map((int)(L % nb1), nmb, nnb, pmb, pnb, u);
            if (nsl > 1) { u.kt0 = (sl >> 1) * (kA + kB) + (sl & 1) * kA; u.nkt = (sl & 1) ? kB : kA; u.slab = sl; } else { u.kt0 = 0; u.nkt = KT; u.slab = -1; }
            return true; }
        return false;
    }
    __device__ __forceinline__ void a_ready(const Unit&) const {}
    __device__ __forceinline__ void done(const Unit&) const {}
};

__device__ __forceinline__ unsigned cvt_pk_bf16(float lo, float hi) { unsigned r; asm volatile("v_cvt_pk_bf16_f32 %0, %1, %2" : "=v"(r) : "v"(lo), "v"(hi)); return r; }

template <class Epi, class Sched, bool ALIGN_EPI = false, bool SP2 = false>
__device__ __forceinline__ void gemm_phase(PG8_LAS unsigned char* lds, const Gemm g, const Sched& S, const Epi& E, unsigned stagger = 0u) {
    int tid_ = threadIdx.x; asm volatile("" : "+v"(tid_));
    const int tid = tid_, wid = __builtin_amdgcn_readfirstlane(tid >> 6), lane = tid & 63, wr = wid >> 2, wc = wid & 3, fr = lane & 15, fq = lane >> 4;
    unsigned voffA[2], voffB[2];
#pragma unroll
    for (int i = 0; i < 2; ++i) { int R, C; stage_rc(tid * 16 + i * 8192, R, C);
        const int Rb = Epi::PERM2 ? (64 * (R >> 5) + perm32(R & 31)) : (Epi::PERM ? ((R & ~31) + perm32(R & 31)) : R);
        voffA[i] = (unsigned)(R * g.lda + C) * 2u; voffB[i] = (unsigned)(Rb * g.ldb + C) * 2u; }
    const size_t kstep = (size_t)(BK * 2);
    const size_t hstepA = (size_t)HALF * g.lda * 2, hstepB = (size_t)(Epi::PERM2 ? 32 : HALF) * g.ldb * 2;
    const size_t tstepA = 2 * hstepA, tstepB = (size_t)BM * g.ldb * 2;
    const unsigned ldsw = (unsigned)wid * 1024u;
    const int aoff = lds_byte(wr * 64 + fr, fq * 8), boff = lds_byte(wc * 32 + fr, fq * 8);
#define PG8_SA(b, h) (((b) * 2 + (h)) * HTB)
#define PG8_SB(b, h) ((4 + (b) * 2 + (h)) * HTB)
#define PG8_STAGE(bufoff, gbase, voff) do { _Pragma("unroll") for (int _i = 0; _i < 2; ++_i) \
        __builtin_amdgcn_global_load_lds((const unsigned*)((const char*)(gbase) + (voff)[_i]), (PG8_LAS unsigned*)(lds + (bufoff) + ldsw + _i * 8192), 16, 0, 0); } while (0)
#define PG8_LDA(dst, b, h) do { _Pragma("unroll") for (int m = 0; m < 4; ++m) _Pragma("unroll") for (int k = 0; k < 2; ++k) dst[m][k] = *(const PG8_LAS bf16x8*)(lds + PG8_SA(b, h) + aoff + m * 2048 + k * 1024); } while (0)
#define PG8_LDB(dst, b, h) do { _Pragma("unroll") for (int n = 0; n < 2; ++n) _Pragma("unroll") for (int k = 0; k < 2; ++k) dst[n][k] = *(const PG8_LAS bf16x8*)(lds + PG8_SB(b, h) + boff + n * 2048 + k * 1024); } while (0)
#define PG8_MMA(ai, bj, At, Bt) do { __builtin_amdgcn_s_setprio(1); _Pragma("unroll") for (int m = 0; m < 4; ++m) _Pragma("unroll") for (int n = 0; n < 2; ++n) _Pragma("unroll") for (int k = 0; k < 2; ++k) \
        acc[ai][bj][m][n] = __builtin_amdgcn_mfma_f32_16x16x32_bf16(Bt[n][k], At[m][k], acc[ai][bj][m][n], 0, 0, 0); __builtin_amdgcn_s_setprio(0); } while (0)
#define PG8_WAIT_V(n) asm volatile("s_waitcnt vmcnt(" #n ")" ::: "memory")
#define PG8_WAIT_L(n) asm volatile("s_waitcnt lgkmcnt(" #n ")" ::: "memory")
#define PG8_BAR __builtin_amdgcn_s_barrier()
#define PG8_SCHED __builtin_amdgcn_sched_barrier(0)
    Unit cur, nxt; int ui = 0;
    if (!S.next(0, cur)) return;
    if (stagger) { const unsigned long long t0_ = __builtin_amdgcn_s_memrealtime(); while (__builtin_amdgcn_s_memrealtime() - t0_ < stagger) __builtin_amdgcn_s_sleep(4); }
    f32x4 acc[2][2][4][2];
#pragma unroll
    for (int a = 0; a < 2; ++a)
#pragma unroll
        for (int b = 0; b < 2; ++b)
#pragma unroll
            for (int m = 0; m < 4; ++m)
#pragma unroll
                for (int n = 0; n < 2; ++n) acc[a][b][m][n] = (f32x4){0.f, 0.f, 0.f, 0.f};
    bf16x8 At[4][2], B0[2][2], B1[2][2];
    const char* cA = (const char*)g.A + (size_t)cur.pm * tstepA + (size_t)cur.kt0 * kstep; const char* cB = (const char*)g.Bt + (size_t)cur.pn * tstepB + (size_t)cur.kt0 * kstep;
    S.a_ready(cur);
    if constexpr (SP2) {
        PG8_STAGE(PG8_SB(0, 0), cB, voffB); PG8_STAGE(PG8_SB(0, 1), cB + hstepB, voffB); PG8_STAGE(PG8_SA(0, 0), cA, voffA); PG8_STAGE(PG8_SA(0, 1), cA + hstepA, voffA);
        if (wr == 1) PG8_BAR;
        PG8_WAIT_V(2); PG8_BAR;
        PG8_STAGE(PG8_SB(1, 0), cB + kstep, voffB); PG8_STAGE(PG8_SA(1, 0), cA + kstep, voffA); PG8_STAGE(PG8_SB(1, 1), cB + hstepB + kstep, voffB);
        PG8_WAIT_V(6); PG8_BAR;
    } else {
        PG8_STAGE(PG8_SB(0, 0), cB, voffB); PG8_STAGE(PG8_SA(0, 0), cA, voffA); PG8_STAGE(PG8_SB(0, 1), cB + hstepB, voffB); PG8_STAGE(PG8_SA(0, 1), cA + hstepA, voffA);
        if (wr == 1) PG8_BAR;
        PG8_WAIT_V(4); PG8_BAR;
        PG8_STAGE(PG8_SB(1, 0), cB + kstep, voffB); PG8_STAGE(PG8_SA(1, 0), cA + kstep, voffA); PG8_STAGE(PG8_SB(1, 1), cB + hstepB + kstep, voffB);
        PG8_WAIT_V(6); PG8_BAR;
    }
    for (;;) {
        const bool has_next = S.next(ui + 1, nxt);
        const char* nA = has_next ? (const char*)g.A + (size_t)nxt.pm * tstepA + (size_t)nxt.kt0 * kstep : cA; const char* nB = has_next ? (const char*)g.Bt + (size_t)nxt.pn * tstepB + (size_t)nxt.kt0 * kstep : cB;
        const int nt = cur.nkt;
        for (int t = 0; t < nt; t += 2) {
            const bool last = (t == nt - 2);
            const char* a1 = cA + (size_t)(t + 1) * kstep;
            const char* a2 = last ? nA : cA + (size_t)(t + 2) * kstep; const char* b2 = last ? nB : cB + (size_t)(t + 2) * kstep;
            const char* a3 = a2 + kstep; const char* b3 = b2 + kstep;
            if (last && has_next) S.a_ready(nxt);
            if constexpr (Epi::MIDK) { if (t == (nt >> 1)) E.mid(acc, cur, wr, wc, fr, fq); }
            if constexpr (SP2) {
            PG8_LDB(B0, 0, 0); PG8_LDB(B1, 0, 1); PG8_SCHED; PG8_LDA(At, 0, 0); PG8_STAGE(PG8_SA(1, 1), a1 + hstepA, voffA);
            PG8_WAIT_V(8); PG8_WAIT_L(0); PG8_BAR; PG8_MMA(0, 0, At, B0); PG8_MMA(0, 1, At, B1); PG8_BAR; PG8_SCHED;
            PG8_LDA(At, 0, 1); PG8_STAGE(PG8_SB(0, 0), b2, voffB); PG8_STAGE(PG8_SB(0, 1), b2 + hstepB, voffB); PG8_STAGE(PG8_SA(0, 0), a2, voffA);
            PG8_WAIT_V(8); PG8_WAIT_L(0); PG8_BAR; PG8_MMA(1, 0, At, B0); PG8_MMA(1, 1, At, B1); PG8_BAR; PG8_SCHED;
            PG8_LDB(B0, 1, 0); PG8_LDB(B1, 1, 1); PG8_SCHED; PG8_LDA(At, 1, 0); PG8_STAGE(PG8_SA(0, 1), a2 + hstepA, voffA);
            PG8_WAIT_V(8); PG8_WAIT_L(0); PG8_BAR; PG8_MMA(0, 0, At, B0); PG8_MMA(0, 1, At, B1); PG8_BAR; PG8_SCHED;
            PG8_LDA(At, 1, 1); PG8_STAGE(PG8_SB(1, 0), b3, voffB); PG8_STAGE(PG8_SB(1, 1), b3 + hstepB, voffB); PG8_STAGE(PG8_SA(1, 0), a3, voffA);
            PG8_WAIT_V(8); PG8_WAIT_L(0); PG8_BAR; PG8_MMA(1, 0, At, B0); PG8_MMA(1, 1, At, B1); PG8_BAR; PG8_SCHED;
            } else {
            PG8_LDB(B0, 0, 0); PG8_SCHED; PG8_LDA(At, 0, 0); PG8_STAGE(PG8_SA(1, 1), a1 + hstepA, voffA);
            PG8_WAIT_L(8); PG8_BAR; PG8_WAIT_L(0); PG8_MMA(0, 0, At, B0); PG8_BAR; PG8_SCHED;
            PG8_LDB(B1, 0, 1); PG8_STAGE(PG8_SB(0, 0), b2, voffB);
            PG8_BAR; PG8_WAIT_L(0); PG8_MMA(0, 1, At, B1); PG8_BAR;
            PG8_LDA(At, 0, 1); PG8_STAGE(PG8_SA(0, 0), a2, voffA);
            PG8_BAR; PG8_WAIT_L(0); PG8_MMA(1, 0, At, B0); PG8_BAR; PG8_SCHED;
            PG8_STAGE(PG8_SB(0, 1), b2 + hstepB, voffB);
            PG8_WAIT_V(6); PG8_BAR; PG8_MMA(1, 1, At, B1); PG8_BAR;
            PG8_LDB(B0, 1, 0); PG8_SCHED; PG8_LDA(At, 1, 0); PG8_STAGE(PG8_SA(0, 1), a2 + hstepA, voffA);
            PG8_WAIT_L(8); PG8_BAR; PG8_WAIT_L(0); PG8_MMA(0, 0, At, B0); PG8_BAR; PG8_SCHED;
            PG8_LDB(B1, 1, 1); PG8_STAGE(PG8_SB(1, 0), b3, voffB);
            PG8_BAR; PG8_WAIT_L(0); PG8_MMA(0, 1, At, B1); PG8_BAR;
            PG8_LDA(At, 1, 1); PG8_STAGE(PG8_SA(1, 0), a3, voffA);
            PG8_BAR; PG8_WAIT_L(0); PG8_MMA(1, 0, At, B0); PG8_BAR; PG8_SCHED;
            PG8_STAGE(PG8_SB(1, 1), b3 + hstepB, voffB);
            PG8_WAIT_V(6); PG8_BAR; PG8_MMA(1, 1, At, B1); PG8_BAR;
            }
        }
        if constexpr (ALIGN_EPI) { if (wr == 0) PG8_BAR; }
        asm volatile("s_nop 7\n\ts_nop 7" ::: "memory");
        E(acc, cur, wr, wc, fr, fq); S.done(cur);
        if (!has_next) break;
#pragma unroll
        for (int a = 0; a < 2; ++a)
#pragma unroll
            for (int b = 0; b < 2; ++b)
#pragma unroll
                for (int m = 0; m < 4; ++m)
#pragma unroll
                    for (int n = 0; n < 2; ++n) acc[a][b][m][n] = (f32x4){0.f, 0.f, 0.f, 0.f};
        cur = nxt; cA = nA; cB = nB; ++ui;
        if constexpr (ALIGN_EPI) { if (wr == 1) PG8_BAR; }
    }
    PG8_WAIT_V(0);
    if constexpr (!ALIGN_EPI) { if (wr == 0) PG8_BAR; }
    PG8_BAR;
#undef PG8_SA
#undef PG8_SB
#undef PG8_STAGE
#undef PG8_LDA
#undef PG8_LDB
#undef PG8_MMA
#undef PG8_WAIT_V
#undef PG8_WAIT_L
#undef PG8_BAR
#undef PG8_SCHED
}
}

constexpr int NWAVES = 8;
constexpr int DM = 2048, BATCH = 4, SEQ = 2048, DEPTH = 2, CTXL = 256, DFF = 5632, DA = 1024, DBB = 1024, NHEAD = 8, HDIM = 128, NMOD = 9, NNORM = 6;
constexpr int INC = 2 * DA + 5 * DBB + 2 * DM;
constexpr int TX = BATCH * SEQ, TC = BATCH * CTXL, TT = TX + TC;
constexpr int NGRP = 5;
constexpr float EPS = 1e-6f;

constexpr size_t MiB = 1u << 20;
constexpr size_t WS_CTL = 0, WS_MOD = 1 * MiB, ZERO_BYTES = 32768;
constexpr size_t WS_LBT = 2 * MiB;
constexpr size_t WS_W = 4 * MiB, W_LAYER = 192 * MiB;
constexpr size_t WO_GU1 = 0, WO_D1 = 44 * MiB, WO_IN = 66 * MiB, WO_UP = 110 * MiB, WO_OUT = 118 * MiB, WO_GU2 = 126 * MiB, WO_D2 = 170 * MiB;
constexpr size_t WS_X = 388 * MiB;
constexpr size_t WS_H = 460 * MiB;
constexpr size_t WS_Y = 496 * MiB;
constexpr size_t WS_YS = 528 * MiB;
constexpr int NSLAB = 8, NSLAB_OUT = 4;
constexpr size_t WS_R = 592 * MiB;
constexpr size_t WS_ACT = WS_R;
constexpr size_t WS_U = WS_R, WS_V = WS_R + 18 * MiB, WS_Q = WS_R + 36 * MiB, WS_KF = WS_R + 54 * MiB, WS_KB = WS_R + 72 * MiB, WS_VI = WS_R + 90 * MiB;
constexpr size_t WS_LF = WS_R + 108 * MiB, WS_LB = WS_R + 144 * MiB;
constexpr size_t WS_M1 = WS_R, WS_MB = WS_R + 72 * MiB;
constexpr size_t WS_SG = WS_R + 180 * MiB;
constexpr size_t WS_SA = WS_R + 198 * MiB, WS_SB = WS_R + 234 * MiB;
constexpr size_t WS_OF = WS_R + 270 * MiB, WS_OB = WS_R + 306 * MiB;
constexpr size_t WS_YAB = WS_R + 342 * MiB;
constexpr size_t WS_SLOC = WS_R + 378 * MiB;
constexpr size_t WS_ATOT = WS_R + 394 * MiB;
constexpr size_t WS_VST = WS_R + 395 * MiB;
constexpr size_t WS_END = WS_R + 397 * MiB;
constexpr int CW_TMO = 0, CW_BAR = 4096;

constexpr int RING_OFF = 0, RING_BYTES = 131072;
constexpr int LDSCTL_OFF = RING_BYTES, MISC_OFF = LDSCTL_OFF + 320;
constexpr int LDS_BYTES = 147456;

#define GAS __attribute__((address_space(1)))
#define LAS __attribute__((address_space(3)))
typedef unsigned short bf16;
typedef unsigned v4u __attribute__((ext_vector_type(4)));
typedef unsigned v2u __attribute__((ext_vector_type(2)));
typedef float f32x4 __attribute__((ext_vector_type(4)));
typedef short bf16x8 __attribute__((ext_vector_type(8)));
typedef GAS unsigned gu32;
#define RLX_AGENT __ATOMIC_RELAXED, __HIP_MEMORY_SCOPE_AGENT
#define LDS_WAIT() asm volatile("s_waitcnt lgkmcnt(0)" ::: "memory")
#define VM_WAIT() asm volatile("s_waitcnt vmcnt(0)" ::: "memory")
__device__ __forceinline__ unsigned pk2(float lo, float hi) { return pg8::cvt_pk_bf16(lo, hi); }
__device__ __forceinline__ unsigned pk2_sw(float lo, float hi) { const unsigned a = __float_as_uint(lo), b = __float_as_uint(hi); return ((a + 0x7fffu + ((a >> 16) & 1u)) >> 16) | ((b + 0x7fffu + ((b >> 16) & 1u)) & 0xffff0000u); }
typedef _Float16 h16x2 __attribute__((ext_vector_type(2)));
__device__ __forceinline__ unsigned pkh(float lo, float hi) { const h16x2 h = {(_Float16)lo, (_Float16)hi}; return __builtin_bit_cast(unsigned, h); }
__device__ __forceinline__ float hlo(unsigned w) { return (float)__builtin_bit_cast(h16x2, w)[0]; }
__device__ __forceinline__ float hhi(unsigned w) { return (float)__builtin_bit_cast(h16x2, w)[1]; }
__device__ __forceinline__ float bflo(unsigned w) { return __uint_as_float(w << 16); }
__device__ __forceinline__ float bfhi(unsigned w) { return __uint_as_float(w & 0xffff0000u); }
__device__ __forceinline__ float bf2f(unsigned short b) { return __uint_as_float(((unsigned)b) << 16); }
__device__ __forceinline__ float fsigmoid(float x) { return __builtin_amdgcn_rcpf(1.0f + __expf(-x)); }
__device__ __forceinline__ float fsilu(float x) { return x * fsigmoid(x); }
__device__ __forceinline__ float fgelu_tanh(float x) { return x * fsigmoid(1.5957691216057308f * (x + 0.044715f * x * x * x)); }
__device__ __forceinline__ float wave_sum(float v) {
#pragma unroll
    for (int o = 1; o < 64; o <<= 1) v += __shfl_xor(v, o);
    return v;
}

#define XB_TMO      128
#define XB_XCNT(j)  (256  + 64 * (j))
#define XB_XSUB(j)  (1280 + 64 * (j))
#define XB_XGEN(j)  (2304 + 64 * (j))
#define XB_TOP      3328
#define XB_TOPGEN   3392
#define XCD_BAR_WORDS 3456
#define XB_SPIN_CAP (1u << 18)

__device__ __forceinline__ unsigned xb_ld(unsigned* p)              { return __hip_atomic_load(p, __ATOMIC_RELAXED, __HIP_MEMORY_SCOPE_AGENT); }
__device__ __forceinline__ unsigned xb_add(unsigned* p, unsigned v) { return __hip_atomic_fetch_add(p, v, __ATOMIC_RELAXED, __HIP_MEMORY_SCOPE_AGENT); }
__device__ __forceinline__ unsigned xb_xcc_id() { return (unsigned)__builtin_amdgcn_s_getreg((3 << 11) | 20) & 0xFu; }
#define XB_SPIN(cond, bar) do { unsigned _sp = 0; while (cond) { __builtin_amdgcn_s_sleep(1); \
    if ((++_sp & 255u) == 0u) { if (xb_ld(&(bar)[XB_TMO])) break; if (_sp > XB_SPIN_CAP) { atomicAdd(&(bar)[XB_TMO], 1u); break; } } } } while (0)

struct XcdBarrier {
    unsigned* bar; unsigned x;
    volatile LAS unsigned* st;
};
__device__ __forceinline__ XcdBarrier xcd_barrier_post(unsigned* bar, volatile LAS unsigned* st) {
    XcdBarrier b; b.bar = bar; b.x = xb_xcc_id(); b.st = st;
    if (threadIdx.x == 0) (void)xb_add(&bar[XB_XCNT(b.x)], 1u);
    return b;
}
__device__ __forceinline__ void xcd_barrier_complete(unsigned* bar, unsigned x, unsigned& nloc, unsigned& nx) {
    const unsigned G = gridDim.x * gridDim.y * gridDim.z;
    unsigned sum, cnt, mine, sp = 0u;
    for (;;) {
        sum = 0u; cnt = 0u; mine = 0u;
#pragma unroll
        for (unsigned j = 0; j < 16; ++j) { const unsigned c = xb_ld(&bar[XB_XCNT(j)]); sum += c; cnt += (c > 0u) ? 1u : 0u; mine = (j == x) ? c : mine; }
        if (sum == G) break;
        __builtin_amdgcn_s_sleep(1);
        if ((++sp & 255u) == 0u) { if (xb_ld(&bar[XB_TMO])) break; if (sp > XB_SPIN_CAP) { atomicAdd(&bar[XB_TMO], 1u); break; } }
    }
    nloc = mine > 0u ? mine : 1u; nx = cnt > 0u ? cnt : 1u;
}
__device__ __forceinline__ void xcd_barrier(const XcdBarrier& b) {
    asm volatile("s_waitcnt vmcnt(0)" ::: "memory");
    __syncthreads();
    if (threadIdx.x == 0) {
        unsigned* bar = b.bar;
        __builtin_amdgcn_s_waitcnt(0);
        unsigned nloc = b.st[0], nx = b.st[1];
        if (nloc == 0u) { xcd_barrier_complete(bar, b.x, nloc, nx); b.st[0] = nloc; b.st[1] = nx; }
        const unsigned old = xb_add(&bar[XB_XSUB(b.x)], 1u);
        const unsigned gen = old / nloc;
        if (old + 1u == (gen + 1u) * nloc) {
            __builtin_amdgcn_fence(__ATOMIC_RELEASE, "agent");
            asm volatile("s_waitcnt vmcnt(0)" ::: "memory");
            const unsigned og = xb_add(&bar[XB_TOP], 1u);
            const unsigned tg = og / nx;
            if (og + 1u == (tg + 1u) * nx) xb_add(&bar[XB_TOPGEN], 1u);
            else XB_SPIN(xb_ld(&bar[XB_TOPGEN]) == tg, bar);
            __builtin_amdgcn_fence(__ATOMIC_ACQUIRE, "agent");
            xb_add(&bar[XB_XGEN(b.x)], 1u);
            asm volatile("s_waitcnt vmcnt(0)" ::: "memory");
        } else {
            XB_SPIN(xb_ld(&bar[XB_XGEN(b.x)]) == gen, bar);
            __builtin_amdgcn_fence(__ATOMIC_ACQUIRE, "agent");
            asm volatile("s_waitcnt vmcnt(0)" ::: "memory");
        }
    }
    __syncthreads();
}

using pg8::Unit;
__device__ __forceinline__ v4u pack8(const f32x4 a, const f32x4 b) { v4u w; w.x = pk2(a[0], a[1]); w.y = pk2(a[2], a[3]); w.z = pk2(b[0], b[1]); w.w = pk2(b[2], b[3]); return w; }

struct EpiGU {
    static constexpr bool PERM = true, PERM2 = false, MIDK = false;
    bf16* O;
    __device__ __forceinline__ void operator()(const f32x4 (&acc)[2][2][4][2], const Unit& u, int wr, int wc, int fr, int fq) const {
        const int row0 = u.pm * 256 + wr * 64 + fr, col0 = u.pn * 128 + wc * 32 + 8 * fq;
#pragma unroll
        for (int ai = 0; ai < 2; ++ai)
#pragma unroll
            for (int m = 0; m < 4; ++m) {
                f32x4 v0, v1;
#pragma unroll
                for (int j = 0; j < 4; ++j) { v0[j] = fsilu(acc[ai][0][m][0][j]) * acc[ai][1][m][0][j]; v1[j] = fsilu(acc[ai][0][m][1][j]) * acc[ai][1][m][1][j]; }
                *(v4u*)(O + (size_t)(row0 + ai * 128 + m * 16) * DFF + col0) = pack8(v0, v1);
            }
    }
};
__device__ __forceinline__ v4u dpp_swap1(const v4u x) {
    v4u r; r.x = (unsigned)__builtin_amdgcn_update_dpp(0, (int)x.x, 0xB1, 0xF, 0xF, true); r.y = (unsigned)__builtin_amdgcn_update_dpp(0, (int)x.y, 0xB1, 0xF, 0xF, true);
    r.z = (unsigned)__builtin_amdgcn_update_dpp(0, (int)x.z, 0xB1, 0xF, 0xF, true); r.w = (unsigned)__builtin_amdgcn_update_dpp(0, (int)x.w, 0xB1, 0xF, 0xF, true); return r;
}
struct EpiY {
    static constexpr bool PERM = true, PERM2 = true, MIDK = false;
    bf16* Y16; bf16* YS;
    __device__ __forceinline__ void operator()(const f32x4 (&acc)[2][2][4][2], const Unit& u, int wr, int wc, int fr, int fq) const {
        bf16* base = (u.slab < 0) ? Y16 + (size_t)(u.pm * 256) * DM : YS + (size_t)u.slab * TC * DM + (size_t)(u.pm * 256 - TX) * DM;
        const bool odd = fr & 1;
        bf16* pA = base + (size_t)(wr * 64 + (fr & ~1)) * DM + u.pn * 256 + wc * 64 + 8 * fq + (odd ? 32 : 0);
        bf16* pB = base + (size_t)(wr * 64 + (fr | 1)) * DM + u.pn * 256 + wc * 64 + 8 * fq + (odd ? 32 : 0);
#pragma unroll
        for (int ai = 0; ai < 2; ++ai)
#pragma unroll
            for (int m = 0; m < 4; ++m) {
                const v4u P0 = pack8(acc[ai][0][m][0], acc[ai][0][m][1]), P1 = pack8(acc[ai][1][m][0], acc[ai][1][m][1]);
                v4u X; X.x = odd ? P0.x : P1.x; X.y = odd ? P0.y : P1.y; X.z = odd ? P0.z : P1.z; X.w = odd ? P0.w : P1.w;
                const v4u Y = dpp_swap1(X);
                v4u A, B; A.x = odd ? Y.x : P0.x; A.y = odd ? Y.y : P0.y; A.z = odd ? Y.z : P0.z; A.w = odd ? Y.w : P0.w;
                B.x = odd ? P1.x : Y.x; B.y = odd ? P1.y : Y.y; B.z = odd ? P1.z : Y.z; B.w = odd ? P1.w : Y.w;
                const size_t ro = (size_t)(ai * 128 + m * 16) * DM;
                *(v4u*)(pA + ro) = A; *(v4u*)(pB + ro) = B;
            }
    }
};
constexpr int SEQT = CTXL + SEQ;
__device__ __forceinline__ size_t hm_row(int row) {
    int b, tau; if (row < TX) { b = row >> 11; tau = CTXL + (row & (SEQ - 1)); } else { const int rc = row - TX; b = rc >> 8; tau = rc & (CTXL - 1); }
    return ((size_t)b * NHEAD * SEQT + tau) * HDIM;
}
template <class T>
__device__ __forceinline__ void store_lines(T* pE, T* pO, int second, const v4u C0, const v4u C1, bool odd) {
    v4u X; X.x = odd ? C0.x : C1.x; X.y = odd ? C0.y : C1.y; X.z = odd ? C0.z : C1.z; X.w = odd ? C0.w : C1.w;
    const v4u Y = dpp_swap1(X);
    v4u A, B; A.x = odd ? Y.x : C0.x; A.y = odd ? Y.y : C0.y; A.z = odd ? Y.z : C0.z; A.w = odd ? Y.w : C0.w;
    B.x = odd ? C1.x : Y.x; B.y = odd ? C1.y : Y.y; B.z = odd ? C1.z : Y.z; B.w = odd ? C1.w : Y.w;
    *(v4u*)(pE + (odd ? second : 0)) = A; *(v4u*)(pO + (odd ? second : 0)) = B;
}
__device__ __forceinline__ size_t gate_blob(int pm, int pn, int wave, int am, int lane) { return ((((size_t)(pm * 8 + pn) * 8 + wave) * 8 + am) * 64 + lane) * 16; }
__device__ __forceinline__ unsigned q8(const f32x4 v) {
    return (unsigned)(v[0] * 255.f + 0.5f) | ((unsigned)(v[1] * 255.f + 0.5f) << 8) | ((unsigned)(v[2] * 255.f + 0.5f) << 16) | ((unsigned)(v[3] * 255.f + 0.5f) << 24);
}
struct EpiIN {
    static constexpr bool PERM = true, PERM2 = true, MIDK = false;
    bf16 *U, *V, *Q, *VI, *SG; unsigned char *SA, *SB; unsigned short *LF, *LB; const float* lbt; float* VST;
    static __device__ __forceinline__ void elem_body(const f32x4 (&acc)[2][2][4][2], bf16* O, int ld, int rE, int rO, bool odd, float a1n, float a3n, float m1, float m0) {
#pragma unroll
        for (int ai = 0; ai < 2; ++ai)
#pragma unroll
            for (int m = 0; m < 4; ++m) {
                f32x4 v[2][2];
#pragma unroll
                for (int bj = 0; bj < 2; ++bj)
#pragma unroll
                    for (int n = 0; n < 2; ++n)
#pragma unroll
                        for (int j = 0; j < 4; ++j) { const float t = acc[ai][bj][m][n][j]; const float e = __builtin_amdgcn_exp2f(t * (a3n * (t * t) + a1n)); v[bj][n][j] = (m1 * t + m0) * __builtin_amdgcn_rcpf(1.0f + e); }
                store_lines(O + (size_t)(rE + ai * 128 + m * 16) * ld, O + (size_t)(rO + ai * 128 + m * 16) * ld, 32, pack8(v[0][0], v[0][1]), pack8(v[1][0], v[1][1]), odd);
            }
    }
    __device__ __forceinline__ void operator()(const f32x4 (&acc)[2][2][4][2], const Unit& u, int wr, int wc, int fr, int fq) const {
        const int rowb = u.pm * 256 + wr * 64;
        const int rE = rowb + (fr & ~1), rO = rowb + (fr | 1); const bool odd = fr & 1;
        const int grp = u.pn >> 2;
        const int cg = (u.pn & 3) * 256 + wc * 64 + 8 * fq;
        if (grp >= 2 && grp <= 5) {
            const size_t hoff = (size_t)(cg >> 7) * SEQT * HDIM + (cg & 127);
            if (grp == 3 || grp == 4) {
                const int dir = grp - 3; unsigned short* LO = (dir ? LB : LF) + hoff;
                const f32x4 l00 = *(const f32x4*)(lbt + dir * 1024 + cg), l01 = *(const f32x4*)(lbt + dir * 1024 + cg + 4), l10 = *(const f32x4*)(lbt + dir * 1024 + cg + 32), l11 = *(const f32x4*)(lbt + dir * 1024 + cg + 36);
#pragma unroll
                for (int ai = 0; ai < 2; ++ai)
#pragma unroll
                    for (int m = 0; m < 4; ++m) {
                        v4u c[2];
#pragma unroll
                        for (int bj = 0; bj < 2; ++bj) {
                            float g[8];
#pragma unroll
                            for (int n = 0; n < 2; ++n)
#pragma unroll
                                for (int j = 0; j < 4; ++j) { const float lb = (bj ? (n ? l11 : l10) : (n ? l01 : l00))[j];
                                    const float z = fminf(fmaxf(acc[ai][bj][m][n][j], -80.f), 80.f), sg = __builtin_amdgcn_rcpf(1.0f + __expf(-z)); g[4 * n + j] = __logf(fmaxf(lb + (1.0f - lb) * sg, 1e-30f)); }
                            c[bj] = (v4u){pkh(g[0], g[1]), pkh(g[2], g[3]), pkh(g[4], g[5]), pkh(g[6], g[7])};
                        }
                        store_lines(LO + hm_row(rE + ai * 128 + m * 16), LO + hm_row(rO + ai * 128 + m * 16), 32, c[0], c[1], odd);
                    }
            } else {
                bf16* O = ((grp == 2) ? Q : VI) + hoff;
#pragma unroll
                for (int ai = 0; ai < 2; ++ai)
#pragma unroll
                    for (int m = 0; m < 4; ++m)
                        store_lines(O + hm_row(rE + ai * 128 + m * 16), O + hm_row(rO + ai * 128 + m * 16), 32, pack8(acc[ai][0][m][0], acc[ai][0][m][1]), pack8(acc[ai][1][m][0], acc[ai][1][m][1]), odd);
            }
            return;
        }
        if (grp == 1) {
            bf16* O = V + cg;
#pragma unroll
            for (int ai = 0; ai < 2; ++ai)
#pragma unroll
                for (int m = 0; m < 4; ++m) {
                    float sm = 0.f, sq = 0.f; f32x4 v[2][2];
#pragma unroll
                    for (int bj = 0; bj < 2; ++bj)
#pragma unroll
                        for (int n = 0; n < 2; ++n)
#pragma unroll
                            for (int j = 0; j < 4; ++j) { const float t = fgelu_tanh(acc[ai][bj][m][n][j]); v[bj][n][j] = t; sm += t; sq += t * t; }
                    store_lines(O + (size_t)(rE + ai * 128 + m * 16) * 1024, O + (size_t)(rO + ai * 128 + m * 16) * 1024, 32, pack8(v[0][0], v[0][1]), pack8(v[1][0], v[1][1]), odd);
                    sm += __shfl_xor(sm, 16); sm += __shfl_xor(sm, 32); sq += __shfl_xor(sq, 16); sq += __shfl_xor(sq, 32);
                    if (fq == 0) { float* p = VST + ((size_t)(rowb + fr + ai * 128 + m * 16) * 16 + (u.pn & 3) * 4 + wc) * 2; p[0] = sm; p[1] = sq; }
                }
            return;
        }
        if (grp >= 7) {
            unsigned char* T = (grp <= 8 ? SA : SB) + gate_blob(u.pm, u.pn - (grp <= 8 ? 28 : 36), wr * 4 + wc, 0, fr + 16 * fq);
#pragma unroll
            for (int ai = 0; ai < 2; ++ai)
#pragma unroll
                for (int m = 0; m < 4; ++m) {
                    v4u w;
#pragma unroll
                    for (int bj = 0; bj < 2; ++bj)
#pragma unroll
                        for (int n = 0; n < 2; ++n) { f32x4 sg;
#pragma unroll
                            for (int j = 0; j < 4; ++j) sg[j] = fsigmoid(acc[ai][bj][m][n][j]);
                            const unsigned qq = q8(sg); if (bj == 0 && n == 0) w.x = qq; else if (bj == 0) w.y = qq; else if (n == 0) w.z = qq; else w.w = qq; }
                    *(v4u*)(T + (size_t)(ai * 4 + m) * 1024) = w;
                }
            return;
        }
        bf16* O; int ld, fn;
        if (grp == 0) { O = U + cg; ld = 1024; fn = 1; }
        else { O = SG + cg; ld = 1024; fn = 2; }
        const float L2E = 1.4426950408889634f;
        elem_body(acc, O, ld, rE, rO, odd, fn == 1 ? -L2E * 1.5957691216057308f : -L2E, fn == 1 ? -L2E * 1.5957691216057308f * 0.044715f : 0.f, fn == 3 ? 0.f : 1.f, fn == 3 ? 1.f : 0.f);
    }
};
struct EpiMerge {
    static constexpr bool PERM = true, PERM2 = true, MIDK = true;
    const unsigned char* SA; const unsigned char* SB; bf16* MB;
    __device__ __forceinline__ void mid(f32x4 (&acc)[2][2][4][2], const Unit& u, int wr, int wc, int fr, int fq) const {
        int lane = fr + 16 * fq; asm volatile("" : "+v"(lane));
        const size_t off = gate_blob(u.pm, u.pn, wr * 4 + wc, 0, lane);
#pragma unroll
        for (int ai = 0; ai < 2; ++ai)
#pragma unroll
            for (int m = 0; m < 4; ++m) {
                const v4u a = *(const v4u*)(SA + off + (size_t)(ai * 4 + m) * 1024), b = *(const v4u*)(SB + off + (size_t)(ai * 4 + m) * 1024);
                const unsigned aw[4] = {a.x, a.y, a.z, a.w}, bw[4] = {b.x, b.y, b.z, b.w};
#pragma unroll
                for (int d = 0; d < 4; ++d)
#pragma unroll
                    for (int j = 0; j < 4; ++j) acc[ai][d >> 1][m][d & 1][j] *= (float)((aw[d] >> (8 * j)) & 0xffu) * __builtin_amdgcn_rcpf(fmaxf((float)((bw[d] >> (8 * j)) & 0xffu), 0.5f));
                if ((m & 3) == 3) asm volatile("" ::: "memory");
            }
    }
    __device__ __forceinline__ void operator()(const f32x4 (&acc)[2][2][4][2], const Unit& u, int wr, int wc, int fr, int fq) const {
        int lane = fr + 16 * fq; asm volatile("" : "+v"(lane));
        const size_t off = gate_blob(u.pm, u.pn, wr * 4 + wc, 0, lane);
        const bool odd = lane & 1;
        bf16* O = MB + (size_t)(u.pm * 256 + wr * 64) * 2048 + u.pn * 256 + wc * 64 + 8 * (lane >> 4);
        const int fE = (lane & 15) & ~1, fO = (lane & 15) | 1;
#pragma unroll
        for (int ai = 0; ai < 2; ++ai)
#pragma unroll
            for (int m = 0; m < 4; ++m) {
                const v4u b = *(const v4u*)(SB + off + (size_t)(ai * 4 + m) * 1024);
                const unsigned bw[4] = {b.x, b.y, b.z, b.w};
                f32x4 v[2][2];
#pragma unroll
                for (int d = 0; d < 4; ++d)
#pragma unroll
                    for (int j = 0; j < 4; ++j) v[d >> 1][d & 1][j] = acc[ai][d >> 1][m][d & 1][j] * (fmaxf((float)((bw[d] >> (8 * j)) & 0xffu), 0.5f) * (1.0f / 255.0f));
                store_lines(O + (size_t)(fE + ai * 128 + m * 16) * 2048, O + (size_t)(fO + ai * 128 + m * 16) * 2048, 32, pack8(v[0][0], v[0][1]), pack8(v[1][0], v[1][1]), odd);
            }
    }
};

struct Args { const float* in[20]; float* out; unsigned char* ws; int ph_lo, ph_hi; };

struct Frame {
    LAS unsigned char* lds;
    int wave, G, bx;
};
__device__ __forceinline__ int opaque_tid() { int t = threadIdx.x; asm volatile("" : "+v"(t)); return t; }
#define FTID (tid__)
#define FLANE (tid__ & 63)
#define TID_DECL() const int tid__ = opaque_tid()
__device__ __forceinline__ size_t opaque_zero() { size_t z = 0; asm volatile("" : "+s"(z)); return z; }
#define opaque_ptr(p) ((p) + opaque_zero())
__device__ __forceinline__ int opaque_int(int i) { asm volatile("" : "+s"(i)); return i; }
#define INP(i) (args.in[opaque_int(i)])

constexpr int I_GU = (DM / 64) * (2 * DFF / 32), I_D = (DFF / 64) * (DM / 32), I_IN = (DM / 64) * (INC / 32), I_UP = (DA / 64) * (DM / 32), I_OUT = (DM / 64) * (DM / 32);
constexpr int PER_LAYER = 2 * I_GU + 2 * I_D + I_IN + 2 * I_UP + I_OUT;
constexpr int IT_EARLY = I_GU + I_D + I_IN;
constexpr int SPARE_G = 227;
struct TrItem { const float* src; bf16* dst; int ldsrc, ldd; };
__device__ __forceinline__ TrItem tr_resolve(const Args& args, unsigned char* ws, int it) {
    const int l = it / PER_LAYER; int r = it % PER_LAYER;
    unsigned char* wl = ws + WS_W + (size_t)l * W_LAYER;
    const float* W; bf16* dst; int K, N, ldd, koff = 0; bool gu = false;
    if (r < I_GU) { W = INP(7) + (size_t)l * DM * 2 * DFF; K = DM; N = 2 * DFF; dst = (bf16*)(wl + WO_GU1); ldd = DM; gu = true; }
    else if ((r -= I_GU) < I_D) { W = INP(8) + (size_t)l * DFF * DM; K = DFF; N = DM; dst = (bf16*)(wl + WO_D1); ldd = DFF; }
    else if ((r -= I_D) < I_IN) { W = INP(11) + (size_t)l * DM * INC; K = DM; N = INC; dst = (bf16*)(wl + WO_IN); ldd = DM; }
    else if ((r -= I_IN) < I_UP) { W = INP(17) + (size_t)l * DA * DM; K = DA; N = DM; dst = (bf16*)(wl + WO_UP); ldd = 2 * DA; }
    else if ((r -= I_UP) < I_UP) { W = INP(18) + (size_t)l * DBB * DM; K = DBB; N = DM; dst = (bf16*)(wl + WO_UP); ldd = 2 * DA; koff = DA; }
    else if ((r -= I_UP) < I_OUT) { W = INP(19) + (size_t)l * DM * DM; K = DM; N = DM; dst = (bf16*)(wl + WO_OUT); ldd = DM; }
    else if ((r -= I_OUT) < I_GU) { W = INP(9) + (size_t)l * DM * 2 * DFF; K = DM; N = 2 * DFF; dst = (bf16*)(wl + WO_GU2); ldd = DM; gu = true; }
    else { r -= I_GU; W = INP(10) + (size_t)l * DFF * DM; K = DFF; N = DM; dst = (bf16*)(wl + WO_D2); ldd = DFF; }
    (void)K;
    const int nblk = N / 32, kb = r / nblk, nb = r % nblk;
    int sc0 = 32 * nb;
    if (gu) { const int tile = nb >> 3, within = 32 * (nb & 7); sc0 = (within < 128) ? (128 * tile + within) : (DFF + 128 * tile + within - 128); }
    TrItem t; t.src = W + (size_t)(64 * kb) * N + sc0; t.ldsrc = N; t.dst = dst + (size_t)(32 * nb) * ldd + koff + 64 * kb; t.ldd = ldd; return t;
}
__device__ __forceinline__ void tr_load(const TrItem& t, int lane, f32x4 (&v)[8]) {
    const int rr = lane >> 3, c4 = (lane & 7) * 4;
#pragma unroll
    for (int i = 0; i < 8; ++i) v[i] = __builtin_nontemporal_load((const f32x4*)(t.src + (size_t)(8 * i + rr) * t.ldsrc + c4));
}
__device__ __forceinline__ void tr_emit(const TrItem& t, int lane, const f32x4 (&v)[8], LAS float* scr) {
    const int rr = lane >> 3, c4 = (lane & 7) * 4;
#pragma unroll
    for (int i = 0; i < 8; ++i) { LAS float* s = scr + (8 * i + rr) * 33 + c4; s[0] = v[i][0]; s[1] = v[i][1]; s[2] = v[i][2]; s[3] = v[i][3]; }
    LDS_WAIT(); asm volatile("" ::: "memory");
    const int c = lane & 7;
#pragma unroll
    for (int j = 0; j < 4; ++j) { const int n = (lane >> 3) + 8 * j; const LAS float* s = scr + (8 * c) * 33 + n;
        v4u o; o.x = pk2(s[0 * 33], s[1 * 33]); o.y = pk2(s[2 * 33], s[3 * 33]); o.z = pk2(s[4 * 33], s[5 * 33]); o.w = pk2(s[6 * 33], s[7 * 33]);
        *(v4u*)(t.dst + (size_t)n * t.ldd + 8 * c) = o; }
    LDS_WAIT(); asm volatile("" ::: "memory");
}
__device__ __forceinline__ void convert_items(Frame& F, const Args& args, int it_lo, int it_hi, int iw, int nw) {
    TID_DECL();
    unsigned char* ws = opaque_ptr(args.ws);
    LAS float* scr = (LAS float*)(F.lds + RING_OFF + F.wave * 16384);
    int it = it_lo + iw;
    if (it < it_hi) {
        TrItem cur = tr_resolve(args, ws, it); f32x4 v[8]; tr_load(cur, FLANE, v);
        for (;;) {
            const int itn = it + nw; const bool more = itn < it_hi;
            TrItem nxt = cur; f32x4 vn[8];
            if (more) { nxt = tr_resolve(args, ws, itn); tr_load(nxt, FLANE, vn); }
            tr_emit(cur, FLANE, v, scr);
            if (!more) break;
#pragma unroll
            for (int i = 0; i < 8; ++i) v[i] = vn[i];
            cur = nxt; it = itn;
        }
    }
    __syncthreads();
}
__device__ __forceinline__ void mod_items(Frame& F, const Args& args, int iwg, int nwg) {
    TID_DECL();
    unsigned char* ws = opaque_ptr(args.ws);
    float* mod = (float*)(ws + WS_MOD);
    LAS float* sc = (LAS float*)(F.lds + RING_OFF);
    LAS float* red = (LAS float*)(F.lds + RING_OFF + 65536);
    for (int t = FTID; t < NGRP * DM; t += NWAVES * 64) { const int g = t >> 11, kk = t & (DM - 1);
        const float cv = (g < 4) ? INP(1)[g * DM + kk] : INP(3)[kk];
        sc[t] = cv / (1.0f + __expf(-cv)); }
    __syncthreads();
    constexpr int NB = NMOD * DM / 32;
    const int cg = FLANE & 7, kr = FLANE >> 3;
    for (int it = iwg; it < DEPTH * NB; it += nwg) {
        const int l = it / NB, nb = it % NB;
        const float* W = INP(4) + (size_t)l * DM * NMOD * DM + (size_t)(F.wave * 256 + kr) * (NMOD * DM) + nb * 32 + 4 * cg;
        f32x4 a[NGRP];
#pragma unroll
        for (int g = 0; g < NGRP; ++g) a[g] = (f32x4){0.f, 0.f, 0.f, 0.f};
#pragma unroll 8
        for (int i = 0; i < 32; ++i) { const f32x4 w = __builtin_nontemporal_load((const f32x4*)(W + (size_t)(8 * i) * (NMOD * DM)));
#pragma unroll
            for (int g = 0; g < NGRP; ++g) { const float sv = sc[g * DM + F.wave * 256 + 8 * i + kr]; a[g] += w * sv; } }
#pragma unroll
        for (int g = 0; g < NGRP; ++g)
#pragma unroll
            for (int c = 0; c < 4; ++c) { float v = a[g][c]; v += __shfl_xor(v, 8); v += __shfl_xor(v, 16); v += __shfl_xor(v, 32); a[g][c] = v; }
        if (kr == 0) {
#pragma unroll
            for (int g = 0; g < NGRP; ++g)
#pragma unroll
                for (int c = 0; c < 4; ++c) red[(F.wave * 8 + cg) * 20 + g * 4 + c] = a[g][c]; }
        __syncthreads();
        if (FTID < 160) { const int cgi = FTID / 20, v = FTID % 20, g = v >> 2, c = v & 3; float sum = 0.f;
#pragma unroll
            for (int w = 0; w < NWAVES; ++w) sum += red[(w * 8 + cgi) * 20 + v];
            const int n = nb * 32 + 4 * cgi + c;
            mod[(size_t)(l * NGRP + g) * NMOD * DM + n] = sum + INP(5)[(size_t)l * NMOD * DM + n]; }
        __syncthreads();
    }
}
__device__ __forceinline__ void p0_prologue(Frame& F, const Args& args) {
    TID_DECL();
    unsigned char* ws = opaque_ptr(args.ws);
    convert_items(F, args, 0, I_GU, F.bx * NWAVES + F.wave, F.G * NWAVES);
    mod_items(F, args, F.bx, F.G);
    if (F.bx == 0) {
        float* lbt = (float*)(ws + WS_LBT);
        for (int idx = FTID; idx < 2 * DBB; idx += NWAVES * 64) {
            float z[DEPTH], mx = -3.0e38f, den = 0.f;
#pragma unroll
            for (int l = 0; l < DEPTH; ++l) { z[l] = INP(15)[l * 2 * DBB + idx]; mx = fmaxf(mx, z[l]); }
#pragma unroll
            for (int l = 0; l < DEPTH; ++l) { z[l] = __expf(z[l] - mx); den += z[l]; }
            float cum = 0.f; const float s0 = z[0] / den;
#pragma unroll
            for (int l = 0; l < DEPTH; ++l) { cum += z[l] / den; lbt[l * 2 * DBB + idx] = (l == 0) ? 0.f : (cum - s0); }
        }
    }
}
constexpr int BG_E0 = 34764, BG_E1 = 64264, BG_E2 = 86264, BG_D2_L1 = 2 * PER_LAYER - I_D;
static_assert(BG_E0 >= IT_EARLY && BG_E1 >= PER_LAYER + I_GU && BG_E2 >= PER_LAYER + IT_EARLY + 2 * I_UP + I_OUT && BG_E2 <= BG_D2_L1, "each slot ends after what the next phases need");
constexpr int BG_S2_END = BG_E2;
__device__ __forceinline__ void background_work(Frame& F, const Args& args, int slot) {
    const int iwg = F.bx - SPARE_G, nwg = F.G - SPARE_G, iw = iwg * NWAVES + F.wave, nw = nwg * NWAVES;
    if (slot == 0) convert_items(F, args, I_GU, BG_E0, iw, nw);
    else if (slot == 1) convert_items(F, args, BG_E0, BG_E1, iw, nw);
    else convert_items(F, args, BG_E1, BG_E2, iw, nw);
}
__device__ __forceinline__ void tail_work(Frame& F, const Args& args, int U, int lo, int hi) {
    const int r = U % F.G; if (r == 0 || F.bx < r) return;
    convert_items(F, args, lo, hi, (F.bx - r) * NWAVES + F.wave, (F.G - r) * NWAVES);
}

__device__ __forceinline__ int row_grp(int row) { return row < TX ? (row >> 11) : 4; }
template <int MODE, bool XIN = false>
__device__ __forceinline__ void thin_phase(Frame& F, const Args& args, int nrows, int nslab, const float* gpost, const float* mod_r, int gate_i, float w,
                                           const float* gpre, const float* mod_m, int shift_i, int scale_i) {
    TID_DECL();
    unsigned char* ws = opaque_ptr(args.ws);
    bf16* X = (bf16*)(ws + WS_X); bf16* H = (bf16*)(ws + WS_H);
    const int rpw = nrows / F.G, g0 = row_grp(32 * F.bx), g1 = 4;
    LAS float* VA = (LAS float*)(F.lds + RING_OFF);
    LAS float* VB = VA + 2 * DM;
    LAS float* VC = VB + 2 * DM;
    for (int t = FTID; t < 2 * DM; t += NWAVES * 64) { const int gi = t >> 11, n = t & (DM - 1), g = gi ? g1 : g0;
        if (MODE != 0) VA[t] = w * mod_r[(size_t)(g * NMOD + gate_i) * DM + n] * gpost[n];
        if (MODE != 2) { VB[t] = gpre[n] * (1.0f + mod_m[(size_t)(g * NMOD + scale_i) * DM + n]); VC[t] = mod_m[(size_t)(g * NMOD + shift_i) * DM + n]; } }
    __syncthreads();
    for (int rr = F.wave; rr < rpw; rr += NWAVES) {
        const int row = rr < 32 ? 32 * F.bx + rr : TX + 4 * F.bx + (rr - 32), gi = rr < 32 ? 0 : 1;
        const int e0 = 8 * FLANE;
        f32x4 x[4][2];
        if (MODE == 0 || XIN) {
            const float* src = (row < TX ? INP(0) + (size_t)row * DM : INP(2) + (size_t)(row - TX) * DM) + e0;
#pragma unroll
            for (int j = 0; j < 4; ++j) { x[j][0] = *(const f32x4*)(src + 512 * j); x[j][1] = *(const f32x4*)(src + 512 * j + 4); }
        } else {
#pragma unroll
            for (int j = 0; j < 4; ++j) { const v4u w4 = *(const v4u*)(X + (size_t)row * DM + e0 + 512 * j);
                x[j][0] = (f32x4){bflo(w4.x), bfhi(w4.x), bflo(w4.y), bfhi(w4.y)}; x[j][1] = (f32x4){bflo(w4.z), bfhi(w4.z), bflo(w4.w), bfhi(w4.w)}; }
        }
        if (MODE != 0) {
            f32x4 y[4][2]; float s = 0.f;
            if (row < TX) {
                const bf16* Y16 = (const bf16*)(ws + WS_Y) + (size_t)row * DM + e0;
#pragma unroll
                for (int j = 0; j < 4; ++j) { const v4u w4 = *(const v4u*)(Y16 + 512 * j);
                    y[j][0] = (f32x4){bflo(w4.x), bfhi(w4.x), bflo(w4.y), bfhi(w4.y)}; y[j][1] = (f32x4){bflo(w4.z), bfhi(w4.z), bflo(w4.w), bfhi(w4.w)}; }
            } else {
                const bf16* YS = (const bf16*)(ws + WS_YS) + (size_t)(row - TX) * DM + e0;
#pragma unroll
                for (int j = 0; j < 4; ++j) { const v4u w4 = *(const v4u*)(YS + 512 * j);
                    y[j][0] = (f32x4){bflo(w4.x), bfhi(w4.x), bflo(w4.y), bfhi(w4.y)}; y[j][1] = (f32x4){bflo(w4.z), bfhi(w4.z), bflo(w4.w), bfhi(w4.w)}; }
#pragma unroll 1
                for (int sl = 1; sl < nslab; ++sl)
#pragma unroll
                    for (int j = 0; j < 4; ++j) { const v4u w4 = *(const v4u*)(YS + (size_t)sl * TC * DM + 512 * j);
                        y[j][0] += (f32x4){bflo(w4.x), bfhi(w4.x), bflo(w4.y), bfhi(w4.y)}; y[j][1] += (f32x4){bflo(w4.z), bfhi(w4.z), bflo(w4.w), bfhi(w4.w)}; }
            }
#pragma unroll
            for (int j = 0; j < 4; ++j)
#pragma unroll
                for (int q = 0; q < 2; ++q) s += (y[j][q][0] * y[j][q][0] + y[j][q][1] * y[j][q][1]) + (y[j][q][2] * y[j][q][2] + y[j][q][3] * y[j][q][3]);
            const float r = 1.0f / sqrtf(wave_sum(s) * (1.0f / DM) + EPS);
#pragma unroll
            for (int j = 0; j < 4; ++j)
#pragma unroll
                for (int q = 0; q < 2; ++q) { const f32x4 a = *(const LAS f32x4*)(VA + gi * DM + e0 + 512 * j + 4 * q); x[j][q] += a * y[j][q] * r; }
        }
        if (MODE == 2) {
#pragma unroll
            for (int j = 0; j < 4; ++j) { *(f32x4*)(args.out + (size_t)row * DM + e0 + 512 * j) = x[j][0]; *(f32x4*)(args.out + (size_t)row * DM + e0 + 512 * j + 4) = x[j][1]; }
        } else {
            float s = 0.f;
#pragma unroll
            for (int j = 0; j < 4; ++j) {
                if (MODE != 0) *(v4u*)(X + (size_t)row * DM + e0 + 512 * j) = pack8(x[j][0], x[j][1]);
#pragma unroll
                for (int q = 0; q < 2; ++q) s += (x[j][q][0] * x[j][q][0] + x[j][q][1] * x[j][q][1]) + (x[j][q][2] * x[j][q][2] + x[j][q][3] * x[j][q][3]); }
            const float r = 1.0f / sqrtf(wave_sum(s) * (1.0f / DM) + EPS);
#pragma unroll
            for (int j = 0; j < 4; ++j) { f32x4 h[2];
#pragma unroll
                for (int q = 0; q < 2; ++q) { const f32x4 bb = *(const LAS f32x4*)(VB + gi * DM + e0 + 512 * j + 4 * q), cc = *(const LAS f32x4*)(VC + gi * DM + e0 + 512 * j + 4 * q); h[q] = x[j][q] * r * bb + cc; }
                *(v4u*)(H + (size_t)row * DM + e0 + 512 * j) = pack8(h[0], h[1]); }
        }
    }
    __syncthreads();
}

__device__ __forceinline__ void readout_phase(Frame& F, const Args& args, int nrows, const float* gain) {
    TID_DECL();
    unsigned char* ws = opaque_ptr(args.ws);
    const bf16* OF = (const bf16*)(ws + WS_OF); const bf16* OB = (const bf16*)(ws + WS_OB); const bf16* SG = (const bf16*)(ws + WS_SG); bf16* YAB = (bf16*)(ws + WS_YAB);
    const int gw = F.bx * NWAVES + F.wave, NGW = F.G * NWAVES;
    for (int row = gw; row < nrows; row += NGW) {
        const size_t off = (size_t)row * DBB + 16 * FLANE;
        const size_t hoff = hm_row(row) + (size_t)(FLANE >> 3) * SEQT * HDIM + 16 * (FLANE & 7);
        f32x4 o[4]; float s = 0.f;
#pragma unroll
        for (int j = 0; j < 4; ++j) { const v2u a2 = *(const v2u*)(OF + hoff + 4 * j), b2 = *(const v2u*)(OB + hoff + 4 * j);
            o[j] = (f32x4){bflo(a2.x) + bflo(b2.x), bfhi(a2.x) + bfhi(b2.x), bflo(a2.y) + bflo(b2.y), bfhi(a2.y) + bfhi(b2.y)}; s += (o[j][0] * o[j][0] + o[j][1] * o[j][1]) + (o[j][2] * o[j][2] + o[j][3] * o[j][3]); }
        s += __shfl_xor(s, 1); s += __shfl_xor(s, 2); s += __shfl_xor(s, 4);
        const float r = 1.0f / sqrtf(s * (1.0f / HDIM) + EPS);
        const v4u g0 = *(const v4u*)(SG + off), g1 = *(const v4u*)(SG + off + 8);
        const unsigned gw_[8] = {g0.x, g0.y, g0.z, g0.w, g1.x, g1.y, g1.z, g1.w};
        unsigned ow[8];
#pragma unroll
        for (int j = 0; j < 4; ++j) { const f32x4 gn = *(const f32x4*)(gain + 16 * FLANE + 4 * j);
            const float a0 = o[j][0] * r * gn[0] * bflo(gw_[2 * j]), a1 = o[j][1] * r * gn[1] * bfhi(gw_[2 * j]), a2 = o[j][2] * r * gn[2] * bflo(gw_[2 * j + 1]), a3 = o[j][3] * r * gn[3] * bfhi(gw_[2 * j + 1]);
            ow[2 * j] = pk2(a0, a1); ow[2 * j + 1] = pk2(a2, a3); }
        bf16* dst = YAB + (size_t)row * (2 * DA) + DA + 16 * FLANE;
        *(v4u*)dst = (v4u){ow[0], ow[1], ow[2], ow[3]}; *(v4u*)(dst + 8) = (v4u){ow[4], ow[5], ow[6], ow[7]};
    }
}

constexpr int GM_VNT = 0, GM_STAT = 128 * 272;
__device__ __forceinline__ void gmlp_unit(Frame& F, const Args& args, int row0, int g, const float* cng, const float* wsp, const float* bsp) {
    TID_DECL();
    unsigned char* ws = opaque_ptr(args.ws);
    const bf16* U = (const bf16*)(ws + WS_U); const bf16* V = (const bf16*)(ws + WS_V); bf16* YAB = (bf16*)(ws + WS_YAB);
    LAS unsigned char* vnT = F.lds + RING_OFF + GM_VNT; LAS float* stat = (LAS float*)(F.lds + RING_OFF + GM_STAT);
    if (FTID < 128) {
        const f32x4* p = (const f32x4*)((const float*)(ws + WS_VST) + (size_t)(row0 + FTID) * 32);
        float sm = 0.f, sq = 0.f;
#pragma unroll
        for (int k = 0; k < 8; ++k) { const f32x4 t = p[k]; sm += t[0] + t[2]; sq += t[1] + t[3]; }
        const float mean = sm * (1.0f / DA), var = fmaxf(sq * (1.0f / DA) - mean * mean, 0.f);
        stat[2 * FTID] = mean; stat[2 * FTID + 1] = 1.0f / sqrtf(var + EPS);
    }
    __syncthreads();
    for (int it = FTID; it < 128 * 16; it += NWAVES * 64) {
        const int s = it & 127, dd = it >> 7;
        const v4u a = *(const v4u*)(V + (size_t)(row0 + s) * DA + g * 128 + 8 * dd);
        const float mean = stat[2 * s], rstd = stat[2 * s + 1];
        const f32x4 g0 = *(const f32x4*)(cng + g * 128 + 8 * dd), g1 = *(const f32x4*)(cng + g * 128 + 8 * dd + 4);
        const unsigned wv[4] = {a.x, a.y, a.z, a.w};
#pragma unroll
        for (int j = 0; j < 4; ++j) {
            const float lo = (bflo(wv[j]) - mean) * rstd * (j < 2 ? g0[2 * j] : g1[2 * j - 4]), hi = (bfhi(wv[j]) - mean) * rstd * (j < 2 ? g0[2 * j + 1] : g1[2 * j - 3]);
            const unsigned p = pk2(lo, hi);
            *(LAS unsigned short*)(vnT + (8 * dd + 2 * j) * 272 + 2 * s) = (unsigned short)(p & 0xffffu);
            *(LAS unsigned short*)(vnT + (8 * dd + 2 * j + 1) * 272 + 2 * s) = (unsigned short)(p >> 16);
        }
    }
    __syncthreads();
    const int i = FLANE & 15, gq = FLANE >> 4;
    f32x4 acc[8];
#pragma unroll
    for (int md = 0; md < 8; ++md) acc[md] = (f32x4){0.f, 0.f, 0.f, 0.f};
    const float* wrow = wsp + ((size_t)g * 128 + 16 * F.wave + i) * 128;
#pragma unroll
    for (int kk = 0; kk < 4; ++kk) {
        const f32x4 w0 = *(const f32x4*)(wrow + 32 * kk + 8 * gq), w1 = *(const f32x4*)(wrow + 32 * kk + 8 * gq + 4);
        const v4u wb = pack8(w0, w1); bf16x8 bfrag; __builtin_memcpy(&bfrag, &wb, 16);
#pragma unroll
        for (int md = 0; md < 8; ++md) {
            const bf16x8 afrag = *(const LAS bf16x8*)(vnT + (16 * md + i) * 272 + (32 * kk + 8 * gq) * 2);
            acc[md] = __builtin_amdgcn_mfma_f32_16x16x32_bf16(afrag, bfrag, acc[md], 0, 0, 0);
        }
    }
    const int t = 16 * F.wave + i; const float bias = bsp[g * 128 + t];
#pragma unroll
    for (int md = 0; md < 8; ++md) {
        const size_t col = (size_t)g * 128 + 16 * md + 4 * gq;
        const v2u uu = *(const v2u*)(U + (size_t)(row0 + t) * DA + col);
        v2u o; o.x = pk2(bflo(uu.x) * (acc[md][0] + bias), bfhi(uu.x) * (acc[md][1] + bias)); o.y = pk2(bflo(uu.y) * (acc[md][2] + bias), bfhi(uu.y) * (acc[md][3] + bias));
        *(v2u*)(YAB + (size_t)(row0 + t) * (2 * DA) + col) = o;
    }
    __syncthreads();
}

constexpr int SC_QS = 0, SC_KS = 17408, SC_KET = 34816, SC_VT = 53248, SC_DD = 71680, SC_AT = 73728;
constexpr int SEGLEN = (CTXL + SEQ) / 4, SEG_GROUPS = SEGLEN / 64;
__device__ __forceinline__ int scan_tau(int dir, int sigma) { return dir ? (sigma < CTXL ? CTXL - 1 - sigma : SEQT + CTXL - 1 - sigma) : sigma; }
struct ScanRegs { f32x4 lf[4]; v2u qv[4], vv[4]; };
template <bool FULL>
__device__ __forceinline__ void scan_load(ScanRegs& R, const unsigned short* LG, const bf16* Q, const bf16* VI, int dir, int sigma0, int c0) {
#pragma unroll
    for (int p = 0; p < 4; ++p) { const size_t ro = (size_t)scan_tau(dir, sigma0 + p) * HDIM + c0;
        { const v2u w2 = *(const v2u*)(LG + ro); R.lf[p] = (f32x4){hlo(w2.x), hhi(w2.x), hlo(w2.y), hhi(w2.y)}; } R.vv[p] = *(const v2u*)(VI + ro); if (FULL) R.qv[p] = *(const v2u*)(Q + ro); }
}
template <bool FULL>
__device__ __forceinline__ void scan_stage1(const ScanRegs& R, LAS unsigned char* L, int sb1, int c0, int qi, int lane, f32x4& atot) {
    f32x4 a[4]; a[0] = R.lf[0]; a[1] = a[0] + R.lf[1]; a[2] = a[1] + R.lf[2]; a[3] = a[2] + R.lf[3];
    f32x4 inc = a[3], a15;
#pragma unroll
    for (int c = 0; c < 4; ++c) { float v = inc[c]; float t = __shfl_up(v, 16); if (qi >= 1) v += t; t = __shfl_up(v, 32); if (qi >= 2) v += t; inc[c] = v; a15[c] = __shfl(v, 48 + (lane & 15)); }
    const f32x4 excl = inc - a[3];
    float kef[4][4];
#pragma unroll
    for (int p = 0; p < 4; ++p) {
        const f32x4 ap = a[p] + excl;
        f32x4 kf4;
#pragma unroll
        for (int c = 0; c < 4; ++c) { kf4[c] = 1.0f - __expf(R.lf[p][c]); kef[p][c] = kf4[c] * __expf(a15[c] - ap[c]); }
        if (FULL) {
            const f32x4 qf4 = (f32x4){bflo(R.qv[p].x), bfhi(R.qv[p].x), bflo(R.qv[p].y), bfhi(R.qv[p].y)};
            f32x4 qs, ks;
#pragma unroll
            for (int c = 0; c < 4; ++c) { qs[c] = qf4[c] * __expf(ap[c]); ks[c] = kf4[c] * __expf(fminf(-ap[c], 80.f)); }
            const int ro = (sb1 * 16 + 4 * qi + p) * 272 + 2 * c0;
            *(LAS v2u*)(L + SC_QS + ro) = (v2u){pk2(qs[0], qs[1]), pk2(qs[2], qs[3])};
            *(LAS v2u*)(L + SC_KS + ro) = (v2u){pk2(ks[0], ks[1]), pk2(ks[2], ks[3])};
        }
    }
    const int to = sb1 * 4608 + qi * 1152 + c0 * 8;
    *(LAS v4u*)(L + SC_KET + to) = (v4u){pk2(kef[0][0], kef[1][0]), pk2(kef[2][0], kef[3][0]), pk2(kef[0][1], kef[1][1]), pk2(kef[2][1], kef[3][1])};
    *(LAS v4u*)(L + SC_KET + to + 16) = (v4u){pk2(kef[0][2], kef[1][2]), pk2(kef[2][2], kef[3][2]), pk2(kef[0][3], kef[1][3]), pk2(kef[2][3], kef[3][3])};
    const unsigned v00 = R.vv[0].x, v01 = R.vv[0].y, v10 = R.vv[1].x, v11 = R.vv[1].y, v20 = R.vv[2].x, v21 = R.vv[2].y, v30 = R.vv[3].x, v31 = R.vv[3].y;
    *(LAS v4u*)(L + SC_VT + to) = (v4u){(v00 & 0xffffu) | (v10 << 16), (v20 & 0xffffu) | (v30 << 16), (v00 >> 16) | (v10 & 0xffff0000u), (v20 >> 16) | (v30 & 0xffff0000u)};
    *(LAS v4u*)(L + SC_VT + to + 16) = (v4u){(v01 & 0xffffu) | (v11 << 16), (v21 & 0xffffu) | (v31 << 16), (v01 >> 16) | (v11 & 0xffff0000u), (v21 >> 16) | (v31 & 0xffff0000u)};
    if (qi == 3) *(LAS f32x4*)(L + SC_DD + (sb1 * 128 + c0) * 4) = (f32x4){__expf(a15[0]), __expf(a15[1]), __expf(a15[2]), __expf(a15[3])};
    atot += a15;
}
template <bool FULL>
__device__ __forceinline__ void scan_stage2(f32x4 (&S)[8], LAS unsigned char* L, bf16* O, int dir, int sigma0, bool do_out, int i, int gq, int eb) {
#pragma unroll 1
    for (int sb = 0; sb < 4; ++sb) {
        const v2u vraw = *(const LAS v2u*)(L + SC_VT + sb * 4608 + gq * 1152 + (eb + i) * 8);
        const v4u vw = (v4u){vraw.x, vraw.y, 0u, 0u}; bf16x8 vf; __builtin_memcpy(&vf, &vw, 16);
        if (FULL && do_out) {
            f32x4 P = (f32x4){0.f, 0.f, 0.f, 0.f};
#pragma unroll
            for (int kk = 0; kk < 4; ++kk) {
                const bf16x8 af = *(const LAS bf16x8*)(L + SC_KS + (sb * 16 + i) * 272 + (32 * kk + 8 * gq) * 2);
                const bf16x8 bfr = *(const LAS bf16x8*)(L + SC_QS + (sb * 16 + i) * 272 + (32 * kk + 8 * gq) * 2);
                P = __builtin_amdgcn_mfma_f32_16x16x32_bf16(af, bfr, P, 0, 0, 0);
            }
#pragma unroll
            for (int r = 0; r < 4; ++r) P[r] = (4 * gq + r <= i) ? P[r] : 0.f;
            const v4u pw = (v4u){pk2(P[0], P[1]), pk2(P[2], P[3]), 0u, 0u}; bf16x8 pb; __builtin_memcpy(&pb, &pw, 16);
            f32x4 Oa = __builtin_amdgcn_mfma_f32_16x16x32_bf16(vf, pb, (f32x4){0.f, 0.f, 0.f, 0.f}, 0, 0, 0);
#pragma unroll
            for (int kk = 0; kk < 4; ++kk) {
                const v4u sw = (v4u){pk2(S[2 * kk][0], S[2 * kk][1]), pk2(S[2 * kk][2], S[2 * kk][3]), pk2(S[2 * kk + 1][0], S[2 * kk + 1][1]), pk2(S[2 * kk + 1][2], S[2 * kk + 1][3])};
                bf16x8 sf; __builtin_memcpy(&sf, &sw, 16);
                const v2u q0 = *(const LAS v2u*)(L + SC_QS + (sb * 16 + i) * 272 + (32 * kk + 4 * gq) * 2), q1 = *(const LAS v2u*)(L + SC_QS + (sb * 16 + i) * 272 + (32 * kk + 16 + 4 * gq) * 2);
                const v4u qw = (v4u){q0.x, q0.y, q1.x, q1.y}; bf16x8 qb; __builtin_memcpy(&qb, &qw, 16);
                Oa = __builtin_amdgcn_mfma_f32_16x16x32_bf16(sf, qb, Oa, 0, 0, 0);
            }
            *(v2u*)(O + (size_t)scan_tau(dir, sigma0 + sb * 16 + i) * HDIM + eb + 4 * gq) = (v2u){pk2_sw(Oa[0], Oa[1]), pk2_sw(Oa[2], Oa[3])};
        }
#pragma unroll
        for (int tt = 0; tt < 8; ++tt) {
            const f32x4 dd = *(const LAS f32x4*)(L + SC_DD + (sb * 128 + 16 * tt + 4 * gq) * 4);
            const v2u kraw = *(const LAS v2u*)(L + SC_KET + sb * 4608 + gq * 1152 + (16 * tt + i) * 8);
            const v4u kw = (v4u){kraw.x, kraw.y, 0u, 0u}; bf16x8 kf; __builtin_memcpy(&kf, &kw, 16);
            S[tt] = __builtin_amdgcn_mfma_f32_16x16x32_bf16(kf, vf, S[tt] * dd, 0, 0, 0);
        }
    }
}
template <bool FULL>
__device__ __forceinline__ void scan_pass(Frame& F, const Args& args, int b, int h, int dir, int seg, bool ctx_out) {
    TID_DECL();
    unsigned char* ws = opaque_ptr(args.ws);
    const size_t hb = (size_t)(b * NHEAD + h) * SEQT * HDIM;
    const bf16* Q = (const bf16*)(ws + WS_Q) + hb; const bf16* VI = (const bf16*)(ws + WS_VI) + hb;
    const unsigned short* LG = (const unsigned short*)(ws + (dir ? WS_LB : WS_LF)) + hb; bf16* O = (bf16*)(ws + (dir ? WS_OB : WS_OF)) + hb;
    f32x4* SLOC = (f32x4*)(ws + WS_SLOC); float* ATOT = (float*)(ws + WS_ATOT);
    const int unit = ((seg * 2 + dir) * NHEAD + h) * BATCH + b;
    LAS unsigned char* L = F.lds + RING_OFF;
    const int sb1 = F.wave >> 1, c0 = 64 * (F.wave & 1) + 4 * (FLANE & 15), qi = FLANE >> 4;
    const int i = FLANE & 15, gq = FLANE >> 4, eb = 16 * F.wave;
    f32x4 S[8];
#pragma unroll
    for (int tt = 0; tt < 8; ++tt) S[tt] = (f32x4){0.f, 0.f, 0.f, 0.f};
    if (FULL) {
        for (int j = 0; j < seg; ++j) { const int uj = ((j * 2 + dir) * NHEAD + h) * BATCH + b;
#pragma unroll
            for (int tt = 0; tt < 8; ++tt) { const f32x4 at = *(const f32x4*)(ATOT + (size_t)uj * HDIM + 16 * tt + 4 * gq);
                const f32x4 dec = (f32x4){__expf(at[0]), __expf(at[1]), __expf(at[2]), __expf(at[3])};
                S[tt] = S[tt] * dec + SLOC[((size_t)(uj * 8 + F.wave) * 8 + tt) * 64 + FLANE]; } }
    }
    f32x4 atot = (f32x4){0.f, 0.f, 0.f, 0.f};
    const int g_lo = seg * SEG_GROUPS, g_hi = g_lo + SEG_GROUPS, pos1 = sb1 * 16 + 4 * qi;
    ScanRegs RA, RB;
    scan_load<FULL>(RA, LG, Q, VI, dir, g_lo * 64 + pos1, c0);
    scan_load<FULL>(RB, LG, Q, VI, dir, (g_lo + 1) * 64 + pos1, c0);
    for (int gi = g_lo; gi < g_hi; gi += 2) {
        __syncthreads();
        scan_stage1<FULL>(RA, L, sb1, c0, qi, FLANE, atot);
        if (gi + 2 < g_hi) scan_load<FULL>(RA, LG, Q, VI, dir, (gi + 2) * 64 + pos1, c0);
        __syncthreads();
        scan_stage2<FULL>(S, L, O, dir, gi * 64, ctx_out || gi >= CTXL / 64, i, gq, eb);
        if (gi + 1 >= g_hi) break;
        __syncthreads();
        scan_stage1<FULL>(RB, L, sb1, c0, qi, FLANE, atot);
        if (gi + 3 < g_hi) scan_load<FULL>(RB, LG, Q, VI, dir, (gi + 3) * 64 + pos1, c0);
        __syncthreads();
        scan_stage2<FULL>(S, L, O, dir, (gi + 1) * 64, ctx_out || gi + 1 >= CTXL / 64, i, gq, eb);
    }
    if (!FULL) {
#pragma unroll
        for (int tt = 0; tt < 8; ++tt) SLOC[((size_t)(unit * 8 + F.wave) * 8 + tt) * 64 + FLANE] = S[tt];
        __syncthreads();
        LAS float* AT = (LAS float*)(L + SC_AT);
        if (qi == 0) *(LAS f32x4*)(AT + F.wave * 64 + 4 * (FLANE & 15)) = atot;
        __syncthreads();
        if (FTID < HDIM) { const int chh = FTID >> 6, cc = FTID & 63; ATOT[(size_t)unit * HDIM + FTID] = (AT[(0 + chh) * 64 + cc] + AT[(2 + chh) * 64 + cc]) + (AT[(4 + chh) * 64 + cc] + AT[(6 + chh) * 64 + cc]); }
    }
    __syncthreads();
}

constexpr int NPH_LAYER = 13, NPHASES = 2 + DEPTH * NPH_LAYER;
__global__ void __launch_bounds__(NWAVES * 64, 2) mk_fwd(Args args) {
    TID_DECL();
    extern __shared__ __attribute__((aligned(16))) unsigned char lds[];
    Frame F;
    F.lds = (LAS unsigned char*)lds;
    F.wave = __builtin_amdgcn_readfirstlane(FTID >> 6);
    F.G = gridDim.x; F.bx = blockIdx.x;
    for (int u = FTID; u < (LDS_BYTES - LDSCTL_OFF) / 4; u += NWAVES * 64) ((LAS unsigned*)(F.lds + LDSCTL_OFF))[u] = 0u;
    __syncthreads();
    XcdBarrier bar = xcd_barrier_post((unsigned*)(args.ws + WS_CTL) + CW_BAR, (volatile LAS unsigned*)(F.lds + MISC_OFF) + 8);
    const int lo = args.ph_lo, hi = args.ph_hi;
#define IN(k) (lo <= (k) && (k) < hi)
    unsigned long long probe_t = (PROBE_PHASE >= 0) ? __builtin_amdgcn_s_memrealtime() : 0ull; const unsigned long long probe_t0 = probe_t;
#define SEAM(k) do { if (IN(k) && IN((k) + 1)) xcd_barrier(bar); \
        if (PROBE_PHASE >= 0) { const unsigned long long tn_ = __builtin_amdgcn_s_memrealtime(); \
            if ((k) == PROBE_PHASE) { const unsigned long long w_ = (unsigned long long)PROBE_MULT * (tn_ - probe_t); while (__builtin_amdgcn_s_memrealtime() - tn_ < w_) __builtin_amdgcn_s_sleep(8); } \
            probe_t = __builtin_amdgcn_s_memrealtime(); } } while (0)
    using pg8::Gemm; using pg8::RectOrder; using pg8::gemm_phase;
    LAS unsigned char* ring = F.lds + RING_OFF;
#define WSB() unsigned char* ws = opaque_ptr(args.ws)
#define MODALL ((const float*)(ws + WS_MOD))
#define NORMG(l_) (INP(6) + (size_t)(l_) * NNORM * DM)
#define MODL(l_) (MODALL + (size_t)(l_) * NGRP * NMOD * DM)
#define WL(l_) (ws + WS_W + (size_t)(l_) * W_LAYER)

    if (IN(0)) { _Pragma("nounroll") for (int rep = 0; rep < REP_P0; ++rep) { p0_prologue(F, args); __syncthreads(); } }
    SEAM(0);
    if (IN(1)) { WSB(); _Pragma("nounroll") for (int rep = 0; rep < REP_THIN; ++rep) thin_phase<0>(F, args, TT, 0, nullptr, nullptr, 0, 0.f, NORMG(0), MODALL, 0, 1); }
    SEAM(1);
#pragma nounroll
    for (int l = 0; l < DEPTH; ++l) {
        const int pb = 2 + l * NPH_LAYER; const bool lastl = (l == DEPTH - 1);
        const int npan_late = lastl ? TX / 256 : TT / 256;
        const int gG = (l == 0) ? SPARE_G : F.G;
        if (IN(pb + 0)) { if (F.bx >= gG) background_work(F, args, 0); else {
            WSB(); Gemm g{(const bf16*)(ws + WS_H), (const bf16*)(WL(l) + WO_GU1), DM, DM}; RectOrder S{0, TT / 256, 0, 2 * DFF / 256, 0, 0, 0, 0, 1, 0, 0, DM / 64, gG, F.bx}; EpiGU E{(bf16*)(ws + WS_ACT)};
            _Pragma("nounroll") for (int rep = 0; rep < REP_GEMM; ++rep) gemm_phase<EpiGU, RectOrder, true, true>(ring, g, S, E);
            if (l == 1) tail_work(F, args, (TT / 256) * (2 * DFF / 256), BG_S2_END, BG_D2_L1); } }
        SEAM(pb + 0);
        if (IN(pb + 1)) { WSB(); Gemm g{(const bf16*)(ws + WS_ACT), (const bf16*)(WL(l) + WO_D1), DFF, DFF}; RectOrder S{0, TX / 256, 0, DM / 256, TX / 256, TC / 256, 0, DM / 256, NSLAB, 12, 10, DFF / 64, F.G, F.bx}; EpiY E{(bf16*)(ws + WS_Y), (bf16*)(ws + WS_YS)};
            _Pragma("nounroll") for (int rep = 0; rep < REP_GEMM; ++rep) gemm_phase<EpiY, RectOrder, true, true>(ring, g, S, E); }
        SEAM(pb + 1);
        if (IN(pb + 2)) { WSB(); _Pragma("nounroll") for (int rep = 0; rep < REP_THIN; ++rep) { if (l == 0 && rep == 0) thin_phase<1, true>(F, args, TT, NSLAB, NORMG(l) + 1 * DM, MODL(l), 2, 0.5f, NORMG(l) + 2 * DM, MODL(l), 3, 4);
            else thin_phase<1>(F, args, TT, NSLAB, NORMG(l) + 1 * DM, MODL(l), 2, rep ? 0.f : 0.5f, NORMG(l) + 2 * DM, MODL(l), 3, 4); } }
        SEAM(pb + 2);
        if (IN(pb + 3)) { if (F.bx >= gG) background_work(F, args, 1); else {
            WSB(); Gemm g{(const bf16*)(ws + WS_H), (const bf16*)(WL(l) + WO_IN), DM, DM};
            RectOrder S{0, lastl ? TX / 256 : TT / 256, 0, INC / 256, TX / 256, lastl ? TC / 256 : 0, 12, 12, 1, 0, 0, DM / 64, gG, F.bx};
            EpiIN E{(bf16*)(ws + WS_U), (bf16*)(ws + WS_V), (bf16*)(ws + WS_Q), (bf16*)(ws + WS_VI), (bf16*)(ws + WS_SG), (unsigned char*)(ws + WS_SA), (unsigned char*)(ws + WS_SB),
                    (unsigned short*)(ws + WS_LF), (unsigned short*)(ws + WS_LB), (const float*)(ws + WS_LBT) + (size_t)l * 2 * DBB, (float*)(ws + WS_VST)};
            _Pragma("nounroll") for (int rep = 0; rep < REP_GEMM; ++rep) gemm_phase<EpiIN, RectOrder, true, true>(ring, g, S, E); } }
        SEAM(pb + 3);
        if (IN(pb + 4)) {
            if (F.bx < 192) { _Pragma("nounroll") for (int rep = 0; rep < REP_S1 * REP_SA; ++rep)
                scan_pass<false>(F, args, F.bx & 3, (F.bx >> 2) & 7, (F.bx >> 5) & 1, F.bx >> 6, !lastl); }
            _Pragma("nounroll") for (int rep = 0; rep < REP_S1 * REP_GMLP; ++rep) {
            const int n3 = lastl ? 5 : 6;
            const int u_lo = F.bx >= 192 ? (F.bx - 192) * n3 : 64 * n3 + F.bx, u_hi = u_lo + (F.bx >= 192 ? n3 : 1);
            for (int it = u_lo; it < u_hi; ++it)
                gmlp_unit(F, args, (it >> 3) * 128, it & 7, INP(12) + (size_t)l * DA, INP(13) + (size_t)l * 8 * 128 * 128, INP(14) + (size_t)l * 8 * 128);
            }
        }
        SEAM(pb + 4);
        if (IN(pb + 5)) { _Pragma("nounroll") for (int rep = 0; rep < REP_S1 * REP_SB; ++rep) scan_pass<true>(F, args, F.bx & 3, (F.bx >> 2) & 7, (F.bx >> 5) & 1, F.bx >> 6, !lastl); }
        SEAM(pb + 5);
        if (IN(pb + 6)) { _Pragma("nounroll") for (int rep = 0; rep < REP_THIN; ++rep) readout_phase(F, args, npan_late * 256, INP(16) + (size_t)l * DBB); }
        SEAM(pb + 6);
        if (IN(pb + 7)) { WSB(); RectOrder S{0, npan_late, 0, DM / 256, 0, 0, 0, 0, 1, 0, 0, 2 * DA / 64, F.G, F.bx};
            Gemm g{(const bf16*)(ws + WS_YAB), (const bf16*)(WL(l) + WO_UP), 2 * DA, 2 * DA}; EpiMerge E{(const unsigned char*)(ws + WS_SA), (const unsigned char*)(ws + WS_SB), (bf16*)(ws + WS_MB)};
            _Pragma("nounroll") for (int rep = 0; rep < REP_GEMM; ++rep) gemm_phase<EpiMerge, RectOrder, true, true>(ring, g, S, E); }
        SEAM(pb + 7);
        if (IN(pb + 8)) { WSB(); Gemm g{(const bf16*)(ws + WS_MB), (const bf16*)(WL(l) + WO_OUT), DM, DM}; RectOrder S{0, TX / 256, 0, DM / 256, TX / 256, lastl ? 0 : TC / 256, 0, DM / 256, NSLAB_OUT, 8, 8, DM / 64, F.G, F.bx}; EpiY E{(bf16*)(ws + WS_Y), (bf16*)(ws + WS_YS)};
            _Pragma("nounroll") for (int rep = 0; rep < REP_GEMM; ++rep) gemm_phase<EpiY, RectOrder, true, true>(ring, g, S, E); }
        SEAM(pb + 8);
        if (IN(pb + 9)) { WSB(); _Pragma("nounroll") for (int rep = 0; rep < REP_THIN; ++rep) thin_phase<1>(F, args, npan_late * 256, NSLAB_OUT, NORMG(l) + 3 * DM, MODL(l), 5, rep ? 0.f : 1.0f, NORMG(l) + 4 * DM, MODL(l), 6, 7); }
        SEAM(pb + 9);
        if (IN(pb + 10)) { if (F.bx >= gG) background_work(F, args, 2); else {
            WSB(); Gemm g{(const bf16*)(ws + WS_H), (const bf16*)(WL(l) + WO_GU2), DM, DM}; RectOrder S{0, npan_late, 0, 2 * DFF / 256, 0, 0, 0, 0, 1, 0, 0, DM / 64, gG, F.bx}; EpiGU E{(bf16*)(ws + WS_ACT)};
            _Pragma("nounroll") for (int rep = 0; rep < REP_GEMM; ++rep) gemm_phase<EpiGU, RectOrder, true, true>(ring, g, S, E);
            if (l == 1) tail_work(F, args, npan_late * (2 * DFF / 256), BG_D2_L1, 2 * PER_LAYER); } }
        SEAM(pb + 10);
        if (IN(pb + 11)) { WSB(); Gemm g{(const bf16*)(ws + WS_ACT), (const bf16*)(WL(l) + WO_D2), DFF, DFF}; RectOrder S{0, TX / 256, 0, DM / 256, TX / 256, lastl ? 0 : TC / 256, 0, DM / 256, NSLAB, 12, 10, DFF / 64, F.G, F.bx}; EpiY E{(bf16*)(ws + WS_Y), (bf16*)(ws + WS_YS)};
            _Pragma("nounroll") for (int rep = 0; rep < REP_GEMM; ++rep) gemm_phase<EpiY, RectOrder, true, true>(ring, g, S, E); }
        SEAM(pb + 11);
        if (IN(pb + 12)) { WSB();
            if (lastl) _Pragma("nounroll") for (int rep = 0; rep < REP_THIN; ++rep) thin_phase<2>(F, args, TX, 0, NORMG(l) + 5 * DM, MODL(l), 8, 0.5f, nullptr, nullptr, 0, 0);
            else _Pragma("nounroll") for (int rep = 0; rep < REP_THIN; ++rep) thin_phase<1>(F, args, TT, NSLAB, NORMG(l) + 5 * DM, MODL(l), 8, rep ? 0.f : 0.5f, NORMG(l + 1), MODL(l + 1), 0, 1);
        }
        if (!lastl) SEAM(pb + 12);
    }
    if (PROBE_PHASE == 99 && F.bx == 0) { const unsigned long long tn_ = __builtin_amdgcn_s_memrealtime(), w_ = tn_ - probe_t0; while (__builtin_amdgcn_s_memrealtime() - tn_ < w_) __builtin_amdgcn_s_sleep(8); }
#undef IN
#undef SEAM
}

extern "C" void kernel_launch(void* const* d_in, const int* in_sizes, int n_in, void* d_out, int out_size, void* d_ws, size_t ws_size, hipStream_t stream) {
    static int grid = 0;
    if (grid == 0) {
        if (n_in != 20 || in_sizes[0] != TX * DM || out_size != TX * DM || ws_size < WS_END) {
            fprintf(stderr, "kernel_launch: unexpected shapes / workspace (n_in %d, in0 %d, out %d, ws %zu, need %zu); nothing launched\n", n_in, n_in > 0 ? in_sizes[0] : -1, out_size, ws_size, (size_t)WS_END); grid = -1; return; }
        int dev = 0, cus = 0, per_cu = 0;
        if (hipGetDevice(&dev) != hipSuccess || hipDeviceGetAttribute(&cus, hipDeviceAttributeMultiprocessorCount, dev) != hipSuccess) { grid = -1; return; }
        if (hipFuncSetAttribute((const void*)mk_fwd, hipFuncAttributeMaxDynamicSharedMemorySize, LDS_BYTES) != hipSuccess) { fprintf(stderr, "kernel_launch: hipFuncSetAttribute failed\n"); grid = -1; return; }
        if (hipOccupancyMaxActiveBlocksPerMultiprocessor(&per_cu, (const void*)mk_fwd, NWAVES * 64, LDS_BYTES) != hipSuccess || per_cu < 1)
            fprintf(stderr, "kernel_launch: note: occupancy query reports %d workgroups per CU\n", per_cu);
        (void)hipGetLastError();
        grid = cus;
        if (grid != 256) fprintf(stderr, "kernel_launch: note: %d CUs\n", grid);
    }
    if (grid < 0) return;
    if (hipMemsetAsync((char*)d_ws, 0, ZERO_BYTES, stream) != hipSuccess) { fprintf(stderr, "kernel_launch: memset failed\n"); return; }
    Args a{};
    for (int i = 0; i < 20; ++i) a.in[i] = (const float*)d_in[i];
    a.out = (float*)d_out; a.ws = (unsigned char*)d_ws;
#if MK_PER_PHASE
    for (int p = 0; p < NPHASES; ++p) { a.ph_lo = p; a.ph_hi = p + 1; hipLaunchKernelGGL(mk_fwd, dim3(grid), dim3(NWAVES * 64), LDS_BYTES, stream, a); }
#else
    a.ph_lo = 0; a.ph_hi = NPHASES;
    hipLaunchKernelGGL(mk_fwd, dim3(grid), dim3(NWAVES * 64), LDS_BYTES, stream, a);
#endif
    const hipError_t le = hipPeekAtLastError();
    if (le != hipSuccess) fprintf(stderr, "kernel_launch: launch failed: %s\n", hipGetErrorName(le));
}
```

```cpp
#include <hip/hip_runtime.h>
#include <cstdio>
#include <cstdint>

#ifndef STAG_GU
#define STAG_GU 0
#endif
#ifndef STAG_IN
#define STAG_IN 0
#endif
#ifndef REP_GEMM
#define REP_GEMM 1
#endif
#ifndef REP_P0
#define REP_P0 1
#endif
#ifndef REP_S1
#define REP_S1 1
#endif
#ifndef REP_GMLP
#define REP_GMLP 1
#endif
#ifndef REP_SA
#define REP_SA 1
#endif
#ifndef REP_SB
#define REP_SB 1
#endif
#ifndef REP_THIN
#define REP_THIN 1
#endif
#ifndef PROBE_SECT
#define PROBE_SECT 0
#endif
#ifndef REP_BAR
#define REP_BAR 1
#endif
#ifndef REP_ST1
#define REP_ST1 1
#endif
#ifndef PROBE_PHASE
#define PROBE_PHASE (-1)
#endif
#ifndef PROBE_MULT
#define PROBE_MULT 9
#endif
#ifndef MK_PER_PHASE
#define MK_PER_PHASE 0
#endif

namespace pg8 {
#define PG8_LAS __attribute__((address_space(3)))
typedef unsigned short bf16_t;
typedef short bf16x8 __attribute__((ext_vector_type(8)));
typedef float f32x4 __attribute__((ext_vector_type(4)));
typedef unsigned u32x4 __attribute__((ext_vector_type(4)));
constexpr int BM = 256, BK = 64, HALF = 128, HTB = HALF * BK * 2, STAGE_BYTES = 8 * HTB, NXCD = 8, WGM = 8;

__host__ __device__ __forceinline__ int lds_byte(int r, int c) { const int st = (r >> 4) * 2 + (c >> 5), rr = r & 15, cc = c & 31, ob = rr * 64 + cc * 2; return st * 1024 + (ob ^ (((ob >> 9) & 1) << 5)); }
__host__ __device__ __forceinline__ void stage_rc(int b, int& R, int& C) { const int st = b / 1024, sb = b % 1024, swz = sb ^ (((sb >> 9) & 1) << 5); R = (st >> 1) * 16 + swz / 64; C = (st & 1) * 32 + (swz % 64) / 2; }
__host__ __device__ __forceinline__ int perm32(int rho) { const int n = rho >> 4, i = rho & 15; return 8 * (i >> 2) + 4 * n + (i & 3); }

struct Unit { int pm, pn, kt0, nkt, slab; };
struct Gemm { const bf16_t* A; const bf16_t* Bt; int lda, ldb; };

struct RectOrder {
    int pma, nma, pna, nna, pmb, nmb, pnb, nnb, nsl, kA, kB, KT, G, c;
    __device__ __forceinline__ void map(int wgid, int nM, int nN, int pm0, int pn0, Unit& u) const {
        const int nwg = nM * nN;
        { const int q = nwg / NXCD, r = nwg % NXCD, xcd = wgid % NXCD, off = wgid / NXCD; wgid = (xcd < r ? xcd * (q + 1) : r * (q + 1) + (xcd - r) * q) + off; }
        const int nig = WGM * nN, gid = wgid / nig, fm = gid * WGM, gsz = (nM - fm) < WGM ? (nM - fm) : WGM;
        u.pm = pm0 + fm + ((wgid % nig) % gsz); u.pn = pn0 + (wgid % nig) / gsz;
    }
    __device__ __forceinline__ bool next(int i, Unit& u) const {
        long L = (long)i * G + c; const int na = nma * nna;
        if (L < na) { map((int)L, nma, nna, pma, pna, u); u.kt0 = 0; u.nkt = KT; u.slab = -1; return true; }
        L -= na; const int nb1 = nmb * nnb;
        if (L < (long)nb1 * nsl) { const int sl = (int)(L / nb1); map((int)(L % nb1), nmb, nnb, pmb, pnb, u);
            if (nsl > 1) { u.kt0 = (sl >> 1) * (kA + kB) + (sl & 1) * kA; u.nkt = (sl & 1) ? kB : kA; u.slab = sl; } else { u.kt0 = 0; u.nkt = KT; u.slab = -1; }
            return true; }
        return false;
    }
    __device__ __forceinline__ void a_ready(const Unit&) const {}
    __device__ __forceinline__ void done(const Unit&) const {}
};

__device__ __forceinline__ unsigned cvt_pk_bf16(float lo, float hi) { unsigned r; asm volatile("v_cvt_pk_bf16_f32 %0, %1, %2" : "=v"(r) : "v"(lo), "v"(hi)); return r; }

template <class Epi, class Sched, bool ALIGN_EPI = false, bool SP2 = false>
__device__ __forceinline__ void gemm_phase(PG8_LAS unsigned char* lds, const Gemm g, const Sched& S, const Epi& E, unsigned stagger = 0u) {
    int tid_ = threadIdx.x; asm volatile("" : "+v"(tid_));
    const int tid = tid_, wid = __builtin_amdgcn_readfirstlane(tid >> 6), lane = tid & 63, wr = wid >> 2, wc = wid & 3, fr = lane & 15, fq = lane >> 4;
    unsigned voffA[2], voffB[2];
#pragma unroll
    for (int i = 0; i < 2; ++i) { int R, C; stage_rc(tid * 16 + i * 8192, R, C);
        const int Rb = Epi::PERM2 ? (64 * (R >> 5) + perm32(R & 31)) : (Epi::PERM ? ((R & ~31) + perm32(R & 31)) : R);
        voffA[i] = (unsigned)(R * g.lda + C) * 2u; voffB[i] = (unsigned)(Rb * g.ldb + C) * 2u; }
    const size_t kstep = (size_t)(BK * 2);
    const size_t hstepA = (size_t)HALF * g.lda * 2, hstepB = (size_t)(Epi::PERM2 ? 32 : HALF) * g.ldb * 2;
    const size_t tstepA = 2 * hstepA, tstepB = (size_t)BM * g.ldb * 2;
    const unsigned ldsw = (unsigned)wid * 1024u;
    const int aoff = lds_byte(wr * 64 + fr, fq * 8), boff = lds_byte(wc * 32 + fr, fq * 8);
#define PG8_SA(b, h) (((b) * 2 + (h)) * HTB)
#define PG8_SB(b, h) ((4 + (b) * 2 + (h)) * HTB)
#define PG8_STAGE(bufoff, gbase, voff) do { _Pragma("unroll") for (int _i = 0; _i < 2; ++_i) \
        __builtin_amdgcn_global_load_lds((const unsigned*)((const char*)(gbase) + (voff)[_i]), (PG8_LAS unsigned*)(lds + (bufoff) + ldsw + _i * 8192), 16, 0, 0); } while (0)
#define PG8_LDA(dst, b, h) do { _Pragma("unroll") for (int m = 0; m < 4; ++m) _Pragma("unroll") for (int k = 0; k < 2; ++k) dst[m][k] = *(const PG8_LAS bf16x8*)(lds + PG8_SA(b, h) + aoff + m * 2048 + k * 1024); } while (0)
#define PG8_LDB(dst, b, h) do { _Pragma("unroll") for (int n = 0; n < 2; ++n) _Pragma("unroll") for (int k = 0; k < 2; ++k) dst[n][k] = *(const PG8_LAS bf16x8*)(lds + PG8_SB(b, h) + boff + n * 2048 + k * 1024); } while (0)
#define PG8_MMA(ai, bj, At, Bt) do { __builtin_amdgcn_s_setprio(1); _Pragma("unroll") for (int m = 0; m < 4; ++m) _Pragma("unroll") for (int n = 0; n < 2; ++n) _Pragma("unroll") for (int k = 0; k < 2; ++k) \
        acc[ai][bj][m][n] = __builtin_amdgcn_mfma_f32_16x16x32_bf16(Bt[n][k], At[m][k], acc[ai][bj][m][n], 0, 0, 0); __builtin_amdgcn_s_setprio(0); } while (0)
#define PG8_WAIT_V(n) asm volatile("s_waitcnt vmcnt(" #n ")" ::: "memory")
#define PG8_WAIT_L(n) asm volatile("s_waitcnt lgkmcnt(" #n ")" ::: "memory")
#define PG8_BAR __builtin_amdgcn_s_barrier()
#define PG8_SCHED __builtin_amdgcn_sched_barrier(0)
    Unit cur, nxt; int ui = 0;
    if (!S.next(0, cur)) return;
    if (stagger) { const unsigned long long t0_ = __builtin_amdgcn_s_memrealtime(); while (__builtin_amdgcn_s_memrealtime() - t0_ < stagger) __builtin_amdgcn_s_sleep(4); }
    f32x4 acc[2][2][4][2];
#pragma unroll
    for (int a = 0; a < 2; ++a)
#pragma unroll
        for (int b = 0; b < 2; ++b)
#pragma unroll
            for (int m = 0; m < 4; ++m)
#pragma unroll
                for (int n = 0; n < 2; ++n) acc[a][b][m][n] = (f32x4){0.f, 0.f, 0.f, 0.f};
    bf16x8 At[4][2], B0[2][2], B1[2][2];
    const char* cA = (const char*)g.A + (size_t)cur.pm * tstepA + (size_t)cur.kt0 * kstep; const char* cB = (const char*)g.Bt + (size_t)cur.pn * tstepB + (size_t)cur.kt0 * kstep;
    S.a_ready(cur);
    if constexpr (SP2) {
        PG8_STAGE(PG8_SB(0, 0), cB, voffB); PG8_STAGE(PG8_SB(0, 1), cB + hstepB, voffB); PG8_STAGE(PG8_SA(0, 0), cA, voffA); PG8_STAGE(PG8_SA(0, 1), cA + hstepA, voffA);
        if (wr == 1) PG8_BAR;
        PG8_WAIT_V(2); PG8_BAR;
        PG8_STAGE(PG8_SB(1, 0), cB + kstep, voffB); PG8_STAGE(PG8_SA(1, 0), cA + kstep, voffA); PG8_STAGE(PG8_SB(1, 1), cB + hstepB + kstep, voffB);
        PG8_WAIT_V(6); PG8_BAR;
    } else {
        PG8_STAGE(PG8_SB(0, 0), cB, voffB); PG8_STAGE(PG8_SA(0, 0), cA, voffA); PG8_STAGE(PG8_SB(0, 1), cB + hstepB, voffB); PG8_STAGE(PG8_SA(0, 1), cA + hstepA, voffA);
        if (wr == 1) PG8_BAR;
        PG8_WAIT_V(4); PG8_BAR;
        PG8_STAGE(PG8_SB(1, 0), cB + kstep, voffB); PG8_STAGE(PG8_SA(1, 0), cA + kstep, voffA); PG8_STAGE(PG8_SB(1, 1), cB + hstepB + kstep, voffB);
        PG8_WAIT_V(6); PG8_BAR;
    }
    for (;;) {
        const bool has_next = S.next(ui + 1, nxt);
        const char* nA = has_next ? (const char*)g.A + (size_t)nxt.pm * tstepA + (size_t)nxt.kt0 * kstep : cA; const char* nB = has_next ? (const char*)g.Bt + (size_t)nxt.pn * tstepB + (size_t)nxt.kt0 * kstep : cB;
        const int nt = cur.nkt;
        for (int t = 0; t < nt; t += 2) {
            const bool last = (t == nt - 2);
            const char* a1 = cA + (size_t)(t + 1) * kstep;
            const char* a2 = last ? nA : cA + (size_t)(t + 2) * kstep; const char* b2 = last ? nB : cB + (size_t)(t + 2) * kstep;
            const char* a3 = a2 + kstep; const char* b3 = b2 + kstep;
            if (last && has_next) S.a_ready(nxt);
            if constexpr (Epi::MIDK) { if (t == (nt >> 1)) E.mid(acc, cur, wr, wc, fr, fq); }
            if constexpr (SP2) {
            PG8_LDB(B0, 0, 0); PG8_LDB(B1, 0, 1); PG8_SCHED; PG8_LDA(At, 0, 0); PG8_STAGE(PG8_SA(1, 1), a1 + hstepA, voffA);
            PG8_WAIT_V(8); PG8_WAIT_L(0); PG8_BAR; PG8_MMA(0, 0, At, B0); PG8_MMA(0, 1, At, B1); PG8_BAR; PG8_SCHED;
            PG8_LDA(At, 0, 1); PG8_STAGE(PG8_SB(0, 0), b2, voffB); PG8_STAGE(PG8_SB(0, 1), b2 + hstepB, voffB); PG8_STAGE(PG8_SA(0, 0), a2, voffA);
            PG8_WAIT_V(8); PG8_WAIT_L(0); PG8_BAR; PG8_MMA(1, 0, At, B0); PG8_MMA(1, 1, At, B1); PG8_BAR; PG8_SCHED;
            PG8_LDB(B0, 1, 0); PG8_LDB(B1, 1, 1); PG8_SCHED; PG8_LDA(At, 1, 0); PG8_STAGE(PG8_SA(0, 1), a2 + hstepA, voffA);
            PG8_WAIT_V(8); PG8_WAIT_L(0); PG8_BAR; PG8_MMA(0, 0, At, B0); PG8_MMA(0, 1, At, B1); PG8_BAR; PG8_SCHED;
            PG8_LDA(At, 1, 1); PG8_STAGE(PG8_SB(1, 0), b3, voffB); PG8_STAGE(PG8_SB(1, 1), b3 + hstepB, voffB); PG8_STAGE(PG8_SA(1, 0), a3, voffA);
            PG8_WAIT_V(8); PG8_WAIT_L(0); PG8_BAR; PG8_MMA(1, 0, At, B0); PG8_MMA(1, 1, At, B1); PG8_BAR; PG8_SCHED;
            } else {
            PG8_LDB(B0, 0, 0); PG8_SCHED; PG8_LDA(At, 0, 0); PG8_STAGE(PG8_SA(1, 1), a1 + hstepA, voffA);
            PG8_WAIT_L(8); PG8_BAR; PG8_WAIT_L(0); PG8_MMA(0, 0, At, B0); PG8_BAR; PG8_SCHED;
            PG8_LDB(B1, 0, 1); PG8_STAGE(PG8_SB(0, 0), b2, voffB);
            PG8_BAR; PG8_WAIT_L(0); PG8_MMA(0, 1, At, B1); PG8_BAR;
            PG8_LDA(At, 0, 1); PG8_STAGE(PG8_SA(0, 0), a2, voffA);
            PG8_BAR; PG8_WAIT_L(0); PG8_MMA(1, 0, At, B0); PG8_BAR; PG8_SCHED;
            PG8_STAGE(PG8_SB(0, 1), b2 + hstepB, voffB);
            PG8_WAIT_V(6); PG8_BAR; PG8_MMA(1, 1, At, B1); PG8_BAR;
            PG8_LDB(B0, 1, 0); PG8_SCHED; PG8_LDA(At, 1, 0); PG8_STAGE(PG8_SA(0, 1), a2 + hstepA, voffA);
            PG8_WAIT_L(8); PG8_BAR; PG8_WAIT_L(0); PG8_MMA(0, 0, At, B0); PG8_BAR; PG8_SCHED;
            PG8_LDB(B1, 1, 1); PG8_STAGE(PG8_SB(1, 0), b3, voffB);
            PG8_BAR; PG8_WAIT_L(0); PG8_MMA(0, 1, At, B1); PG8_BAR;
            PG8_LDA(At, 1, 1); PG8_STAGE(PG8_SA(1, 0), a3, voffA);
            PG8_BAR; PG8_WAIT_L(0); PG8_MMA(1, 0, At, B0); PG8_BAR; PG8_SCHED;
            PG8_STAGE(PG8_SB(1, 1), b3 + hstepB, voffB);
            PG8_WAIT_V(6); PG8_BAR; PG8_MMA(1, 1, At, B1); PG8_BAR;
            }
        }
        if constexpr (ALIGN_EPI) { if (wr == 0) PG8_BAR; }
        asm volatile("s_nop 7\n\ts_nop 7" ::: "memory");
        E(acc, cur, wr, wc, fr, fq); S.done(cur);
        if (!has_next) break;
#pragma unroll
        for (int a = 0; a < 2; ++a)
#pragma unroll
            for (int b = 0; b < 2; ++b)
#pragma unroll
                for (int m = 0; m < 4; ++m)
#pragma unroll
                    for (int n = 0; n < 2; ++n) acc[a][b][m][n] = (f32x4){0.f, 0.f, 0.f, 0.f};
        cur = nxt; cA = nA; cB = nB; ++ui;
        if constexpr (ALIGN_EPI) { if (wr == 1) PG8_BAR; }
    }
    PG8_WAIT_V(0);
    if constexpr (!ALIGN_EPI) { if (wr == 0) PG8_BAR; }
    PG8_BAR;
#undef PG8_SA
#undef PG8_SB
#undef PG8_STAGE
#undef PG8_LDA
#undef PG8_LDB
#undef PG8_MMA
#undef PG8_WAIT_V
#undef PG8_WAIT_L
#undef PG8_BAR
#undef PG8_SCHED
}
}

constexpr int NWAVES = 8;
constexpr int DM = 2048, BATCH = 4, SEQ = 2048, DEPTH = 2, CTXL = 256, DFF = 5632, DA = 1024, DBB = 1024, NHEAD = 8, HDIM = 128, NMOD = 9, NNORM = 6;
constexpr int INC = 2 * DA + 5 * DBB + 2 * DM;
constexpr int TX = BATCH * SEQ, TC = BATCH * CTXL, TT = TX + TC;
constexpr int NGRP = 5;
constexpr float EPS = 1e-6f;

constexpr size_t MiB = 1u << 20;
constexpr size_t WS_CTL = 0, WS_MOD = 1 * MiB, ZERO_BYTES = 32768;
constexpr size_t WS_LBT = 2 * MiB;
constexpr size_t WS_W = 4 * MiB, W_LAYER = 192 * MiB;
constexpr size_t WO_GU1 = 0, WO_D1 = 44 * MiB, WO_IN = 66 * MiB, WO_UP = 110 * MiB, WO_OUT = 118 * MiB, WO_GU2 = 126 * MiB, WO_D2 = 170 * MiB;
constexpr size_t WS_X = 388 * MiB;
constexpr size_t WS_H = 460 * MiB;
constexpr size_t WS_Y = 496 * MiB;
constexpr size_t WS_YS = 528 * MiB;
constexpr int NSLAB = 8, NSLAB_OUT = 4;
constexpr size_t WS_R = 592 * MiB;
constexpr size_t WS_ACT = WS_R;
constexpr size_t WS_U = WS_R, WS_V = WS_R + 18 * MiB, WS_Q = WS_R + 36 * MiB, WS_KF = WS_R + 54 * MiB, WS_KB = WS_R + 72 * MiB, WS_VI = WS_R + 90 * MiB;
constexpr size_t WS_LF = WS_R + 108 * MiB, WS_LB = WS_R + 144 * MiB;
constexpr size_t WS_M1 = WS_R, WS_MB = WS_R + 72 * MiB;
constexpr size_t WS_SG = WS_R + 180 * MiB;
constexpr size_t WS_SA = WS_R + 198 * MiB, WS_SB = WS_R + 234 * MiB;
constexpr size_t WS_OF = WS_R + 270 * MiB, WS_OB = WS_R + 306 * MiB;
constexpr size_t WS_YAB = WS_R + 342 * MiB;
constexpr size_t WS_SLOC = WS_R + 378 * MiB;
constexpr size_t WS_ATOT = WS_R + 394 * MiB;
constexpr size_t WS_VST = WS_R + 395 * MiB;
constexpr size_t WS_END = WS_R + 397 * MiB;
constexpr int CW_TMO = 0, CW_BAR = 4096;

constexpr int RING_OFF = 0, RING_BYTES = 131072;
constexpr int LDSCTL_OFF = RING_BYTES, MISC_OFF = LDSCTL_OFF + 320;
constexpr int LDS_BYTES = 147456;

#define GAS __attribute__((address_space(1)))
#define LAS __attribute__((address_space(3)))
typedef unsigned short bf16;
typedef unsigned v4u __attribute__((ext_vector_type(4)));
typedef unsigned v2u __attribute__((ext_vector_type(2)));
typedef float f32x4 __attribute__((ext_vector_type(4)));
typedef short bf16x8 __attribute__((ext_vector_type(8)));
typedef GAS unsigned gu32;
#define RLX_AGENT __ATOMIC_RELAXED, __HIP_MEMORY_SCOPE_AGENT
#define LDS_WAIT() asm volatile("s_waitcnt lgkmcnt(0)" ::: "memory")
#define VM_WAIT() asm volatile("s_waitcnt vmcnt(0)" ::: "memory")
__device__ __forceinline__ unsigned pk2(float lo, float hi) { return pg8::cvt_pk_bf16(lo, hi); }
__device__ __forceinline__ unsigned pk2_sw(float lo, float hi) { const unsigned a = __float_as_uint(lo), b = __float_as_uint(hi); return ((a + 0x7fffu + ((a >> 16) & 1u)) >> 16) | ((b + 0x7fffu + ((b >> 16) & 1u)) & 0xffff0000u); }
typedef _Float16 h16x2 __attribute__((ext_vector_type(2)));
__device__ __forceinline__ unsigned pkh(float lo, float hi) { const h16x2 h = {(_Float16)lo, (_Float16)hi}; return __builtin_bit_cast(unsigned, h); }
__device__ __forceinline__ float hlo(unsigned w) { return (float)__builtin_bit_cast(h16x2, w)[0]; }
__device__ __forceinline__ float hhi(unsigned w) { return (float)__builtin_bit_cast(h16x2, w)[1]; }
__device__ __forceinline__ float bflo(unsigned w) { return __uint_as_float(w << 16); }
__device__ __forceinline__ float bfhi(unsigned w) { return __uint_as_float(w & 0xffff0000u); }
__device__ __forceinline__ float bf2f(unsigned short b) { return __uint_as_float(((unsigned)b) << 16); }
__device__ __forceinline__ float fsigmoid(float x) { return __builtin_amdgcn_rcpf(1.0f + __expf(-x)); }
__device__ __forceinline__ float fsilu(float x) { return x * fsigmoid(x); }
__device__ __forceinline__ float fgelu_tanh(float x) { return x * fsigmoid(1.5957691216057308f * (x + 0.044715f * x * x * x)); }
__device__ __forceinline__ float wave_sum(float v) {
#pragma unroll
    for (int o = 1; o < 64; o <<= 1) v += __shfl_xor(v, o);
    return v;
}

#define XB_TMO      128
#define XB_XCNT(j)  (256  + 64 * (j))
#define XB_XSUB(j)  (1280 + 64 * (j))
#define XB_XGEN(j)  (2304 + 64 * (j))
#define XB_TOP      3328
#define XB_TOPGEN   3392
#define XCD_BAR_WORDS 3456
#define XB_SPIN_CAP (1u << 18)

__device__ __forceinline__ unsigned xb_ld(unsigned* p)              { return __hip_atomic_load(p, __ATOMIC_RELAXED, __HIP_MEMORY_SCOPE_AGENT); }
__device__ __forceinline__ unsigned xb_add(unsigned* p, unsigned v) { return __hip_atomic_fetch_add(p, v, __ATOMIC_RELAXED, __HIP_MEMORY_SCOPE_AGENT); }
__device__ __forceinline__ unsigned xb_xcc_id() { return (unsigned)__builtin_amdgcn_s_getreg((3 << 11) | 20) & 0xFu; }
#define XB_SPIN(cond, bar) do { unsigned _sp = 0; while (cond) { __builtin_amdgcn_s_sleep(1); \
    if ((++_sp & 255u) == 0u) { if (xb_ld(&(bar)[XB_TMO])) break; if (_sp > XB_SPIN_CAP) { atomicAdd(&(bar)[XB_TMO], 1u); break; } } } } while (0)

struct XcdBarrier {
    unsigned* bar; unsigned x;
    volatile LAS unsigned* st;
};
__device__ __forceinline__ XcdBarrier xcd_barrier_post(unsigned* bar, volatile LAS unsigned* st) {
    XcdBarrier b; b.bar = bar; b.x = xb_xcc_id(); b.st = st;
    if (threadIdx.x == 0) (void)xb_add(&bar[XB_XCNT(b.x)], 1u);
    return b;
}
__device__ __forceinline__ void xcd_barrier_complete(unsigned* bar, unsigned x, unsigned& nloc, unsigned& nx) {
    const unsigned G = gridDim.x * gridDim.y * gridDim.z;
    unsigned sum, cnt, mine, sp = 0u;
    for (;;) {
        sum = 0u; cnt = 0u; mine = 0u;
        unsigned cj[16];
#pragma unroll
        for (unsigned j = 0; j < 16; ++j) cj[j] = xb_ld(&bar[XB_XCNT(j)]);
        __builtin_amdgcn_sched_barrier(0);
#pragma unroll
        for (unsigned j = 0; j < 16; ++j) { const unsigned c = cj[j]; sum += c; cnt += (c > 0u) ? 1u : 0u; mine = (j == x) ? c : mine; }
        if (sum == G) break;
        __builtin_amdgcn_s_sleep(1);
        if ((++sp & 255u) == 0u) { if (xb_ld(&bar[XB_TMO])) break; if (sp > XB_SPIN_CAP) { atomicAdd(&bar[XB_TMO], 1u); break; } }
    }
    nloc = mine > 0u ? mine : 1u; nx = cnt > 0u ? cnt : 1u;
}
__device__ __forceinline__ void xcd_barrier(const XcdBarrier& b) {
    asm volatile("s_waitcnt vmcnt(0)" ::: "memory");
    __syncthreads();
    if (threadIdx.x == 0) {
        unsigned* bar = b.bar;
        __builtin_amdgcn_s_waitcnt(0);
        unsigned nloc = b.st[0], nx = b.st[1];
        if (nloc == 0u) { xcd_barrier_complete(bar, b.x, nloc, nx); b.st[0] = nloc; b.st[1] = nx; }
        const unsigned old = xb_add(&bar[XB_XSUB(b.x)], 1u);
        const unsigned gen = old / nloc;
        if (old + 1u == (gen + 1u) * nloc) {
            __builtin_amdgcn_fence(__ATOMIC_RELEASE, "agent");
            asm volatile("s_waitcnt vmcnt(0)" ::: "memory");
            const unsigned og = xb_add(&bar[XB_TOP], 1u);
            const unsigned tg = og / nx;
            if (og + 1u == (tg + 1u) * nx) xb_add(&bar[XB_TOPGEN], 1u);
            else XB_SPIN(xb_ld(&bar[XB_TOPGEN]) == tg, bar);
            __builtin_amdgcn_fence(__ATOMIC_ACQUIRE, "agent");
            xb_add(&bar[XB_XGEN(b.x)], 1u);
            asm volatile("s_waitcnt vmcnt(0)" ::: "memory");
        } else {
            XB_SPIN(xb_ld(&bar[XB_XGEN(b.x)]) == gen, bar);
            __builtin_amdgcn_fence(__ATOMIC_ACQUIRE, "agent");
            asm volatile("s_waitcnt vmcnt(0)" ::: "memory");
        }
    }
    __syncthreads();
}

using pg8::Unit;
__device__ __forceinline__ v4u pack8(const f32x4 a, const f32x4 b) { v4u w; w.x = pk2(a[0], a[1]); w.y = pk2(a[2], a[3]); w.z = pk2(b[0], b[1]); w.w = pk2(b[2], b[3]); return w; }

typedef float f32x2 __attribute__((ext_vector_type(2)));
struct EpiGU {
    static constexpr bool PERM = true, PERM2 = false, MIDK = false;
    bf16* O;
    __device__ __forceinline__ void operator()(const f32x4 (&acc)[2][2][4][2], const Unit& u, int wr, int wc, int fr, int fq) const {
        const int row0 = u.pm * 256 + wr * 64 + fr, col0 = u.pn * 128 + wc * 32 + 8 * fq;
#pragma unroll
        for (int ai = 0; ai < 2; ++ai)
#pragma unroll
            for (int m = 0; m < 4; ++m) {
                f32x4 v0, v1;
#pragma unroll
                for (int n = 0; n < 2; ++n)
#pragma unroll
                    for (int j = 0; j < 4; j += 2) {
                        const f32x2 g2 = (f32x2){acc[ai][0][m][n][j], acc[ai][0][m][n][j + 1]}, u2 = (f32x2){acc[ai][1][m][n][j], acc[ai][1][m][n][j + 1]};
                        const f32x2 a2 = g2 * (f32x2){-1.4426950408889634f, -1.4426950408889634f};
                        const f32x2 d2 = (f32x2){__builtin_amdgcn_exp2f(a2.x), __builtin_amdgcn_exp2f(a2.y)} + (f32x2){1.0f, 1.0f};
                        const f32x2 o2 = (g2 * u2) * (f32x2){__builtin_amdgcn_rcpf(d2.x), __builtin_amdgcn_rcpf(d2.y)};
                        if (n == 0) { v0[j] = o2.x; v0[j + 1] = o2.y; } else { v1[j] = o2.x; v1[j + 1] = o2.y; }
                    }
                *(v4u*)(O + (size_t)(row0 + ai * 128 + m * 16) * DFF + col0) = pack8(v0, v1);
            }
    }
};
__device__ __forceinline__ v4u dpp_swap1(const v4u x) {
    v4u r; r.x = (unsigned)__builtin_amdgcn_update_dpp(0, (int)x.x, 0xB1, 0xF, 0xF, true); r.y = (unsigned)__builtin_amdgcn_update_dpp(0, (int)x.y, 0xB1, 0xF, 0xF, true);
    r.z = (unsigned)__builtin_amdgcn_update_dpp(0, (int)x.z, 0xB1, 0xF, 0xF, true); r.w = (unsigned)__builtin_amdgcn_update_dpp(0, (int)x.w, 0xB1, 0xF, 0xF, true); return r;
}
struct EpiY {
    static constexpr bool PERM = true, PERM2 = true, MIDK = false;
    bf16* Y16; bf16* YS;
    __device__ __forceinline__ void operator()(const f32x4 (&acc)[2][2][4][2], const Unit& u, int wr, int wc, int fr, int fq) const {
        bf16* base = (u.slab < 0) ? Y16 + (size_t)(u.pm * 256) * DM : YS + (size_t)u.slab * TC * DM + (size_t)(u.pm * 256 - TX) * DM;
        const bool odd = fr & 1;
        bf16* pA = base + (size_t)(wr * 64 + (fr & ~1)) * DM + u.pn * 256 + wc * 64 + 8 * fq + (odd ? 32 : 0);
        bf16* pB = base + (size_t)(wr * 64 + (fr | 1)) * DM + u.pn * 256 + wc * 64 + 8 * fq + (odd ? 32 : 0);
#pragma unroll
        for (int ai = 0; ai < 2; ++ai)
#pragma unroll
            for (int m = 0; m < 4; ++m) {
                const v4u P0 = pack8(acc[ai][0][m][0], acc[ai][0][m][1]), P1 = pack8(acc[ai][1][m][0], acc[ai][1][m][1]);
                v4u X; X.x = odd ? P0.x : P1.x; X.y = odd ? P0.y : P1.y; X.z = odd ? P0.z : P1.z; X.w = odd ? P0.w : P1.w;
                const v4u Y = dpp_swap1(X);
                v4u A, B; A.x = odd ? Y.x : P0.x; A.y = odd ? Y.y : P0.y; A.z = odd ? Y.z : P0.z; A.w = odd ? Y.w : P0.w;
                B.x = odd ? P1.x : Y.x; B.y = odd ? P1.y : Y.y; B.z = odd ? P1.z : Y.z; B.w = odd ? P1.w : Y.w;
                const size_t ro = (size_t)(ai * 128 + m * 16) * DM;
                *(v4u*)(pA + ro) = A; *(v4u*)(pB + ro) = B;
            }
    }
};
constexpr int SEQT = CTXL + SEQ;
__device__ __forceinline__ size_t hm_row(int row) {
    int b, tau; if (row < TX) { b = row >> 11; tau = CTXL + (row & (SEQ - 1)); } else { const int rc = row - TX; b = rc >> 8; tau = rc & (CTXL - 1); }
    return ((size_t)b * NHEAD * SEQT + tau) * HDIM;
}
template <class T>
__device__ __forceinline__ void store_lines(T* pE, T* pO, int second, const v4u C0, const v4u C1, bool odd) {
    v4u X; X.x = odd ? C0.x : C1.x; X.y = odd ? C0.y : C1.y; X.z = odd ? C0.z : C1.z; X.w = odd ? C0.w : C1.w;
    const v4u Y = dpp_swap1(X);
    v4u A, B; A.x = odd ? Y.x : C0.x; A.y = odd ? Y.y : C0.y; A.z = odd ? Y.z : C0.z; A.w = odd ? Y.w : C0.w;
    B.x = odd ? C1.x : Y.x; B.y = odd ? C1.y : Y.y; B.z = odd ? C1.z : Y.z; B.w = odd ? C1.w : Y.w;
    *(v4u*)(pE + (odd ? second : 0)) = A; *(v4u*)(pO + (odd ? second : 0)) = B;
}
__device__ __forceinline__ size_t gate_blob(int pm, int pn, int wave, int am, int lane) { return ((((size_t)(pm * 8 + pn) * 8 + wave) * 8 + am) * 64 + lane) * 16; }
__device__ __forceinline__ unsigned q8(const f32x4 v) {
    return (unsigned)(v[0] * 255.f + 0.5f) | ((unsigned)(v[1] * 255.f + 0.5f) << 8) | ((unsigned)(v[2] * 255.f + 0.5f) << 16) | ((unsigned)(v[3] * 255.f + 0.5f) << 24);
}
struct EpiIN {
    static constexpr bool PERM = true, PERM2 = true, MIDK = false;
    bf16 *U, *V, *Q, *VI, *SG; unsigned char *SA, *SB; unsigned short *LF, *LB; const float* lbt; float* VST;
    static __device__ __forceinline__ void elem_body(const f32x4 (&acc)[2][2][4][2], bf16* O, int ld, int rE, int rO, bool odd, float a1n, float a3n, float m1, float m0) {
#pragma unroll
        for (int ai = 0; ai < 2; ++ai)
#pragma unroll
            for (int m = 0; m < 4; ++m) {
                f32x4 v[2][2];
#pragma unroll
                for (int bj = 0; bj < 2; ++bj)
#pragma unroll
                    for (int n = 0; n < 2; ++n)
#pragma unroll
                        for (int j = 0; j < 4; ++j) { const float t = acc[ai][bj][m][n][j]; const float e = __builtin_amdgcn_exp2f(t * (a3n * (t * t) + a1n)); v[bj][n][j] = (m1 * t + m0) * __builtin_amdgcn_rcpf(1.0f + e); }
                store_lines(O + (size_t)(rE + ai * 128 + m * 16) * ld, O + (size_t)(rO + ai * 128 + m * 16) * ld, 32, pack8(v[0][0], v[0][1]), pack8(v[1][0], v[1][1]), odd);
            }
    }
    __device__ __forceinline__ void operator()(const f32x4 (&acc)[2][2][4][2], const Unit& u, int wr, int wc, int fr, int fq) const {
        const int rowb = u.pm * 256 + wr * 64;
        const int rE = rowb + (fr & ~1), rO = rowb + (fr | 1); const bool odd = fr & 1;
        const int grp = u.pn >> 2;
        const int cg = (u.pn & 3) * 256 + wc * 64 + 8 * fq;
        if (grp >= 2 && grp <= 5) {
            const size_t hoff = (size_t)(cg >> 7) * SEQT * HDIM + (cg & 127);
            if (grp == 3 || grp == 4) {
                const int dir = grp - 3; unsigned short* LO = (dir ? LB : LF) + hoff;
                const f32x4 l00 = *(const f32x4*)(lbt + dir * 1024 + cg), l01 = *(const f32x4*)(lbt + dir * 1024 + cg + 4), l10 = *(const f32x4*)(lbt + dir * 1024 + cg + 32), l11 = *(const f32x4*)(lbt + dir * 1024 + cg + 36);
#pragma unroll
                for (int ai = 0; ai < 2; ++ai)
#pragma unroll
                    for (int m = 0; m < 4; ++m) {
                        v4u c[2];
#pragma unroll
                        for (int bj = 0; bj < 2; ++bj) {
                            float g[8];
#pragma unroll
                            for (int n = 0; n < 2; ++n)
#pragma unroll
                                for (int j = 0; j < 4; ++j) { const float lb = (bj ? (n ? l11 : l10) : (n ? l01 : l00))[j];
                                    const float z = fminf(fmaxf(acc[ai][bj][m][n][j], -80.f), 80.f), sg = __builtin_amdgcn_rcpf(1.0f + __expf(-z)); g[4 * n + j] = __logf(fmaxf(lb + (1.0f - lb) * sg, 1e-30f)); }
                            c[bj] = (v4u){pkh(g[0], g[1]), pkh(g[2], g[3]), pkh(g[4], g[5]), pkh(g[6], g[7])};
                        }
                        store_lines(LO + hm_row(rE + ai * 128 + m * 16), LO + hm_row(rO + ai * 128 + m * 16), 32, c[0], c[1], odd);
                    }
            } else {
                bf16* O = ((grp == 2) ? Q : VI) + hoff;
#pragma unroll
                for (int ai = 0; ai < 2; ++ai)
#pragma unroll
                    for (int m = 0; m < 4; ++m)
                        store_lines(O + hm_row(rE + ai * 128 + m * 16), O + hm_row(rO + ai * 128 + m * 16), 32, pack8(acc[ai][0][m][0], acc[ai][0][m][1]), pack8(acc[ai][1][m][0], acc[ai][1][m][1]), odd);
            }
            return;
        }
        if (grp == 1) {
            bf16* O = V + cg;
#pragma unroll
            for (int ai = 0; ai < 2; ++ai)
#pragma unroll
                for (int m = 0; m < 4; ++m) {
                    float sm = 0.f, sq = 0.f; f32x4 v[2][2];
#pragma unroll
                    for (int bj = 0; bj < 2; ++bj)
#pragma unroll
                        for (int n = 0; n < 2; ++n)
#pragma unroll
                            for (int j = 0; j < 4; ++j) { const float t = fgelu_tanh(acc[ai][bj][m][n][j]); v[bj][n][j] = t; sm += t; sq += t * t; }
                    store_lines(O + (size_t)(rE + ai * 128 + m * 16) * 1024, O + (size_t)(rO + ai * 128 + m * 16) * 1024, 32, pack8(v[0][0], v[0][1]), pack8(v[1][0], v[1][1]), odd);
                    sm += __shfl_xor(sm, 16); sm += __shfl_xor(sm, 32); sq += __shfl_xor(sq, 16); sq += __shfl_xor(sq, 32);
                    if (fq == 0) { float* p = VST + ((size_t)(rowb + fr + ai * 128 + m * 16) * 16 + (u.pn & 3) * 4 + wc) * 2; p[0] = sm; p[1] = sq; }
                }
            return;
        }
        if (grp >= 7) {
            unsigned char* T = (grp <= 8 ? SA : SB) + gate_blob(u.pm, u.pn - (grp <= 8 ? 28 : 36), wr * 4 + wc, 0, fr + 16 * fq);
#pragma unroll
            for (int ai = 0; ai < 2; ++ai)
#pragma unroll
                for (int m = 0; m < 4; ++m) {
                    v4u w;
#pragma unroll
                    for (int bj = 0; bj < 2; ++bj)
#pragma unroll
                        for (int n = 0; n < 2; ++n) { f32x4 sg;
#pragma unroll
                            for (int j = 0; j < 4; ++j) sg[j] = fsigmoid(acc[ai][bj][m][n][j]);
                            const unsigned qq = q8(sg); if (bj == 0 && n == 0) w.x = qq; else if (bj == 0) w.y = qq; else if (n == 0) w.z = qq; else w.w = qq; }
                    *(v4u*)(T + (size_t)(ai * 4 + m) * 1024) = w;
                }
            return;
        }
        bf16* O; int ld, fn;
        if (grp == 0) { O = U + cg; ld = 1024; fn = 1; }
        else { O = SG + cg; ld = 1024; fn = 2; }
        const float L2E = 1.4426950408889634f;
        elem_body(acc, O, ld, rE, rO, odd, fn == 1 ? -L2E * 1.5957691216057308f : -L2E, fn == 1 ? -L2E * 1.5957691216057308f * 0.044715f : 0.f, fn == 3 ? 0.f : 1.f, fn == 3 ? 1.f : 0.f);
    }
};
struct EpiMerge {
    static constexpr bool PERM = true, PERM2 = true, MIDK = true;
    const unsigned char* SA; const unsigned char* SB; bf16* MB;
    __device__ __forceinline__ void mid(f32x4 (&acc)[2][2][4][2], const Unit& u, int wr, int wc, int fr, int fq) const {
        int lane = fr + 16 * fq; asm volatile("" : "+v"(lane));
        const size_t off = gate_blob(u.pm, u.pn, wr * 4 + wc, 0, lane);
#pragma unroll
        for (int ai = 0; ai < 2; ++ai) {
            v4u av[4], bv[4];
#pragma unroll
            for (int m = 0; m < 4; ++m) { av[m] = *(const v4u*)(SA + off + (size_t)(ai * 4 + m) * 1024); bv[m] = *(const v4u*)(SB + off + (size_t)(ai * 4 + m) * 1024); }
            __builtin_amdgcn_sched_barrier(0);
#pragma unroll
            for (int m = 0; m < 4; ++m) {
                const unsigned aw[4] = {av[m].x, av[m].y, av[m].z, av[m].w}, bw[4] = {bv[m].x, bv[m].y, bv[m].z, bv[m].w};
#pragma unroll
                for (int d = 0; d < 4; ++d)
#pragma unroll
                    for (int j = 0; j < 4; ++j) acc[ai][d >> 1][m][d & 1][j] *= (float)((aw[d] >> (8 * j)) & 0xffu) * __builtin_amdgcn_rcpf(fmaxf((float)((bw[d] >> (8 * j)) & 0xffu), 0.5f));
            }
            __builtin_amdgcn_sched_barrier(0);
        }
    }
    __device__ __forceinline__ void operator()(const f32x4 (&acc)[2][2][4][2], const Unit& u, int wr, int wc, int fr, int fq) const {
        int lane = fr + 16 * fq; asm volatile("" : "+v"(lane));
        const size_t off = gate_blob(u.pm, u.pn, wr * 4 + wc, 0, lane);
        const bool odd = lane & 1;
        bf16* O = MB + (size_t)(u.pm * 256 + wr * 64) * 2048 + u.pn * 256 + wc * 64 + 8 * (lane >> 4);
        const int fE = (lane & 15) & ~1, fO = (lane & 15) | 1;
        v4u bv[8];
#pragma unroll
        for (int q = 0; q < 8; ++q) bv[q] = *(const v4u*)(SB + off + (size_t)q * 1024);
        __builtin_amdgcn_sched_barrier(0);
#pragma unroll
        for (int ai = 0; ai < 2; ++ai)
#pragma unroll
            for (int m = 0; m < 4; ++m) {
                const v4u b = bv[ai * 4 + m];
                const unsigned bw[4] = {b.x, b.y, b.z, b.w};
                f32x4 v[2][2];
#pragma unroll
                for (int d = 0; d < 4; ++d)
#pragma unroll
                    for (int j = 0; j < 4; ++j) v[d >> 1][d & 1][j] = acc[ai][d >> 1][m][d & 1][j] * (fmaxf((float)((bw[d] >> (8 * j)) & 0xffu), 0.5f) * (1.0f / 255.0f));
                store_lines(O + (size_t)(fE + ai * 128 + m * 16) * 2048, O + (size_t)(fO + ai * 128 + m * 16) * 2048, 32, pack8(v[0][0], v[0][1]), pack8(v[1][0], v[1][1]), odd);
            }
    }
};

struct Args { const float* in[20]; float* out; unsigned char* ws; int ph_lo, ph_hi; };

struct Frame {
    LAS unsigned char* lds;
    int wave, G, bx;
    unsigned long long sect;
};
#define SECT_B(n) unsigned long long st_##n##__ = 0; if (PROBE_SECT == n) st_##n##__ = __builtin_amdgcn_s_memrealtime()
#define SECT_E(n) if (PROBE_SECT == n) F.sect += __builtin_amdgcn_s_memrealtime() - st_##n##__
__device__ __forceinline__ int opaque_tid() { int t = threadIdx.x; asm volatile("" : "+v"(t)); return t; }
#define FTID (tid__)
#define FLANE (tid__ & 63)
#define TID_DECL() const int tid__ = opaque_tid()
__device__ __forceinline__ size_t opaque_zero() { size_t z = 0; asm volatile("" : "+s"(z)); return z; }
#define opaque_ptr(p) ((p) + opaque_zero())
__device__ __forceinline__ int opaque_int(int i) { asm volatile("" : "+s"(i)); return i; }
#define INP(i) (args.in[opaque_int(i)])

constexpr int I_GU = (DM / 64) * (2 * DFF / 32), I_D = (DFF / 64) * (DM / 32), I_IN = (DM / 64) * (INC / 32), I_UP = (DA / 64) * (DM / 32), I_OUT = (DM / 64) * (DM / 32);
constexpr int PER_LAYER = 2 * I_GU + 2 * I_D + I_IN + 2 * I_UP + I_OUT;
constexpr int IT_EARLY = I_GU + I_D + I_IN;
constexpr int SPARE_G = 227;
struct TrItem { const float* src; bf16* dst; int ldsrc, ldd; };
__device__ __forceinline__ TrItem tr_resolve(const Args& args, unsigned char* ws, int it) {
    const int l = it / PER_LAYER; int r = it % PER_LAYER;
    unsigned char* wl = ws + WS_W + (size_t)l * W_LAYER;
    const float* W; bf16* dst; int K, N, ldd, koff = 0; bool gu = false;
    if (r < I_GU) { W = INP(7) + (size_t)l * DM * 2 * DFF; K = DM; N = 2 * DFF; dst = (bf16*)(wl + WO_GU1); ldd = DM; gu = true; }
    else if ((r -= I_GU) < I_D) { W = INP(8) + (size_t)l * DFF * DM; K = DFF; N = DM; dst = (bf16*)(wl + WO_D1); ldd = DFF; }
    else if ((r -= I_D) < I_IN) { W = INP(11) + (size_t)l * DM * INC; K = DM; N = INC; dst = (bf16*)(wl + WO_IN); ldd = DM; }
    else if ((r -= I_IN) < I_UP) { W = INP(17) + (size_t)l * DA * DM; K = DA; N = DM; dst = (bf16*)(wl + WO_UP); ldd = 2 * DA; }
    else if ((r -= I_UP) < I_UP) { W = INP(18) + (size_t)l * DBB * DM; K = DBB; N = DM; dst = (bf16*)(wl + WO_UP); ldd = 2 * DA; koff = DA; }
    else if ((r -= I_UP) < I_OUT) { W = INP(19) + (size_t)l * DM * DM; K = DM; N = DM; dst = (bf16*)(wl + WO_OUT); ldd = DM; }
    else if ((r -= I_OUT) < I_GU) { W = INP(9) + (size_t)l * DM * 2 * DFF; K = DM; N = 2 * DFF; dst = (bf16*)(wl + WO_GU2); ldd = DM; gu = true; }
    else { r -= I_GU; W = INP(10) + (size_t)l * DFF * DM; K = DFF; N = DM; dst = (bf16*)(wl + WO_D2); ldd = DFF; }
    (void)K;
    const int nblk = N / 32, kb = r / nblk, nb = r % nblk;
    int sc0 = 32 * nb;
    if (gu) { const int tile = nb >> 3, within = 32 * (nb & 7); sc0 = (within < 128) ? (128 * tile + within) : (DFF + 128 * tile + within - 128); }
    TrItem t; t.src = W + (size_t)(64 * kb) * N + sc0; t.ldsrc = N; t.dst = dst + (size_t)(32 * nb) * ldd + koff + 64 * kb; t.ldd = ldd; return t;
}
__device__ __forceinline__ void tr_load(const TrItem& t, int lane, f32x4 (&v)[8]) {
    const int rr = lane >> 3, c4 = (lane & 7) * 4;
#pragma unroll
    for (int i = 0; i < 8; ++i) v[i] = __builtin_nontemporal_load((const f32x4*)(t.src + (size_t)(8 * i + rr) * t.ldsrc + c4));
}
__device__ __forceinline__ void tr_emit(const TrItem& t, int lane, const f32x4 (&v)[8], LAS float* scr) {
    const int rr = lane >> 3, c4 = (lane & 7) * 4;
#pragma unroll
    for (int i = 0; i < 8; ++i) { LAS float* s = scr + (8 * i + rr) * 33 + c4; s[0] = v[i][0]; s[1] = v[i][1]; s[2] = v[i][2]; s[3] = v[i][3]; }
    LDS_WAIT(); asm volatile("" ::: "memory");
    const int c = lane & 7;
#pragma unroll
    for (int j = 0; j < 4; ++j) { const int n = (lane >> 3) + 8 * j; const LAS float* s = scr + (8 * c) * 33 + n;
        v4u o; o.x = pk2(s[0 * 33], s[1 * 33]); o.y = pk2(s[2 * 33], s[3 * 33]); o.z = pk2(s[4 * 33], s[5 * 33]); o.w = pk2(s[6 * 33], s[7 * 33]);
        *(v4u*)(t.dst + (size_t)n * t.ldd + 8 * c) = o; }
    LDS_WAIT(); asm volatile("" ::: "memory");
}
__device__ __forceinline__ void convert_items(Frame& F, const Args& args, int it_lo, int it_hi, int iw, int nw) {
    TID_DECL();
    unsigned char* ws = opaque_ptr(args.ws);
    LAS float* scr = (LAS float*)(F.lds + RING_OFF + F.wave * 16384);
    int it = it_lo + iw;
    if (it < it_hi) {
        TrItem cur = tr_resolve(args, ws, it); f32x4 v[8]; tr_load(cur, FLANE, v);
        for (;;) {
            const int itn = it + nw; const bool more = itn < it_hi;
            TrItem nxt = cur; f32x4 vn[8];
            if (more) { nxt = tr_resolve(args, ws, itn); tr_load(nxt, FLANE, vn); }
            tr_emit(cur, FLANE, v, scr);
            if (!more) break;
#pragma unroll
            for (int i = 0; i < 8; ++i) v[i] = vn[i];
            cur = nxt; it = itn;
        }
    }
    __syncthreads();
}
__device__ __forceinline__ void mod_items(Frame& F, const Args& args, int iwg, int nwg) {
    TID_DECL();
    unsigned char* ws = opaque_ptr(args.ws);
    float* mod = (float*)(ws + WS_MOD);
    LAS float* sc = (LAS float*)(F.lds + RING_OFF);
    LAS float* red = (LAS float*)(F.lds + RING_OFF + 65536);
    for (int t = FTID; t < NGRP * DM; t += NWAVES * 64) { const int g = t >> 11, kk = t & (DM - 1);
        const float cv = (g < 4) ? INP(1)[g * DM + kk] : INP(3)[kk];
        sc[t] = cv / (1.0f + __expf(-cv)); }
    __syncthreads();
    constexpr int NB = NMOD * DM / 32;
    const int cg = FLANE & 7, kr = FLANE >> 3;
    for (int it = iwg; it < DEPTH * NB; it += nwg) {
        const int l = it / NB, nb = it % NB;
        const float* W = INP(4) + (size_t)l * DM * NMOD * DM + (size_t)(F.wave * 256 + kr) * (NMOD * DM) + nb * 32 + 4 * cg;
        f32x4 a[NGRP];
#pragma unroll
        for (int g = 0; g < NGRP; ++g) a[g] = (f32x4){0.f, 0.f, 0.f, 0.f};
#pragma unroll 8
        for (int i = 0; i < 32; ++i) { const f32x4 w = __builtin_nontemporal_load((const f32x4*)(W + (size_t)(8 * i) * (NMOD * DM)));
#pragma unroll
            for (int g = 0; g < NGRP; ++g) { const float sv = sc[g * DM + F.wave * 256 + 8 * i + kr]; a[g] += w * sv; } }
#pragma unroll
        for (int g = 0; g < NGRP; ++g)
#pragma unroll
            for (int c = 0; c < 4; ++c) { float v = a[g][c]; v += __shfl_xor(v, 8); v += __shfl_xor(v, 16); v += __shfl_xor(v, 32); a[g][c] = v; }
        if (kr == 0) {
#pragma unroll
            for (int g = 0; g < NGRP; ++g)
#pragma unroll
                for (int c = 0; c < 4; ++c) red[(F.wave * 8 + cg) * 20 + g * 4 + c] = a[g][c]; }
        __syncthreads();
        if (FTID < 160) { const int cgi = FTID / 20, v = FTID % 20, g = v >> 2, c = v & 3; float sum = 0.f;
#pragma unroll
            for (int w = 0; w < NWAVES; ++w) sum += red[(w * 8 + cgi) * 20 + v];
            const int n = nb * 32 + 4 * cgi + c;
            mod[(size_t)(l * NGRP + g) * NMOD * DM + n] = sum + INP(5)[(size_t)l * NMOD * DM + n]; }
        __syncthreads();
    }
}
__device__ __forceinline__ void p0_prologue(Frame& F, const Args& args) {
    TID_DECL();
    unsigned char* ws = opaque_ptr(args.ws);
    convert_items(F, args, 0, I_GU, F.bx * NWAVES + F.wave, F.G * NWAVES);
    mod_items(F, args, F.bx, F.G);
    if (F.bx == 0) {
        float* lbt = (float*)(ws + WS_LBT);
        for (int idx = FTID; idx < 2 * DBB; idx += NWAVES * 64) {
            float z[DEPTH], mx = -3.0e38f, den = 0.f;
#pragma unroll
            for (int l = 0; l < DEPTH; ++l) { z[l] = INP(15)[l * 2 * DBB + idx]; mx = fmaxf(mx, z[l]); }
#pragma unroll
            for (int l = 0; l < DEPTH; ++l) { z[l] = __expf(z[l] - mx); den += z[l]; }
            float cum = 0.f; const float s0 = z[0] / den;
#pragma unroll
            for (int l = 0; l < DEPTH; ++l) { cum += z[l] / den; lbt[l * 2 * DBB + idx] = (l == 0) ? 0.f : (cum - s0); }
        }
    }
}
constexpr int BG_E0 = 33764, BG_E1 = 60464, BG_E2 = 82464, BG_D2_L1 = 2 * PER_LAYER - I_D;
static_assert(BG_E0 >= IT_EARLY && BG_E1 >= PER_LAYER + I_GU && BG_E2 >= PER_LAYER + IT_EARLY + 2 * I_UP + I_OUT && BG_E2 <= BG_D2_L1, "each slot ends after what the next phases need");
constexpr int BG_S2_END = BG_E2;
__device__ __forceinline__ void background_work(Frame& F, const Args& args, int slot) {
    const int iwg = F.bx - SPARE_G, nwg = F.G - SPARE_G, iw = iwg * NWAVES + F.wave, nw = nwg * NWAVES;
    if (slot == 0) convert_items(F, args, I_GU, BG_E0, iw, nw);
    else if (slot == 1) convert_items(F, args, BG_E0, BG_E1, iw, nw);
    else convert_items(F, args, BG_E1, BG_E2, iw, nw);
}
__device__ __forceinline__ void tail_work(Frame& F, const Args& args, int U, int lo, int hi) {
    const int r = U % F.G; if (r == 0 || F.bx < r) return;
    convert_items(F, args, lo, hi, (F.bx - r) * NWAVES + F.wave, (F.G - r) * NWAVES);
}

__device__ __forceinline__ int row_grp(int row) { return row < TX ? (row >> 11) : 4; }
template <int MODE, bool XIN = false>
__device__ __forceinline__ void thin_phase(Frame& F, const Args& args, int nrows, int nslab, const float* gpost, const float* mod_r, int gate_i, float w,
                                           const float* gpre, const float* mod_m, int shift_i, int scale_i) {
    TID_DECL();
    unsigned char* ws = opaque_ptr(args.ws);
    bf16* X = (bf16*)(ws + WS_X); bf16* H = (bf16*)(ws + WS_H);
    const int rpw = nrows / F.G, g0 = row_grp(32 * F.bx), g1 = 4;
    LAS float* VA = (LAS float*)(F.lds + RING_OFF);
    LAS float* VB = VA + 2 * DM;
    LAS float* VC = VB + 2 * DM;
    const int e0 = 8 * FLANE;
    const bf16* Y16 = (const bf16*)(ws + WS_Y);
    v4u xb[2][4], yb[2][4]; f32x4 xf[2][4][2];
#define THIN_LOAD(B, rowv) do { \
        if (MODE == 0 || XIN) { const float* src_ = INP(0) + (size_t)(rowv) * DM + e0; \
            _Pragma("unroll") for (int j = 0; j < 4; ++j) { xf[B][j][0] = *(const f32x4*)(src_ + 512 * j); xf[B][j][1] = *(const f32x4*)(src_ + 512 * j + 4); } } \
        else { _Pragma("unroll") for (int j = 0; j < 4; ++j) xb[B][j] = *(const v4u*)(X + (size_t)(rowv) * DM + e0 + 512 * j); } \
        if (MODE != 0) { _Pragma("unroll") for (int j = 0; j < 4; ++j) yb[B][j] = *(const v4u*)(Y16 + (size_t)(rowv) * DM + e0 + 512 * j); } } while (0)
#define THIN_BODY(rowv, giv) do { \
        if (MODE != 0) { float s_ = 0.f; \
            _Pragma("unroll") for (int j = 0; j < 4; ++j) _Pragma("unroll") for (int q = 0; q < 2; ++q) s_ += (y[j][q][0] * y[j][q][0] + y[j][q][1] * y[j][q][1]) + (y[j][q][2] * y[j][q][2] + y[j][q][3] * y[j][q][3]); \
            const float r_ = 1.0f / sqrtf(wave_sum(s_) * (1.0f / DM) + EPS); \
            _Pragma("unroll") for (int j = 0; j < 4; ++j) _Pragma("unroll") for (int q = 0; q < 2; ++q) { const f32x4 a_ = *(const LAS f32x4*)(VA + (giv) * DM + e0 + 512 * j + 4 * q); x[j][q] += a_ * y[j][q] * r_; } } \
        if (MODE == 2) { _Pragma("unroll") for (int j = 0; j < 4; ++j) { *(f32x4*)(args.out + (size_t)(rowv) * DM + e0 + 512 * j) = x[j][0]; *(f32x4*)(args.out + (size_t)(rowv) * DM + e0 + 512 * j + 4) = x[j][1]; } } \
        else { float s_ = 0.f; \
            _Pragma("unroll") for (int j = 0; j < 4; ++j) { if (MODE != 0) *(v4u*)(X + (size_t)(rowv) * DM + e0 + 512 * j) = pack8(x[j][0], x[j][1]); \
                _Pragma("unroll") for (int q = 0; q < 2; ++q) s_ += (x[j][q][0] * x[j][q][0] + x[j][q][1] * x[j][q][1]) + (x[j][q][2] * x[j][q][2] + x[j][q][3] * x[j][q][3]); } \
            const float r_ = 1.0f / sqrtf(wave_sum(s_) * (1.0f / DM) + EPS); \
            _Pragma("unroll") for (int j = 0; j < 4; ++j) { f32x4 h_[2]; \
                _Pragma("unroll") for (int q = 0; q < 2; ++q) { const f32x4 bb_ = *(const LAS f32x4*)(VB + (giv) * DM + e0 + 512 * j + 4 * q), cc_ = *(const LAS f32x4*)(VC + (giv) * DM + e0 + 512 * j + 4 * q); h_[q] = x[j][q] * r_ * bb_ + cc_; } \
                *(v4u*)(H + (size_t)(rowv) * DM + e0 + 512 * j) = pack8(h_[0], h_[1]); } } } while (0)
#define THIN_UNPACK(dst, w4) do { dst[0] = (f32x4){bflo((w4).x), bfhi((w4).x), bflo((w4).y), bfhi((w4).y)}; dst[1] = (f32x4){bflo((w4).z), bfhi((w4).z), bflo((w4).w), bfhi((w4).w)}; } while (0)
    const int xrow0 = 32 * F.bx + F.wave;
    THIN_LOAD(0, xrow0);
#pragma unroll
    for (int it = 0; it < 2; ++it) { const int t = (FTID + it * NWAVES * 64) * 4, gi = t >> 11, n = t & (DM - 1), g = gi ? g1 : g0;
        f32x4 mr, gp, gr, ms, mh;
        if (MODE != 0) { mr = *(const f32x4*)(mod_r + (size_t)(g * NMOD + gate_i) * DM + n); gp = *(const f32x4*)(gpost + n); }
        if (MODE != 2) { gr = *(const f32x4*)(gpre + n); ms = *(const f32x4*)(mod_m + (size_t)(g * NMOD + scale_i) * DM + n); mh = *(const f32x4*)(mod_m + (size_t)(g * NMOD + shift_i) * DM + n); }
        if (MODE != 0) *(LAS f32x4*)(VA + t) = (f32x4){w * mr[0] * gp[0], w * mr[1] * gp[1], w * mr[2] * gp[2], w * mr[3] * gp[3]};
        if (MODE != 2) { *(LAS f32x4*)(VB + t) = (f32x4){gr[0] * (1.0f + ms[0]), gr[1] * (1.0f + ms[1]), gr[2] * (1.0f + ms[2]), gr[3] * (1.0f + ms[3])}; *(LAS f32x4*)(VC + t) = mh; } }
    __syncthreads();
#pragma unroll
    for (int k = 0; k < 4; ++k) {
        const int row = xrow0 + 8 * k;
        if (k < 3) THIN_LOAD((k + 1) & 1, row + 8);
        __builtin_amdgcn_sched_barrier(0);
        f32x4 x[4][2], y[4][2];
#pragma unroll
        for (int j = 0; j < 4; ++j) {
            if (MODE == 0 || XIN) { x[j][0] = xf[k & 1][j][0]; x[j][1] = xf[k & 1][j][1]; } else THIN_UNPACK(x[j], xb[k & 1][j]);
            if (MODE != 0) THIN_UNPACK(y[j], yb[k & 1][j]);
        }
        THIN_BODY(row, 0);
        __builtin_amdgcn_sched_barrier(0);
    }
    if (rpw > 32 && F.wave < rpw - 32) {
        const int row = TX + 4 * F.bx + F.wave;
        f32x4 x[4][2], y[4][2];
        if (MODE == 0 || XIN) { const float* src = INP(2) + (size_t)(row - TX) * DM + e0;
#pragma unroll
            for (int j = 0; j < 4; ++j) { x[j][0] = *(const f32x4*)(src + 512 * j); x[j][1] = *(const f32x4*)(src + 512 * j + 4); } }
        else {
#pragma unroll
            for (int j = 0; j < 4; ++j) { const v4u w4 = *(const v4u*)(X + (size_t)row * DM + e0 + 512 * j); THIN_UNPACK(x[j], w4); } }
        if (MODE != 0) {
            const bf16* YS = (const bf16*)(ws + WS_YS) + (size_t)(row - TX) * DM + e0;
#pragma unroll 1
            for (int s0 = 0; s0 < nslab; s0 += 4) {
                v4u sw[4][4];
#pragma unroll
                for (int u = 0; u < 4; ++u)
#pragma unroll
                    for (int j = 0; j < 4; ++j) sw[u][j] = *(const v4u*)(YS + (size_t)(s0 + u) * TC * DM + 512 * j);
#pragma unroll
                for (int u = 0; u < 4; ++u)
#pragma unroll
                    for (int j = 0; j < 4; ++j) { f32x4 t2[2]; THIN_UNPACK(t2, sw[u][j]); if (s0 == 0 && u == 0) { y[j][0] = t2[0]; y[j][1] = t2[1]; } else { y[j][0] += t2[0]; y[j][1] += t2[1]; } }
            }
        }
        THIN_BODY(row, 1);
    }
#undef THIN_LOAD
#undef THIN_BODY
#undef THIN_UNPACK
    __syncthreads();
}

__device__ __forceinline__ void readout_phase(Frame& F, const Args& args, int nrows, const float* gain) {
    TID_DECL();
    unsigned char* ws = opaque_ptr(args.ws);
    const bf16* OF = (const bf16*)(ws + WS_OF); const bf16* OB = (const bf16*)(ws + WS_OB); const bf16* SG = (const bf16*)(ws + WS_SG); bf16* YAB = (bf16*)(ws + WS_YAB);
    const int gw = F.bx * NWAVES + F.wave, NGW = F.G * NWAVES;
    f32x4 gn[4];
#pragma unroll
    for (int j = 0; j < 4; ++j) gn[j] = *(const f32x4*)(gain + 16 * FLANE + 4 * j);
    v2u ra[2][4], rb[2][4]; v4u rg[2][2];
#define RD_LOAD(B, rowv) do { const size_t hoff_ = hm_row(rowv) + (size_t)(FLANE >> 3) * SEQT * HDIM + 16 * (FLANE & 7);     \
        _Pragma("unroll") for (int j = 0; j < 4; ++j) { ra[B][j] = *(const v2u*)(OF + hoff_ + 4 * j); rb[B][j] = *(const v2u*)(OB + hoff_ + 4 * j); } \
        rg[B][0] = *(const v4u*)(SG + (size_t)(rowv) * DBB + 16 * FLANE); rg[B][1] = *(const v4u*)(SG + (size_t)(rowv) * DBB + 16 * FLANE + 8); } while (0)
#define RD_BODY(B, rowv) do { f32x4 o[4]; float s_ = 0.f; \
        _Pragma("unroll") for (int j = 0; j < 4; ++j) { const v2u a2 = ra[B][j], b2 = rb[B][j]; \
            o[j] = (f32x4){bflo(a2.x) + bflo(b2.x), bfhi(a2.x) + bfhi(b2.x), bflo(a2.y) + bflo(b2.y), bfhi(a2.y) + bfhi(b2.y)}; s_ += (o[j][0] * o[j][0] + o[j][1] * o[j][1]) + (o[j][2] * o[j][2] + o[j][3] * o[j][3]); } \
        s_ += __shfl_xor(s_, 1); s_ += __shfl_xor(s_, 2); s_ += __shfl_xor(s_, 4); \
        const float r_ = 1.0f / sqrtf(s_ * (1.0f / HDIM) + EPS); \
        const unsigned gw_[8] = {rg[B][0].x, rg[B][0].y, rg[B][0].z, rg[B][0].w, rg[B][1].x, rg[B][1].y, rg[B][1].z, rg[B][1].w}; \
        unsigned ow[8]; \
        _Pragma("unroll") for (int j = 0; j < 4; ++j) { \
            const float a0 = o[j][0] * r_ * gn[j][0] * bflo(gw_[2 * j]), a1 = o[j][1] * r_ * gn[j][1] * bfhi(gw_[2 * j]), a2_ = o[j][2] * r_ * gn[j][2] * bflo(gw_[2 * j + 1]), a3 = o[j][3] * r_ * gn[j][3] * bfhi(gw_[2 * j + 1]); \
            ow[2 * j] = pk2(a0, a1); ow[2 * j + 1] = pk2(a2_, a3); } \
        bf16* dst = YAB + (size_t)(rowv) * (2 * DA) + DA + 16 * FLANE; \
        *(v4u*)dst = (v4u){ow[0], ow[1], ow[2], ow[3]}; *(v4u*)(dst + 8) = (v4u){ow[4], ow[5], ow[6], ow[7]}; } while (0)
    const bool tail = gw + 4 * NGW < nrows;
    RD_LOAD(0, gw);
#pragma unroll
    for (int k = 0; k < 4; ++k) {
        const int row = gw + k * NGW;
        if (k < 3) RD_LOAD((k + 1) & 1, row + NGW); else if (tail) RD_LOAD(0, gw + 4 * NGW);
        __builtin_amdgcn_sched_barrier(0);
        RD_BODY(k & 1, row);
        __builtin_amdgcn_sched_barrier(0);
    }
    if (tail) RD_BODY(0, gw + 4 * NGW);
#undef RD_LOAD
#undef RD_BODY
}

constexpr int GM_VNT = 0, GM_STAT = 128 * 272;
__device__ __forceinline__ void gmlp_unit(Frame& F, const Args& args, int row0, int g, const float* cng, const float* wsp, const float* bsp) {
    TID_DECL();
    unsigned char* ws = opaque_ptr(args.ws);
    const bf16* U = (const bf16*)(ws + WS_U); const bf16* V = (const bf16*)(ws + WS_V); bf16* YAB = (bf16*)(ws + WS_YAB);
    LAS unsigned char* vnT = F.lds + RING_OFF + GM_VNT; LAS float* stat = (LAS float*)(F.lds + RING_OFF + GM_STAT);
    if (FTID < 128) {
        const f32x4* p = (const f32x4*)((const float*)(ws + WS_VST) + (size_t)(row0 + FTID) * 32);
        float sm = 0.f, sq = 0.f;
#pragma unroll
        for (int k = 0; k < 8; ++k) { const f32x4 t = p[k]; sm += t[0] + t[2]; sq += t[1] + t[3]; }
        const float mean = sm * (1.0f / DA), var = fmaxf(sq * (1.0f / DA) - mean * mean, 0.f);
        stat[2 * FTID] = mean; stat[2 * FTID + 1] = 1.0f / sqrtf(var + EPS);
    }
    __syncthreads();
    for (int it = FTID; it < 128 * 16; it += NWAVES * 64) {
        const int s = it & 127, dd = it >> 7;
        const v4u a = *(const v4u*)(V + (size_t)(row0 + s) * DA + g * 128 + 8 * dd);
        const float mean = stat[2 * s], rstd = stat[2 * s + 1];
        const f32x4 g0 = *(const f32x4*)(cng + g * 128 + 8 * dd), g1 = *(const f32x4*)(cng + g * 128 + 8 * dd + 4);
        const unsigned wv[4] = {a.x, a.y, a.z, a.w};
#pragma unroll
        for (int j = 0; j < 4; ++j) {
            const float lo = (bflo(wv[j]) - mean) * rstd * (j < 2 ? g0[2 * j] : g1[2 * j - 4]), hi = (bfhi(wv[j]) - mean) * rstd * (j < 2 ? g0[2 * j + 1] : g1[2 * j - 3]);
            const unsigned p = pk2(lo, hi);
            *(LAS unsigned short*)(vnT + (8 * dd + 2 * j) * 272 + 2 * s) = (unsigned short)(p & 0xffffu);
            *(LAS unsigned short*)(vnT + (8 * dd + 2 * j + 1) * 272 + 2 * s) = (unsigned short)(p >> 16);
        }
    }
    __syncthreads();
    const int i = FLANE & 15, gq = FLANE >> 4;
    f32x4 acc[8];
#pragma unroll
    for (int md = 0; md < 8; ++md) acc[md] = (f32x4){0.f, 0.f, 0.f, 0.f};
    const float* wrow = wsp + ((size_t)g * 128 + 16 * F.wave + i) * 128;
#pragma unroll
    for (int kk = 0; kk < 4; ++kk) {
        const f32x4 w0 = *(const f32x4*)(wrow + 32 * kk + 8 * gq), w1 = *(const f32x4*)(wrow + 32 * kk + 8 * gq + 4);
        const v4u wb = pack8(w0, w1); bf16x8 bfrag; __builtin_memcpy(&bfrag, &wb, 16);
#pragma unroll
        for (int md = 0; md < 8; ++md) {
            const bf16x8 afrag = *(const LAS bf16x8*)(vnT + (16 * md + i) * 272 + (32 * kk + 8 * gq) * 2);
            acc[md] = __builtin_amdgcn_mfma_f32_16x16x32_bf16(afrag, bfrag, acc[md], 0, 0, 0);
        }
    }
    const int t = 16 * F.wave + i; const float bias = bsp[g * 128 + t];
#pragma unroll
    for (int md = 0; md < 8; ++md) {
        const size_t col = (size_t)g * 128 + 16 * md + 4 * gq;
        const v2u uu = *(const v2u*)(U + (size_t)(row0 + t) * DA + col);
        v2u o; o.x = pk2(bflo(uu.x) * (acc[md][0] + bias), bfhi(uu.x) * (acc[md][1] + bias)); o.y = pk2(bflo(uu.y) * (acc[md][2] + bias), bfhi(uu.y) * (acc[md][3] + bias));
        *(v2u*)(YAB + (size_t)(row0 + t) * (2 * DA) + col) = o;
    }
    __syncthreads();
}

constexpr int SC_QS = 0, SC_KS = 17408, SC_KET = 34816, SC_VT = 53248, SC_DD = 71680, SC_AT = 73728, SC_PP = 75776, SC_OST = 83968;
constexpr int SEGLEN = (CTXL + SEQ) / 4, SEG_GROUPS = SEGLEN / 64;
__device__ __forceinline__ int scan_tau(int dir, int sigma) { return dir ? (sigma < CTXL ? CTXL - 1 - sigma : SEQT + CTXL - 1 - sigma) : sigma; }
struct ScanRegs { v2u lf[4]; v2u qv[4], vv[4]; };
template <bool FULL>
__device__ __forceinline__ void scan_load(ScanRegs& R, const unsigned short* LG, const bf16* Q, const bf16* VI, int dir, int sigma0, int c0) {
#pragma unroll
    for (int p = 0; p < 4; ++p) { const size_t ro = (size_t)scan_tau(dir, sigma0 + p) * HDIM + c0;
        R.lf[p] = *(const v2u*)(LG + ro); R.vv[p] = *(const v2u*)(VI + ro); if (FULL) R.qv[p] = *(const v2u*)(Q + ro); }
}
template <bool FULL>
__device__ __forceinline__ void scan_stage1(const ScanRegs& R, LAS unsigned char* L, int sb1, int c0, int qi, int lane, f32x4& atot, bool do_out) {
    f32x4 lf[4];
#pragma unroll
    for (int p = 0; p < 4; ++p) lf[p] = (f32x4){hlo(R.lf[p].x), hhi(R.lf[p].x), hlo(R.lf[p].y), hhi(R.lf[p].y)};
    f32x4 a[4]; a[0] = lf[0]; a[1] = a[0] + lf[1]; a[2] = a[1] + lf[2]; a[3] = a[2] + lf[3];
    f32x4 inc = a[3], a15;
#pragma unroll
    for (int c = 0; c < 4; ++c) { float v = inc[c]; float t = __shfl_up(v, 16); if (qi >= 1) v += t; t = __shfl_up(v, 32); if (qi >= 2) v += t; inc[c] = v; a15[c] = __shfl(v, 48 + (lane & 15)); }
    const f32x4 excl = inc - a[3];
    float kef[4][4];
#pragma unroll
    for (int p = 0; p < 4; ++p) {
        const f32x4 ap = a[p] + excl;
        f32x4 kf4;
#pragma unroll
        for (int c = 0; c < 4; ++c) { kf4[c] = 1.0f - __expf(lf[p][c]); kef[p][c] = kf4[c] * __expf(a15[c] - ap[c]); }
        if (FULL) {
            const f32x4 qf4 = (f32x4){bflo(R.qv[p].x), bfhi(R.qv[p].x), bflo(R.qv[p].y), bfhi(R.qv[p].y)};
            f32x4 qs, ks;
#pragma unroll
            for (int c = 0; c < 4; ++c) { qs[c] = qf4[c] * __expf(ap[c]); ks[c] = kf4[c] * __expf(fminf(-ap[c], 80.f)); }
            const int ro = (sb1 * 16 + 4 * qi + p) * 272 + 2 * c0;
            *(LAS v2u*)(L + SC_QS + ro) = (v2u){pk2(qs[0], qs[1]), pk2(qs[2], qs[3])};
            *(LAS v2u*)(L + SC_KS + ro) = (v2u){pk2(ks[0], ks[1]), pk2(ks[2], ks[3])};
        }
    }
    if (FULL && do_out) {
        const int ch = c0 >> 6, fi = lane & 15, fg = lane >> 4;
        f32x4 P = (f32x4){0.f, 0.f, 0.f, 0.f};
#pragma unroll
        for (int k2 = 0; k2 < 2; ++k2) {
            const int fo = (sb1 * 16 + fi) * 272 + (64 * ch + 32 * k2 + 8 * fg) * 2;
            P = __builtin_amdgcn_mfma_f32_16x16x32_bf16(*(const LAS bf16x8*)(L + SC_KS + fo), *(const LAS bf16x8*)(L + SC_QS + fo), P, 0, 0, 0);
        }
        *(LAS f32x4*)(L + SC_PP + ((sb1 * 2 + ch) * 64 + lane) * 16) = P;
    }
    const int to = sb1 * 4608 + qi * 1152 + c0 * 8;
    *(LAS v4u*)(L + SC_KET + to) = (v4u){pk2(kef[0][0], kef[1][0]), pk2(kef[2][0], kef[3][0]), pk2(kef[0][1], kef[1][1]), pk2(kef[2][1], kef[3][1])};
    *(LAS v4u*)(L + SC_KET + to + 16) = (v4u){pk2(kef[0][2], kef[1][2]), pk2(kef[2][2], kef[3][2]), pk2(kef[0][3], kef[1][3]), pk2(kef[2][3], kef[3][3])};
    const unsigned v00 = R.vv[0].x, v01 = R.vv[0].y, v10 = R.vv[1].x, v11 = R.vv[1].y, v20 = R.vv[2].x, v21 = R.vv[2].y, v30 = R.vv[3].x, v31 = R.vv[3].y;
    *(LAS v4u*)(L + SC_VT + to) = (v4u){(v00 & 0xffffu) | (v10 << 16), (v20 & 0xffffu) | (v30 << 16), (v00 >> 16) | (v10 & 0xffff0000u), (v20 >> 16) | (v30 & 0xffff0000u)};
    *(LAS v4u*)(L + SC_VT + to + 16) = (v4u){(v01 & 0xffffu) | (v11 << 16), (v21 & 0xffffu) | (v31 << 16), (v01 >> 16) | (v11 & 0xffff0000u), (v21 >> 16) | (v31 & 0xffff0000u)};
    if (qi == 3) *(LAS f32x4*)(L + SC_DD + (sb1 * 128 + c0) * 4) = (f32x4){__expf(a15[0]), __expf(a15[1]), __expf(a15[2]), __expf(a15[3])};
    atot += a15;
}
template <bool FULL, bool DO_OUT>
__device__ __forceinline__ void scan_stage2(f32x4 (&S)[8], LAS unsigned char* L, bf16* O, int dir, int sigma0, int i, int gq, int eb) {
    const LAS unsigned char* pQ = L + SC_QS + i * 272 + 8 * gq;
    const LAS unsigned char* pP = L + SC_PP + (i + 16 * gq) * 16;
    const LAS unsigned char* pV = L + SC_VT + gq * 1152 + (eb + i) * 8;
    v2u vraw = *(const LAS v2u*)pV;
    v2u q0[4], q1[4]; f32x4 pa, pc;
    if (FULL && DO_OUT) {
        pa = *(const LAS f32x4*)pP; pc = *(const LAS f32x4*)(pP + 1024);
#pragma unroll
        for (int kk = 0; kk < 4; ++kk) { q0[kk] = *(const LAS v2u*)(pQ + 64 * kk); q1[kk] = *(const LAS v2u*)(pQ + 64 * kk + 32); }
    }
#pragma unroll 1
    for (int sb = 0; sb < 4; ++sb) {
        f32x4 dd[8]; v2u kraw[8];
#pragma unroll
        for (int tt = 0; tt < 8; ++tt) { dd[tt] = *(const LAS f32x4*)(L + SC_DD + (sb * 128 + 16 * tt + 4 * gq) * 4); kraw[tt] = *(const LAS v2u*)(L + SC_KET + sb * 4608 + gq * 1152 + (16 * tt + i) * 8); }
        __builtin_amdgcn_sched_barrier(0);
        const v4u vw = (v4u){vraw.x, vraw.y, 0u, 0u}; bf16x8 vf; __builtin_memcpy(&vf, &vw, 16);
        if (FULL && DO_OUT) {
            f32x4 Oa = (f32x4){0.f, 0.f, 0.f, 0.f};
#pragma unroll
            for (int kk = 0; kk < 4; ++kk) {
                const v4u sw = (v4u){pk2(S[2 * kk][0], S[2 * kk][1]), pk2(S[2 * kk][2], S[2 * kk][3]), pk2(S[2 * kk + 1][0], S[2 * kk + 1][1]), pk2(S[2 * kk + 1][2], S[2 * kk + 1][3])};
                bf16x8 sf; __builtin_memcpy(&sf, &sw, 16);
                const v4u qw = (v4u){q0[kk].x, q0[kk].y, q1[kk].x, q1[kk].y}; bf16x8 qb; __builtin_memcpy(&qb, &qw, 16);
                Oa = __builtin_amdgcn_mfma_f32_16x16x32_bf16(sf, qb, Oa, 0, 0, 0);
            }
            f32x4 P = pa + pc;
#pragma unroll
            for (int r = 0; r < 4; ++r) P[r] = (4 * gq + r <= i) ? P[r] : 0.f;
            const v4u pw = (v4u){pk2(P[0], P[1]), pk2(P[2], P[3]), 0u, 0u}; bf16x8 pb; __builtin_memcpy(&pb, &pw, 16);
            Oa = __builtin_amdgcn_mfma_f32_16x16x32_bf16(vf, pb, Oa, 0, 0, 0);
            *(LAS v2u*)(L + SC_OST + (sb * 16 + i) * 272 + (eb + 4 * gq) * 2) = (v2u){pk2_sw(Oa[0], Oa[1]), pk2_sw(Oa[2], Oa[3])};
        }
        __builtin_amdgcn_sched_barrier(0);
        const v2u vnext = *(const LAS v2u*)(pV + (sb + 1) * 4608);
        if (FULL && DO_OUT) {
            pa = *(const LAS f32x4*)(pP + (sb + 1) * 2048); pc = *(const LAS f32x4*)(pP + (sb + 1) * 2048 + 1024);
#pragma unroll
            for (int kk = 0; kk < 4; ++kk) { q0[kk] = *(const LAS v2u*)(pQ + (sb + 1) * 4352 + 64 * kk); q1[kk] = *(const LAS v2u*)(pQ + (sb + 1) * 4352 + 64 * kk + 32); }
        }
        __builtin_amdgcn_sched_barrier(0);
#pragma unroll
        for (int tt = 0; tt < 8; ++tt) {
            const v4u kw = (v4u){kraw[tt].x, kraw[tt].y, 0u, 0u}; bf16x8 kf; __builtin_memcpy(&kf, &kw, 16);
            S[tt] = __builtin_amdgcn_mfma_f32_16x16x32_bf16(kf, vf, S[tt] * dd[tt], 0, 0, 0);
        }
        vraw = vnext;
    }
}
__device__ __forceinline__ void scan_flush(LAS unsigned char* L, bf16* O, int dir, int sigma0, int tid) {
#pragma unroll
    for (int h2 = 0; h2 < 2; ++h2) { const int idx = tid + h2 * NWAVES * 64, row = idx >> 4, ch = idx & 15;
        const v4u w = *(const LAS v4u*)(L + SC_OST + row * 272 + ch * 16);
        *(v4u*)(O + (size_t)scan_tau(dir, sigma0 + row) * HDIM + ch * 8) = w; }
}
template <bool FULL>
__device__ __forceinline__ void scan_pass(Frame& F, const Args& args, int b, int h, int dir, int seg, bool ctx_out) {
    TID_DECL();
    unsigned char* ws = opaque_ptr(args.ws);
    const size_t hb = (size_t)(b * NHEAD + h) * SEQT * HDIM;
    const bf16* Q = (const bf16*)(ws + WS_Q) + hb; const bf16* VI = (const bf16*)(ws + WS_VI) + hb;
    const unsigned short* LG = (const unsigned short*)(ws + (dir ? WS_LB : WS_LF)) + hb; bf16* O = (bf16*)(ws + (dir ? WS_OB : WS_OF)) + hb;
    f32x4* SLOC = (f32x4*)(ws + WS_SLOC); float* ATOT = (float*)(ws + WS_ATOT);
    const int unit = ((seg * 2 + dir) * NHEAD + h) * BATCH + b;
    LAS unsigned char* L = F.lds + RING_OFF;
    const int sb1 = F.wave >> 1, c0 = 64 * (F.wave & 1) + 4 * (FLANE & 15), qi = FLANE >> 4;
    const int i = FLANE & 15, gq = FLANE >> 4, eb = 16 * F.wave;
    f32x4 S[8];
#pragma unroll
    for (int tt = 0; tt < 8; ++tt) S[tt] = (f32x4){0.f, 0.f, 0.f, 0.f};
    f32x4 atot = (f32x4){0.f, 0.f, 0.f, 0.f};
    const int g_lo = seg * SEG_GROUPS, g_hi = g_lo + SEG_GROUPS, pos1 = sb1 * 16 + 4 * qi;
    ScanRegs RA, RB;
    scan_load<FULL>(RA, LG, Q, VI, dir, g_lo * 64 + pos1, c0);
    scan_load<FULL>(RB, LG, Q, VI, dir, (g_lo + 1) * 64 + pos1, c0);
    if (FULL) {
        for (int j = 0; j < seg; ++j) { const int uj = ((j * 2 + dir) * NHEAD + h) * BATCH + b;
            f32x4 at[8], sl[8];
#pragma unroll
            for (int tt = 0; tt < 8; ++tt) { at[tt] = *(const f32x4*)(ATOT + (size_t)uj * HDIM + 16 * tt + 4 * gq); sl[tt] = SLOC[((size_t)(uj * 8 + F.wave) * 8 + tt) * 64 + FLANE]; }
            __builtin_amdgcn_sched_barrier(0);
#pragma unroll
            for (int tt = 0; tt < 8; ++tt) { const f32x4 dec = (f32x4){__expf(at[tt][0]), __expf(at[tt][1]), __expf(at[tt][2]), __expf(at[tt][3])}; S[tt] = S[tt] * dec + sl[tt]; } }
    }
#define SCAN_GROUP(R, g, gn, REFILL) do { const bool dout_ = ctx_out || (g) >= CTXL / 64; \
        __syncthreads(); scan_stage1<FULL>(R, L, sb1, c0, qi, FLANE, atot, dout_); \
        if (REFILL) scan_load<FULL>(R, LG, Q, VI, dir, (gn) * 64 + pos1, c0); \
        if (prev_out) scan_flush(L, O, dir, prev_sigma0, FTID);     \
        __syncthreads(); \
        if (dout_) scan_stage2<FULL, true>(S, L, O, dir, (g) * 64, i, gq, eb); else scan_stage2<FULL, false>(S, L, O, dir, (g) * 64, i, gq, eb); \
        prev_out = dout_; prev_sigma0 = (g) * 64; } while (0)
    static_assert(SEG_GROUPS % 2 == 1, "pairs, then one last group from RA");
    bool prev_out = false; int prev_sigma0 = 0;
    for (int gi = g_lo; gi + 1 < g_hi; gi += 2) {
        SCAN_GROUP(RA, gi, gi + 2, true);
        SCAN_GROUP(RB, gi + 1, (gi + 3 < g_hi ? gi + 3 : g_hi - 1), true);
    }
    SCAN_GROUP(RA, g_hi - 1, 0, false);
#undef SCAN_GROUP
    if (FULL) { __syncthreads(); if (prev_out) scan_flush(L, O, dir, prev_sigma0, FTID); }
    if (!FULL) {
#pragma unroll
        for (int tt = 0; tt < 8; ++tt) SLOC[((size_t)(unit * 8 + F.wave) * 8 + tt) * 64 + FLANE] = S[tt];
        __syncthreads();
        LAS float* AT = (LAS float*)(L + SC_AT);
        if (qi == 0) *(LAS f32x4*)(AT + F.wave * 64 + 4 * (FLANE & 15)) = atot;
        __syncthreads();
        if (FTID < HDIM) { const int chh = FTID >> 6, cc = FTID & 63; ATOT[(size_t)unit * HDIM + FTID] = (AT[(0 + chh) * 64 + cc] + AT[(2 + chh) * 64 + cc]) + (AT[(4 + chh) * 64 + cc] + AT[(6 + chh) * 64 + cc]); }
    }
    __syncthreads();
}

constexpr int PA_KDT = 0, PA_VT = 51200, PA_DD = 102400;
constexpr int PA_GROUP = 192, PA_NG = SEGLEN / PA_GROUP;
struct PaRegs { v2u lf[12]; v2u vv[12]; };
__device__ __forceinline__ void pa_load(PaRegs& R, const unsigned short* LG, const bf16* VI, int dir, int sigma0, int col) {
#pragma unroll
    for (int p = 0; p < 12; ++p) { const size_t ro = (size_t)scan_tau(dir, sigma0 + p) * HDIM + col; R.lf[p] = *(const v2u*)(LG + ro); R.vv[p] = *(const v2u*)(VI + ro); }
}
__device__ __forceinline__ void pa_stage1(const PaRegs& R, LAS unsigned char* L, int col, int pq, int c4, int lane, f32x4& atot) {
    f32x4 run = (f32x4){0.f, 0.f, 0.f, 0.f};
#pragma unroll
    for (int p = 0; p < 12; ++p) run += (f32x4){hlo(R.lf[p].x), hhi(R.lf[p].x), hlo(R.lf[p].y), hhi(R.lf[p].y)};
    f32x4 inc = run, Ct;
#pragma unroll
    for (int c = 0; c < 4; ++c) { float v = inc[c];
#pragma unroll
        for (int d = 4; d < 64; d <<= 1) { const float t = __shfl_up(v, d); if (lane >= d) v += t; }
        inc[c] = v; Ct[c] = __shfl(v, 60 + c4); }
    f32x4 cp = inc - run;
    unsigned kd[4][6], vt[4][6];
    float prev[4];
#pragma unroll
    for (int p = 0; p < 12; ++p) {
        const f32x4 l = (f32x4){hlo(R.lf[p].x), hhi(R.lf[p].x), hlo(R.lf[p].y), hhi(R.lf[p].y)};
        cp += l;
        const unsigned vw[2] = {R.vv[p].x, R.vv[p].y};
#pragma unroll
        for (int c = 0; c < 4; ++c) {
            const float kdv = (1.0f - __expf(l[c])) * __expf(Ct[c] - cp[c]);
            const unsigned vb = (c & 1) ? (vw[c >> 1] >> 16) : (vw[c >> 1] & 0xffffu);
            if (p & 1) { kd[c][p >> 1] = pk2(prev[c], kdv); vt[c][p >> 1] |= vb << 16; } else { prev[c] = kdv; vt[c][p >> 1] = vb; }
        }
    }
#pragma unroll
    for (int c = 0; c < 4; ++c) {
        LAS unsigned char* pk = L + PA_KDT + (col + c) * 400 + 24 * pq; LAS unsigned char* pv = L + PA_VT + (col + c) * 400 + 24 * pq;
#pragma unroll
        for (int q = 0; q < 3; ++q) { *(LAS v2u*)(pk + 8 * q) = (v2u){kd[c][2 * q], kd[c][2 * q + 1]}; *(LAS v2u*)(pv + 8 * q) = (v2u){vt[c][2 * q], vt[c][2 * q + 1]}; }
    }
    if (pq == 0) *(LAS f32x4*)(L + PA_DD + col * 4) = (f32x4){__expf(Ct[0]), __expf(Ct[1]), __expf(Ct[2]), __expf(Ct[3])};
    atot += Ct;
}
__device__ __forceinline__ void pa_stage2(f32x4 (&S)[8], LAS unsigned char* L, int i, int gq, int eb) {
    bf16x8 bfr[6], ka[2][6]; f32x4 dd[8];
#pragma unroll
    for (int kk = 0; kk < 6; ++kk) { bfr[kk] = *(const LAS bf16x8*)(L + PA_VT + (eb + i) * 400 + (32 * kk + 8 * gq) * 2); ka[0][kk] = *(const LAS bf16x8*)(L + PA_KDT + i * 400 + (32 * kk + 8 * gq) * 2); }
#pragma unroll
    for (int tt = 0; tt < 8; ++tt) dd[tt] = *(const LAS f32x4*)(L + PA_DD + (16 * tt + 4 * gq) * 4);
#pragma unroll
    for (int tt = 0; tt < 8; ++tt) {
        if (tt < 7) {
#pragma unroll
            for (int kk = 0; kk < 6; ++kk) ka[(tt + 1) & 1][kk] = *(const LAS bf16x8*)(L + PA_KDT + (16 * (tt + 1) + i) * 400 + (32 * kk + 8 * gq) * 2);
        }
        __builtin_amdgcn_sched_barrier(0);
        f32x4 a = S[tt] * dd[tt];
#pragma unroll
        for (int kk = 0; kk < 6; ++kk) a = __builtin_amdgcn_mfma_f32_16x16x32_bf16(ka[tt & 1][kk], bfr[kk], a, 0, 0, 0);
        S[tt] = a;
        __builtin_amdgcn_sched_barrier(0);
    }
}
__device__ __forceinline__ void scan_pass_a2(Frame& F, const Args& args, int b, int h, int dir, int seg) {
    TID_DECL();
    unsigned char* ws = opaque_ptr(args.ws);
    const size_t hb = (size_t)(b * NHEAD + h) * SEQT * HDIM;
    const bf16* VI = (const bf16*)(ws + WS_VI) + hb; const unsigned short* LG = (const unsigned short*)(ws + (dir ? WS_LB : WS_LF)) + hb;
    f32x4* SLOC = (f32x4*)(ws + WS_SLOC); float* ATOT = (float*)(ws + WS_ATOT);
    const int unit = ((seg * 2 + dir) * NHEAD + h) * BATCH + b;
    LAS unsigned char* L = F.lds + RING_OFF;
    const int c4 = FLANE & 3, pq = FLANE >> 2, col = 16 * F.wave + 4 * c4;
    const int i = FLANE & 15, gq = FLANE >> 4, eb = 16 * F.wave;
    f32x4 S[8];
#pragma unroll
    for (int tt = 0; tt < 8; ++tt) S[tt] = (f32x4){0.f, 0.f, 0.f, 0.f};
    f32x4 atot = (f32x4){0.f, 0.f, 0.f, 0.f};
    const int s0 = seg * SEGLEN + 12 * pq;
    PaRegs RA, RB;
    pa_load(RA, LG, VI, dir, s0, col);
    pa_load(RB, LG, VI, dir, s0 + PA_GROUP, col);
    __syncthreads(); pa_stage1(RA, L, col, pq, c4, FLANE, atot); pa_load(RA, LG, VI, dir, s0 + 2 * PA_GROUP, col); __syncthreads(); pa_stage2(S, L, i, gq, eb);
    __syncthreads(); pa_stage1(RB, L, col, pq, c4, FLANE, atot); __syncthreads(); pa_stage2(S, L, i, gq, eb);
    __syncthreads(); pa_stage1(RA, L, col, pq, c4, FLANE, atot); __syncthreads(); pa_stage2(S, L, i, gq, eb);
    static_assert(PA_NG == 3, "three groups written out");
#pragma unroll
    for (int tt = 0; tt < 8; ++tt) SLOC[((size_t)(unit * 8 + F.wave) * 8 + tt) * 64 + FLANE] = S[tt];
    if (pq == 0) *(f32x4*)(ATOT + (size_t)unit * HDIM + col) = atot;
    __syncthreads();
}

constexpr int NPH_LAYER = 13, NPHASES = 2 + DEPTH * NPH_LAYER;
__global__ void __launch_bounds__(NWAVES * 64, 2) mk_fwd(Args args) {
    TID_DECL();
    extern __shared__ __attribute__((aligned(16))) unsigned char lds[];
    Frame F;
    F.lds = (LAS unsigned char*)lds;
    F.wave = __builtin_amdgcn_readfirstlane(FTID >> 6);
    F.G = gridDim.x; F.bx = blockIdx.x; F.sect = 0ull;
    for (int u = FTID; u < (LDS_BYTES - LDSCTL_OFF) / 4; u += NWAVES * 64) ((LAS unsigned*)(F.lds + LDSCTL_OFF))[u] = 0u;
    __syncthreads();
    XcdBarrier bar = xcd_barrier_post((unsigned*)(args.ws + WS_CTL) + CW_BAR, (volatile LAS unsigned*)(F.lds + MISC_OFF) + 8);
    const int lo = args.ph_lo, hi = args.ph_hi;
#define IN(k) (lo <= (k) && (k) < hi)
    unsigned long long probe_t = (PROBE_PHASE >= 0) ? __builtin_amdgcn_s_memrealtime() : 0ull; const unsigned long long probe_t0 = probe_t;
#define SEAM(k) do { if (IN(k) && IN((k) + 1)) { _Pragma("nounroll") for (int rb_ = 0; rb_ < REP_BAR; ++rb_) xcd_barrier(bar); } \
        if (PROBE_PHASE >= 0) { const unsigned long long tn_ = __builtin_amdgcn_s_memrealtime(); \
            if ((k) == PROBE_PHASE) { const unsigned long long w_ = (unsigned long long)PROBE_MULT * (tn_ - probe_t); while (__builtin_amdgcn_s_memrealtime() - tn_ < w_) __builtin_amdgcn_s_sleep(8); } \
            probe_t = __builtin_amdgcn_s_memrealtime(); } } while (0)
    using pg8::Gemm; using pg8::RectOrder; using pg8::gemm_phase;
    LAS unsigned char* ring = F.lds + RING_OFF;
#define WSB() unsigned char* ws = opaque_ptr(args.ws)
#define MODALL ((const float*)(ws + WS_MOD))
#define NORMG(l_) (INP(6) + (size_t)(l_) * NNORM * DM)
#define MODL(l_) (MODALL + (size_t)(l_) * NGRP * NMOD * DM)
#define WL(l_) (ws + WS_W + (size_t)(l_) * W_LAYER)

    if (IN(0)) { _Pragma("nounroll") for (int rep = 0; rep < REP_P0; ++rep) { p0_prologue(F, args); __syncthreads(); } }
    SEAM(0);
    if (IN(1)) { WSB(); _Pragma("nounroll") for (int rep = 0; rep < REP_THIN; ++rep) thin_phase<0>(F, args, TT, 0, nullptr, nullptr, 0, 0.f, NORMG(0), MODALL, 0, 1); }
    SEAM(1);
#pragma nounroll
    for (int l = 0; l < DEPTH; ++l) {
        const int pb = 2 + l * NPH_LAYER; const bool lastl = (l == DEPTH - 1);
        const int npan_late = lastl ? TX / 256 : TT / 256;
        const int gG = (l == 0) ? SPARE_G : F.G;
        if (IN(pb + 0)) { if (F.bx >= gG) background_work(F, args, 0); else {
            WSB(); Gemm g{(const bf16*)(ws + WS_H), (const bf16*)(WL(l) + WO_GU1), DM, DM}; RectOrder S{0, TT / 256, 0, 2 * DFF / 256, 0, 0, 0, 0, 1, 0, 0, DM / 64, gG, F.bx}; EpiGU E{(bf16*)(ws + WS_ACT)};
            _Pragma("nounroll") for (int rep = 0; rep < REP_GEMM; ++rep) gemm_phase<EpiGU, RectOrder, true, true>(ring, g, S, E);
            if (l == 1) tail_work(F, args, (TT / 256) * (2 * DFF / 256), BG_S2_END, BG_D2_L1); } }
        SEAM(pb + 0);
        if (IN(pb + 1)) { WSB(); Gemm g{(const bf16*)(ws + WS_ACT), (const bf16*)(WL(l) + WO_D1), DFF, DFF}; RectOrder S{0, TX / 256, 0, DM / 256, TX / 256, TC / 256, 0, DM / 256, NSLAB, 12, 10, DFF / 64, F.G, F.bx}; EpiY E{(bf16*)(ws + WS_Y), (bf16*)(ws + WS_YS)};
            _Pragma("nounroll") for (int rep = 0; rep < REP_GEMM; ++rep) gemm_phase<EpiY, RectOrder, true, true>(ring, g, S, E); }
        SEAM(pb + 1);
        if (IN(pb + 2)) { WSB(); _Pragma("nounroll") for (int rep = 0; rep < REP_THIN; ++rep) { if (l == 0 && rep == 0) thin_phase<1, true>(F, args, TT, NSLAB, NORMG(l) + 1 * DM, MODL(l), 2, 0.5f, NORMG(l) + 2 * DM, MODL(l), 3, 4);
            else thin_phase<1>(F, args, TT, NSLAB, NORMG(l) + 1 * DM, MODL(l), 2, rep ? 0.f : 0.5f, NORMG(l) + 2 * DM, MODL(l), 3, 4); } }
        SEAM(pb + 2);
        if (IN(pb + 3)) { if (F.bx >= gG) background_work(F, args, 1); else {
            WSB(); Gemm g{(const bf16*)(ws + WS_H), (const bf16*)(WL(l) + WO_IN), DM, DM};
            RectOrder S{0, lastl ? TX / 256 : TT / 256, 0, INC / 256, TX / 256, lastl ? TC / 256 : 0, 12, 12, 1, 0, 0, DM / 64, gG, F.bx};
            EpiIN E{(bf16*)(ws + WS_U), (bf16*)(ws + WS_V), (bf16*)(ws + WS_Q), (bf16*)(ws + WS_VI), (bf16*)(ws + WS_SG), (unsigned char*)(ws + WS_SA), (unsigned char*)(ws + WS_SB),
                    (unsigned short*)(ws + WS_LF), (unsigned short*)(ws + WS_LB), (const float*)(ws + WS_LBT) + (size_t)l * 2 * DBB, (float*)(ws + WS_VST)};
            _Pragma("nounroll") for (int rep = 0; rep < REP_GEMM; ++rep) gemm_phase<EpiIN, RectOrder, true, true>(ring, g, S, E); } }
        SEAM(pb + 3);
        if (IN(pb + 4)) {
            if (F.bx < 192) { _Pragma("nounroll") for (int rep = 0; rep < REP_S1 * REP_SA; ++rep)
                scan_pass_a2(F, args, F.bx & 3, (F.bx >> 2) & 7, (F.bx >> 5) & 1, F.bx >> 6); }
            _Pragma("nounroll") for (int rep = 0; rep < REP_S1 * REP_GMLP; ++rep) {
            const int nun = (lastl ? TX / 128 : TT / 128) * 8;
            if (F.bx >= 192) { for (int it = (F.bx - 192) * 4; it < (F.bx - 192) * 4 + 4; ++it) gmlp_unit(F, args, (it >> 3) * 128, it & 7, INP(12) + (size_t)l * DA, INP(13) + (size_t)l * 8 * 128 * 128, INP(14) + (size_t)l * 8 * 128); }
            else { for (int it = 256 + F.bx; it < (lastl ? 448 : nun); it += 192) gmlp_unit(F, args, (it >> 3) * 128, it & 7, INP(12) + (size_t)l * DA, INP(13) + (size_t)l * 8 * 128 * 128, INP(14) + (size_t)l * 8 * 128); }
            }
        }
        SEAM(pb + 4);
        if (IN(pb + 5)) { _Pragma("nounroll") for (int rep = 0; rep < REP_S1 * REP_SB; ++rep) { SECT_B(5); scan_pass<true>(F, args, F.bx & 3, (F.bx >> 2) & 7, (F.bx >> 5) & 1, F.bx >> 6, !lastl); SECT_E(5); }
            if (lastl && F.bx < 64) { const int it = 448 + F.bx; gmlp_unit(F, args, (it >> 3) * 128, it & 7, INP(12) + (size_t)l * DA, INP(13) + (size_t)l * 8 * 128 * 128, INP(14) + (size_t)l * 8 * 128); } }
        SEAM(pb + 5);
        if (IN(pb + 6)) { _Pragma("nounroll") for (int rep = 0; rep < REP_THIN; ++rep) readout_phase(F, args, npan_late * 256, INP(16) + (size_t)l * DBB); }
        SEAM(pb + 6);
        if (IN(pb + 7)) { WSB(); RectOrder S{0, npan_late, 0, DM / 256, 0, 0, 0, 0, 1, 0, 0, 2 * DA / 64, F.G, F.bx};
            Gemm g{(const bf16*)(ws + WS_YAB), (const bf16*)(WL(l) + WO_UP), 2 * DA, 2 * DA}; EpiMerge E{(const unsigned char*)(ws + WS_SA), (const unsigned char*)(ws + WS_SB), (bf16*)(ws + WS_MB)};
            _Pragma("nounroll") for (int rep = 0; rep < REP_GEMM; ++rep) gemm_phase<EpiMerge, RectOrder, true, true>(ring, g, S, E); }
        SEAM(pb + 7);
        if (IN(pb + 8)) { WSB(); Gemm g{(const bf16*)(ws + WS_MB), (const bf16*)(WL(l) + WO_OUT), DM, DM}; RectOrder S{0, TX / 256, 0, DM / 256, TX / 256, lastl ? 0 : TC / 256, 0, DM / 256, NSLAB_OUT, 8, 8, DM / 64, F.G, F.bx}; EpiY E{(bf16*)(ws + WS_Y), (bf16*)(ws + WS_YS)};
            _Pragma("nounroll") for (int rep = 0; rep < REP_GEMM; ++rep) gemm_phase<EpiY, RectOrder, true, true>(ring, g, S, E); }
        SEAM(pb + 8);
        if (IN(pb + 9)) { WSB(); _Pragma("nounroll") for (int rep = 0; rep < REP_THIN; ++rep) thin_phase<1>(F, args, npan_late * 256, NSLAB_OUT, NORMG(l) + 3 * DM, MODL(l), 5, rep ? 0.f : 1.0f, NORMG(l) + 4 * DM, MODL(l), 6, 7); }
        SEAM(pb + 9);
        if (IN(pb + 10)) { if (F.bx >= gG) background_work(F, args, 2); else {
            WSB(); Gemm g{(const bf16*)(ws + WS_H), (const bf16*)(WL(l) + WO_GU2), DM, DM}; RectOrder S{0, npan_late, 0, 2 * DFF / 256, 0, 0, 0, 0, 1, 0, 0, DM / 64, gG, F.bx}; EpiGU E{(bf16*)(ws + WS_ACT)};
            _Pragma("nounroll") for (int rep = 0; rep < REP_GEMM; ++rep) gemm_phase<EpiGU, RectOrder, true, true>(ring, g, S, E);
            if (l == 1) tail_work(F, args, npan_late * (2 * DFF / 256), BG_D2_L1, 2 * PER_LAYER); } }
        SEAM(pb + 10);
        if (IN(pb + 11)) { WSB(); Gemm g{(const bf16*)(ws + WS_ACT), (const bf16*)(WL(l) + WO_D2), DFF, DFF}; RectOrder S{0, TX / 256, 0, DM / 256, TX / 256, lastl ? 0 : TC / 256, 0, DM / 256, NSLAB, 12, 10, DFF / 64, F.G, F.bx}; EpiY E{(bf16*)(ws + WS_Y), (bf16*)(ws + WS_YS)};
            _Pragma("nounroll") for (int rep = 0; rep < REP_GEMM; ++rep) gemm_phase<EpiY, RectOrder, true, true>(ring, g, S, E); }
        SEAM(pb + 11);
        if (IN(pb + 12)) { WSB();
            if (lastl) _Pragma("nounroll") for (int rep = 0; rep < REP_THIN; ++rep) thin_phase<2>(F, args, TX, 0, NORMG(l) + 5 * DM, MODL(l), 8, 0.5f, nullptr, nullptr, 0, 0);
            else _Pragma("nounroll") for (int rep = 0; rep < REP_THIN; ++rep) thin_phase<1>(F, args, TT, NSLAB, NORMG(l) + 5 * DM, MODL(l), 8, rep ? 0.f : 0.5f, NORMG(l + 1), MODL(l + 1), 0, 1);
        }
        if (!lastl) SEAM(pb + 12);
    }
    if (PROBE_SECT > 0) { const unsigned long long tn_ = __builtin_amdgcn_s_memrealtime(), w_ = (unsigned long long)PROBE_MULT * F.sect; while (__builtin_amdgcn_s_memrealtime() - tn_ < w_) __builtin_amdgcn_s_sleep(8); }
    if (PROBE_PHASE == 99 && F.bx == 0) { const unsigned long long tn_ = __builtin_amdgcn_s_memrealtime(), w_ = tn_ - probe_t0; while (__builtin_amdgcn_s_memrealtime() - tn_ < w_) __builtin_amdgcn_s_sleep(8); }
#undef IN
#undef SEAM
}

extern "C" void kernel_launch(void* const* d_in, const int* in_sizes, int n_in, void* d_out, int out_size, void* d_ws, size_t ws_size, hipStream_t stream) {
    static int grid = 0;
    if (grid == 0) {
        if (n_in != 20 || in_sizes[0] != TX * DM || out_size != TX * DM || ws_size < WS_END) {
            fprintf(stderr, "kernel_launch: unexpected shapes / workspace (n_in %d, in0 %d, out %d, ws %zu, need %zu); nothing launched\n", n_in, n_in > 0 ? in_sizes[0] : -1, out_size, ws_size, (size_t)WS_END); grid = -1; return; }
        int dev = 0, cus = 0, per_cu = 0;
        if (hipGetDevice(&dev) != hipSuccess || hipDeviceGetAttribute(&cus, hipDeviceAttributeMultiprocessorCount, dev) != hipSuccess) { grid = -1; return; }
        if (hipFuncSetAttribute((const void*)mk_fwd, hipFuncAttributeMaxDynamicSharedMemorySize, LDS_BYTES) != hipSuccess) { fprintf(stderr, "kernel_launch: hipFuncSetAttribute failed\n"); grid = -1; return; }
        if (hipOccupancyMaxActiveBlocksPerMultiprocessor(&per_cu, (const void*)mk_fwd, NWAVES * 64, LDS_BYTES) != hipSuccess || per_cu < 1)
            fprintf(stderr, "kernel_launch: note: occupancy query reports %d workgroups per CU\n", per_cu);
        (void)hipGetLastError();
        grid = cus;
        if (grid != 256) fprintf(stderr, "kernel_launch: note: %d CUs\n", grid);
    }
    if (grid < 0) return;
    if (hipMemsetAsync((char*)d_ws, 0, ZERO_BYTES, stream) != hipSuccess) { fprintf(stderr, "kernel_launch: memset failed\n"); return; }
    Args a{};
    for (int i = 0; i < 20; ++i) a.in[i] = (const float*)d_in[i];
    a.out = (float*)d_out; a.ws = (unsigned char*)d_ws;
#if MK_PER_PHASE
    for (int p = 0; p < NPHASES; ++p) { a.ph_lo = p; a.ph_hi = p + 1; hipLaunchKernelGGL(mk_fwd, dim3(grid), dim3(NWAVES * 64), LDS_BYTES, stream, a); }
#else
    a.ph_lo = 0; a.ph_hi = NPHASES;
    hipLaunchKernelGGL(mk_fwd, dim3(grid), dim3(NWAVES * 64), LDS_BYTES, stream, a);
#endif
    const hipError_t le = hipPeekAtLastError();
    if (le != hipSuccess) fprintf(stderr, "kernel_launch: launch failed: %s\n", hipGetErrorName(le));
}
```
